# Optimizing an MI355X kernel written in HIP

```python
import jax, jax.numpy as jnp
from jax import lax
import numpy as np

D_MODEL = 1024
BATCH = 16
SEQ = 2048
DEPTH = 2

HEAD_DIM = 64
N_HEADS = D_MODEL // HEAD_DIM
FOX_HEADS = N_HEADS // 2
SWA_HEADS = N_HEADS - FOX_HEADS
SWA_KV_HEADS = max(1, SWA_HEADS // 4)
SWA_WINDOW = 128
Q_BLOCK = 128
DSA_HEADS = N_HEADS
DSA_KV_HEADS = max(1, DSA_HEADS // 4)
IDX_HEADS = 8
IDX_DIM = 64
DSA_TOPK_MAX = 256
D_FF = 2816
N_EXPERTS = 8
TOP_K = 2
D_FF_EXPERT = 1408
ROPE_THETA = 10000.0
NORM_EPS = 1e-6
N_EVEN = (DEPTH + 1) // 2
N_ODD = DEPTH // 2

EVEN_SPLITS = (FOX_HEADS * HEAD_DIM, FOX_HEADS * HEAD_DIM, FOX_HEADS * HEAD_DIM, FOX_HEADS,
               SWA_HEADS * HEAD_DIM, SWA_KV_HEADS * HEAD_DIM, SWA_KV_HEADS * HEAD_DIM)
EVEN_IN = sum(EVEN_SPLITS)
ODD_SPLITS = (DSA_HEADS * HEAD_DIM, DSA_KV_HEADS * HEAD_DIM, DSA_KV_HEADS * HEAD_DIM,
              IDX_HEADS * IDX_DIM, IDX_DIM, IDX_HEADS)
ODD_IN = sum(ODD_SPLITS)

kernel_name = 'hybrid_fox_swa_dsa_moe'


def _split(t, sizes):
    return jnp.split(t, np.cumsum(sizes)[:-1].tolist(), axis=-1)


def rms_norm(x, g):
    xf = x.astype(jnp.float32)
    y = xf * lax.rsqrt(jnp.mean(xf * xf, axis=-1, keepdims=True) + NORM_EPS)
    return (y * g.astype(jnp.float32)).astype(x.dtype)


def ada_modulation(c, w, b):
    mod = jax.nn.silu(c) @ w + b
    return jnp.split(mod[:, None, :], 6, axis=-1)


def rope_tables(positions, dim):
    half = dim // 2
    inv_freq = ROPE_THETA ** (-jnp.arange(half, dtype=jnp.float32) / half)
    ang = positions.astype(jnp.float32)[..., None] * inv_freq
    return jnp.cos(ang)[:, :, None, :], jnp.sin(ang)[:, :, None, :]


def apply_rope(t, cos, sin):
    half = t.shape[-1] // 2
    tf = t.astype(jnp.float32)
    t1, t2 = tf[..., :half], tf[..., half:]
    return jnp.concatenate([t1 * cos - t2 * sin, t2 * cos + t1 * sin], axis=-1).astype(t.dtype)


def swiglu(h, w_gate, w_up, w_down):
    return (jax.nn.silu(h @ w_gate) * (h @ w_up)) @ w_down


def forgetting_attention(q, k, v, log_f):
    B, S, H, D = q.shape
    cum = jnp.cumsum(log_f.astype(jnp.float32), axis=1).transpose(0, 2, 1)
    kpos = jnp.arange(S)
    scale = D ** -0.5

    def block(i):
        start = i * Q_BLOCK
        qi = lax.dynamic_slice_in_dim(q, start, Q_BLOCK, axis=1)
        ci = lax.dynamic_slice_in_dim(cum, start, Q_BLOCK, axis=2)
        s = jnp.einsum('bqhd,bkhd->bhqk', qi, k, preferred_element_type=jnp.float32) * scale
        s = s + ci[..., :, None] - cum[..., None, :]
        qpos = start + jnp.arange(Q_BLOCK)
        s = jnp.where(kpos[None, :] <= qpos[:, None], s, -jnp.inf)
        p = jax.nn.softmax(s, axis=-1)
        return jnp.einsum('bhqk,bkhd->bqhd', p.astype(v.dtype), v)

    out = lax.map(block, jnp.arange(S // Q_BLOCK))
    return jnp.moveaxis(out, 0, 1).reshape(B, S, H, D)


def sliding_window_sink_attention(q, k, v, sinks):
    B, S, H, D = q.shape
    KVH = k.shape[2]
    G = H // KVH
    W = SWA_WINDOW
    nb = S // W
    qb = q.reshape(B, nb, W, KVH, G, D)

    def band_keys(t):
        tb = t.reshape(B, nb, W, KVH, D)
        prev = jnp.concatenate([jnp.zeros_like(tb[:, :1]), tb[:, :-1]], axis=1)
        return jnp.concatenate([prev, tb], axis=2)

    kk, vv = band_keys(k), band_keys(v)
    s = jnp.einsum('bnqhgd,bnshd->bnhgqs', qb, kk, preferred_element_type=jnp.float32) * D ** -0.5
    rel = (jnp.arange(W)[:, None] + W) - jnp.arange(2 * W)[None, :]
    band = (rel >= 0) & (rel < W)
    not_pad = (jnp.arange(nb)[:, None, None] > 0) | (jnp.arange(2 * W) >= W)[None, None, :]
    valid = band[None] & not_pad
    s = jnp.where(valid[None, :, None, None], s, -jnp.inf)
    sink = sinks.astype(jnp.float32).reshape(KVH, G)[None, None, :, :, None, None]
    m = jnp.maximum(jnp.max(s, axis=-1, keepdims=True), sink)
    e = jnp.exp(s - m)
    p = e / (jnp.sum(e, axis=-1, keepdims=True) + jnp.exp(sink - m))
    out = jnp.einsum('bnhgqs,bnshd->bnqhgd', p.astype(v.dtype), vv)
    return out.reshape(B, S, H, D)


def dsa_attention(q, k, v, iq, ik, iw):
    B, S, H, D = q.shape
    KVH = k.shape[2]
    G = H // KVH
    topk = min(DSA_TOPK_MAX, S // 4)
    kpos = jnp.arange(S)
    scale = D ** -0.5
    gather = jax.vmap(lambda tb, ib: tb[ib])

    def block(i):
        start = i * Q_BLOCK
        qi = lax.dynamic_slice_in_dim(q, start, Q_BLOCK, axis=1).reshape(B, Q_BLOCK, KVH, G, D)
        iqi = lax.dynamic_slice_in_dim(iq, start, Q_BLOCK, axis=1)
        iwi = lax.dynamic_slice_in_dim(iw, start, Q_BLOCK, axis=1).astype(jnp.float32)
        qpos = start + jnp.arange(Q_BLOCK)
        logits = jnp.einsum('bqhd,bsd->bqhs', iqi, ik, preferred_element_type=jnp.float32)
        score = jnp.einsum('bqh,bqhs->bqs', iwi, jax.nn.relu(logits))
        score = jnp.where((kpos[None, :] <= qpos[:, None])[None], score, -jnp.inf)
        _, idx = lax.top_k(score, topk)
        sel_valid = idx <= qpos[None, :, None]
        ks = gather(k, idx)
        vs = gather(v, idx)
        s = jnp.einsum('bqhgd,bqthd->bhgqt', qi, ks, preferred_element_type=jnp.float32) * scale
        s = jnp.where(sel_valid[:, None, None], s, -jnp.inf)
        p = jax.nn.softmax(s, axis=-1)
        o = jnp.einsum('bhgqt,bqthd->bqhgd', p.astype(v.dtype), vs)
        return o.reshape(B, Q_BLOCK, H, D)

    out = lax.map(block, jnp.arange(S // Q_BLOCK))
    return jnp.moveaxis(out, 0, 1).reshape(B, S, H, D)


def moe_swiglu(h, router_w, router_b, w_gate, w_up, w_down):
    B, S, Dm = h.shape
    t = h.reshape(B * S, Dm)
    logits = (t @ router_w).astype(jnp.float32) + router_b.astype(jnp.float32)
    top_vals, top_idx = lax.top_k(logits, TOP_K)
    gates = jax.nn.softmax(top_vals, axis=-1)
    combine = jnp.sum(jax.nn.one_hot(top_idx, N_EXPERTS, dtype=jnp.float32) * gates[..., None], axis=1)
    combine = combine.astype(h.dtype)
    out = jnp.zeros_like(t)
    for e in range(N_EXPERTS):
        out = out + combine[:, e:e + 1] * swiglu(t, w_gate[e], w_up[e], w_down[e])
    return out.reshape(B, S, Dm)


def even_layer(x, c, cos, sin, ada_w, ada_b, norm_mix, norm_ffn, w_in, forget_b, sinks, w_out,
               ffn_gate, ffn_up, ffn_down):
    B, S, _ = x.shape
    sh_m, sc_m, g_m, sh_f, sc_f, g_f = ada_modulation(c, ada_w, ada_b)
    h = rms_norm(x, norm_mix) * (1 + sc_m) + sh_m
    fq, fk, fv, fgl, sq, sk, sv = _split(h @ w_in, EVEN_SPLITS)
    heads = lambda t, n: t.reshape(B, S, n, HEAD_DIM)
    log_f = jax.nn.log_sigmoid((fgl + forget_b).astype(jnp.float32))
    o_fox = forgetting_attention(heads(fq, FOX_HEADS), heads(fk, FOX_HEADS), heads(fv, FOX_HEADS), log_f)
    o_swa = sliding_window_sink_attention(apply_rope(heads(sq, SWA_HEADS), cos, sin),
                                          apply_rope(heads(sk, SWA_KV_HEADS), cos, sin),
                                          heads(sv, SWA_KV_HEADS), sinks)
    mix = jnp.concatenate([o_fox.reshape(B, S, -1), o_swa.reshape(B, S, -1)], axis=-1) @ w_out
    x = x + g_m * mix
    h = rms_norm(x, norm_ffn) * (1 + sc_f) + sh_f
    return x + g_f * swiglu(h, ffn_gate, ffn_up, ffn_down)


def odd_layer(x, c, cos, sin, ada_w, ada_b, norm_mix, norm_ffn, w_in, w_out,
              router_w, router_b, exp_gate, exp_up, exp_down):
    B, S, _ = x.shape
    sh_m, sc_m, g_m, sh_f, sc_f, g_f = ada_modulation(c, ada_w, ada_b)
    h = rms_norm(x, norm_mix) * (1 + sc_m) + sh_m
    q, k, v, iq, ik, iw = _split(h @ w_in, ODD_SPLITS)
    q = apply_rope(q.reshape(B, S, DSA_HEADS, HEAD_DIM), cos, sin)
    k = apply_rope(k.reshape(B, S, DSA_KV_HEADS, HEAD_DIM), cos, sin)
    v = v.reshape(B, S, DSA_KV_HEADS, HEAD_DIM)
    iq = apply_rope(iq.reshape(B, S, IDX_HEADS, IDX_DIM), cos, sin)
    ik = apply_rope(ik.reshape(B, S, 1, IDX_DIM), cos, sin)[:, :, 0]
    iw = iw * (IDX_HEADS ** -0.5 * IDX_DIM ** -0.5)
    o = dsa_attention(q, k, v, iq, ik, iw)
    x = x + g_m * (o.reshape(B, S, -1) @ w_out)
    h = rms_norm(x, norm_ffn) * (1 + sc_f) + sh_f
    return x + g_f * moe_swiglu(h, router_w, router_b, exp_gate, exp_up, exp_down)


def setup_inputs(seed: int = 0) -> dict:
    key = jax.random.key(seed)
    ks = iter(jax.random.split(key, 40))
    D = D_MODEL

    def nrm(shape, s):
        return jax.random.normal(next(ks), shape, jnp.float32) * s

    x = nrm((BATCH, SEQ, D), 1.0)
    c = nrm((BATCH, D), 1.0)
    offset = jax.random.randint(next(ks), (BATCH, 1), 0, 4096, dtype=jnp.int32)
    positions = offset + jnp.arange(SEQ, dtype=jnp.int32)[None, :]
    return {
        'x': x, 'c': c, 'positions': positions,
        'e_ada_w': nrm((N_EVEN, D, 6 * D), 0.5 * D ** -0.5),
        'e_ada_b': nrm((N_EVEN, 6 * D), 0.02),
        'e_norm_mix': 1.0 + nrm((N_EVEN, D), 0.05),
        'e_norm_ffn': 1.0 + nrm((N_EVEN, D), 0.05),
        'e_w_in': nrm((N_EVEN, D, EVEN_IN), D ** -0.5),
        'e_forget_b': 3.0 + nrm((N_EVEN, FOX_HEADS), 1.0),
        'e_sinks': nrm((N_EVEN, SWA_HEADS), 1.0),
        'e_w_out': nrm((N_EVEN, D, D), D ** -0.5),
        'e_ffn_gate': nrm((N_EVEN, D, D_FF), D ** -0.5),
        'e_ffn_up': nrm((N_EVEN, D, D_FF), D ** -0.5),
        'e_ffn_down': nrm((N_EVEN, D_FF, D), D_FF ** -0.5),
        'o_ada_w': nrm((N_ODD, D, 6 * D), 0.5 * D ** -0.5),
        'o_ada_b': nrm((N_ODD, 6 * D), 0.02),
        'o_norm_mix': 1.0 + nrm((N_ODD, D), 0.05),
        'o_norm_ffn': 1.0 + nrm((N_ODD, D), 0.05),
        'o_w_in': nrm((N_ODD, D, ODD_IN), D ** -0.5),
        'o_w_out': nrm((N_ODD, D, D), D ** -0.5),
        'o_router_w': nrm((N_ODD, D, N_EXPERTS), D ** -0.5),
        'o_router_b': nrm((N_ODD, N_EXPERTS), 0.01),
        'o_exp_gate': nrm((N_ODD, N_EXPERTS, D, D_FF_EXPERT), D ** -0.5),
        'o_exp_up': nrm((N_ODD, N_EXPERTS, D, D_FF_EXPERT), D ** -0.5),
        'o_exp_down': nrm((N_ODD, N_EXPERTS, D_FF_EXPERT, D), D_FF_EXPERT ** -0.5),
        'final_norm': 1.0 + nrm((D,), 0.05),
    }


def reference(x, c, positions,
              e_ada_w, e_ada_b, e_norm_mix, e_norm_ffn, e_w_in, e_forget_b, e_sinks, e_w_out,
              e_ffn_gate, e_ffn_up, e_ffn_down,
              o_ada_w, o_ada_b, o_norm_mix, o_norm_ffn, o_w_in, o_w_out,
              o_router_w, o_router_b, o_exp_gate, o_exp_up, o_exp_down,
              final_norm):
    cos, sin = rope_tables(positions, HEAD_DIM)
    for layer in range(DEPTH):
        i = layer // 2
        if layer % 2 == 0:
            x = even_layer(x, c, cos, sin, e_ada_w[i], e_ada_b[i], e_norm_mix[i], e_norm_ffn[i],
                           e_w_in[i], e_forget_b[i], e_sinks[i], e_w_out[i],
                           e_ffn_gate[i], e_ffn_up[i], e_ffn_down[i])
        else:
            x = odd_layer(x, c, cos, sin, o_ada_w[i], o_ada_b[i], o_norm_mix[i], o_norm_ffn[i],
                          o_w_in[i], o_w_out[i], o_router_w[i], o_router_b[i],
                          o_exp_gate[i], o_exp_up[i], o_exp_down[i])
    return rms_norm(x, final_norm)
```

```cpp
#include <hip/hip_runtime.h>
#include <cstdio>
#include <cstdint>

#ifndef MK_STAGE
#define MK_STAGE 4
#endif
#ifndef MK_ONE_LAUNCH
#define MK_ONE_LAUNCH 1
#endif

#ifndef MK_REP_PHASE
#define MK_REP_PHASE -1
#define MK_REP_N 0
#endif
#ifndef MK_DUP
#define MK_DUP 0
#endif
#define GAS __attribute__((address_space(1)))
#define LAS __attribute__((address_space(3)))
typedef unsigned short bf16;
typedef unsigned u32x4 __attribute__((ext_vector_type(4)));
typedef unsigned u32x2 __attribute__((ext_vector_type(2)));
typedef float f32x4 __attribute__((ext_vector_type(4)));
typedef float f32x2 __attribute__((ext_vector_type(2)));
typedef float f32x16 __attribute__((ext_vector_type(16)));
typedef short bf16x8 __attribute__((ext_vector_type(8)));
typedef __bf16 bf16x2_t __attribute__((ext_vector_type(2)));

__device__ __forceinline__ unsigned cvtpk(float lo, float hi) { f32x2 v = {lo, hi}; bf16x2_t b = __builtin_convertvector(v, bf16x2_t); return __builtin_bit_cast(unsigned, b); }
typedef int v8i32 __attribute__((ext_vector_type(8)));
typedef int v4i32g __attribute__((ext_vector_type(4)));
__device__ __forceinline__ unsigned pack4_i8(float a, float b, float c, float d) {
    unsigned w = 0u; w = __builtin_amdgcn_cvt_pk_u8_f32(a + 128.f, 0, w); w = __builtin_amdgcn_cvt_pk_u8_f32(b + 128.f, 1, w); w = __builtin_amdgcn_cvt_pk_u8_f32(c + 128.f, 2, w); w = __builtin_amdgcn_cvt_pk_u8_f32(d + 128.f, 3, w);
    return w ^ 0x80808080u; }
typedef short bf16x16v __attribute__((ext_vector_type(16)));
constexpr float FP8_ACT_SCALE = 8.f, FP8_W_SCALE = 32.f, FP8_OUT_SCALE = 1.f / (8.f * 32.f), FP8_H_SCALE = 16.f, FP8_GU_SCALE = 1.f / (16.f * 32.f);
__device__ __forceinline__ unsigned pack4_fp8(float a, float b, float c, float d) {
    a = __builtin_amdgcn_fmed3f(a, -448.f, 448.f); b = __builtin_amdgcn_fmed3f(b, -448.f, 448.f); c = __builtin_amdgcn_fmed3f(c, -448.f, 448.f); d = __builtin_amdgcn_fmed3f(d, -448.f, 448.f);
    int w = 0; w = __builtin_amdgcn_cvt_pk_fp8_f32(a, b, w, false); w = __builtin_amdgcn_cvt_pk_fp8_f32(c, d, w, true); return (unsigned)w; }
__device__ __forceinline__ float bf2f(unsigned short b) { return __uint_as_float((unsigned)b << 16); }
__device__ __forceinline__ float bflo(unsigned w) { return __uint_as_float(w << 16); }
__device__ __forceinline__ float bfhi(unsigned w) { return __uint_as_float(w & 0xffff0000u); }

constexpr int BATCH = 16, SEQ = 2048, T = BATCH * SEQ, D = 1024;
constexpr int NQ = 2304;
constexpr int FF = 2816, FFE = 1408, NE = 8;
constexpr int FFEP = 1536;
constexpr int E_IN = 2312, O_IN = 2120;
constexpr float C2 = 0.125f * 1.4426950408889634f;
constexpr float NORM_EPS = 1e-6f;
constexpr int YROWS = 2 * T + NE * 256;

constexpr size_t MiB = 1u << 20;
constexpr size_t WS_CTL = 0, CTL_ZERO_BYTES = 1 * MiB;
constexpr size_t WS_MOD = 1 * MiB;
constexpr size_t WS_ROPE = 2 * MiB;
constexpr size_t WS_LOGF = 10 * MiB;
constexpr size_t WS_KAUG = 11 * MiB;
constexpr size_t WS_IW = 15 * MiB;
constexpr size_t WS_TOK = 16 * MiB;
constexpr size_t WS_RS = 16 * MiB + 512 * 1024;
constexpr size_t WS_CS = WS_RS + 128 * 1024;
constexpr int CS_WIN0 = 0, CS_WGU0 = 2304, CS_WIN1 = CS_WGU0 + 2 * 2816, CS_WGU1 = CS_WIN1 + 2304, CS_END = CS_WGU1 + 8 * 2 * 1408;

static_assert(CS_END == 32768, "column scale table");
constexpr size_t WS_LIST = 17 * MiB;
constexpr size_t WS_MASK = 18 * MiB;
constexpr size_t WS_WIN0 = 26 * MiB, WS_WOUT0 = WS_WIN0 + (size_t)NQ * D * 2, WS_WGU0 = WS_WOUT0 + (size_t)D * D * 2, WS_WDN0 = WS_WGU0 + (size_t)2 * FF * D * 2;
constexpr size_t WS_WIN1 = WS_WDN0 + (size_t)D * FF * 2, WS_WOUT1 = WS_WIN1 + (size_t)NQ * D * 2, WS_WGU1 = WS_WOUT1 + (size_t)D * D * 2, WS_WDN1 = WS_WGU1 + (size_t)NE * 2 * FFE * D * 2;
constexpr size_t WS_WEND = WS_WDN1 + (size_t)NE * D * FFE * 2;
constexpr size_t WS_XR = 122 * MiB;
constexpr size_t WS_H = 186 * MiB;
constexpr size_t WS_Y = WS_H, WS_MIX = WS_H;
constexpr size_t WS_QKV = 250 * MiB;
constexpr size_t WS_VT = 394 * MiB;
constexpr size_t WS_VT_SWA = WS_VT + 32 * MiB;
constexpr size_t WS_ACT0 = WS_QKV;
constexpr size_t WS_ACT1 = 318 * MiB;
constexpr size_t WS_END = 500 * MiB;
static_assert(WS_WEND <= WS_XR && WS_XR + (size_t)T * D * 2 <= WS_H && WS_Y + (size_t)YROWS * D * 2 <= WS_ACT1 && WS_H + (size_t)T * D * 2 <= WS_QKV && WS_QKV + (size_t)T * NQ * 2 <= WS_VT && WS_VT_SWA + (size_t)16 * 128 * SEQ * 2 <= WS_END
              && WS_ACT0 + (size_t)T * FF * 2 <= WS_END && WS_ACT1 + (size_t)YROWS * FFE * 2 <= WS_END, "d_ws map");
constexpr int CW_TMO = 0;
constexpr int CW_BAR = 4096;
constexpr int CW_CNT = 16384;

constexpr int VT_STAGE_OFF = 131072, VT_STAGE_WAVE = 2560;
constexpr int SCR_BYTES = 151552;
constexpr int MISC_OFF = SCR_BYTES;
constexpr int LDS_BYTES = SCR_BYTES + 1024;

namespace pg8 {
#define PG8_LAS __attribute__((address_space(3)))
constexpr int BM = 256, BK = 64, HALF = 128, HTB = HALF * BK * 2, NXCD = 8, WGM = 8;
__host__ __device__ __forceinline__ int lds_byte(int r, int c) { const int st = (r >> 4) * 2 + (c >> 5), rr = r & 15, cc = c & 31, ob = rr * 64 + cc * 2; return st * 1024 + (ob ^ (((ob >> 9) & 1) << 5)); }
__host__ __device__ __forceinline__ void stage_rc(int b, int& R, int& C) { const int st = b / 1024, sb = b % 1024, swz = sb ^ (((sb >> 9) & 1) << 5); R = (st >> 1) * 16 + swz / 64; C = (st & 1) * 32 + (swz % 64) / 2; }
__host__ __device__ __forceinline__ int perm32(int rho) { const int n = rho >> 4, i = rho & 15; return 8 * (i >> 2) + 4 * n + (i & 3); }
struct Unit { int pm, pn, e; };

struct StaticOrder {
    int nM, nN, nwg, G, c; const char* A; const char* B; size_t tA, tB; const float* cs;
    __device__ __forceinline__ void init(int M, int N, int K, int G_, int c_, const void* A_, const void* B_, const float* cs_ = nullptr) { nM = M / BM; nN = N / BM; nwg = nM * nN; G = G_; c = c_; A = (const char*)A_; B = (const char*)B_; tA = (size_t)BM * K * 2; tB = tA; cs = cs_; }
    __device__ __forceinline__ const float* cs_ptr(const Unit&) const { return cs; }
    __device__ __forceinline__ bool next(int i, Unit& u) const {
        const long L = (long)i * G + c; if (L >= nwg) return false;
        int wgid = (int)L; { const int q = nwg / NXCD, r = nwg % NXCD, xcd = wgid % NXCD, off = wgid / NXCD; wgid = (xcd < r ? xcd * (q + 1) : r * (q + 1) + (xcd - r) * q) + off; }
        const int nig = WGM * nN, gid = wgid / nig, fm = gid * WGM, gsz = (nM - fm) < WGM ? (nM - fm) : WGM;
        u.pm = fm + ((wgid % nig) % gsz); u.pn = (wgid % nig) / gsz; u.e = 0; return true;
    }
    __device__ __forceinline__ const char* a_base(const Unit& u) const { return A + (size_t)u.pm * tA; }
    __device__ __forceinline__ const char* b_base(const Unit& u) const { return B + (size_t)u.pn * tB; }
    __device__ __forceinline__ int arow(const Unit&, int) const { return 0; }
};

struct MoeOrder {
    int nN, G, c; int P[9]; int cnt[8];
    const char* A; const char* B; size_t tA, tB, bstride; const int* list; bool gather; const float* cs; int cs_estride;
    __device__ __forceinline__ void init(const unsigned* gcnt, int N, int K, int G_, int c_, const void* A_, const void* B_, size_t bstride_, const int* list_, bool gather_, const float* cs_ = nullptr, int cs_estride_ = 0) {
        nN = N / BM; G = G_; c = c_; A = (const char*)A_; B = (const char*)B_; tA = (size_t)BM * K * 2; tB = tA; bstride = bstride_; list = list_; gather = gather_; cs = cs_; cs_estride = cs_estride_;
        P[0] = 0;
#pragma unroll
        for (int e = 0; e < 8; ++e) { int ce = (int)gcnt[64 * e]; ce = ce < 0 ? 0 : (ce > T ? T : ce); cnt[e] = ce; P[e + 1] = P[e] + (ce + 255) / 256; }
    }
    __device__ __forceinline__ bool next(int i, Unit& u) const {
        const long L = (long)i * G + c; if (L >= (long)P[8] * nN) return false;
        const int g = (int)(L / nN); u.pm = g; u.pn = (int)(L - (long)g * nN); int e = 0;
#pragma unroll
        for (int j = 1; j < 8; ++j) if (g >= P[j]) e = j;
        u.e = e; return true;
    }
    __device__ __forceinline__ const char* a_base(const Unit& u) const { return gather ? A : A + (size_t)u.pm * tA; }
    __device__ __forceinline__ const char* b_base(const Unit& u) const { return B + (size_t)u.e * bstride + (size_t)u.pn * tB; }
    __device__ __forceinline__ const float* cs_ptr(const Unit& u) const { return cs + (size_t)u.e * cs_estride; }
    __device__ __forceinline__ int arow(const Unit& u, int r) const {
        int Pe = 0, ce = 0;
#pragma unroll
        for (int j = 0; j < 8; ++j) if (u.e == j) { Pe = P[j]; ce = cnt[j]; }
        const int slot = (u.pm - Pe) * 256 + r;
        return slot < ce ? list[(size_t)u.e * T + slot] : 0;
    }
};

typedef int v4i32 __attribute__((ext_vector_type(4)));
template <int OPK> struct AccSel { typedef f32x4 T; };
template <> struct AccSel<2> { typedef v4i32g T; };
template <int OPK  > struct Frag;
template <> struct Frag<0> { bf16x8 k0, k1;
    __device__ __forceinline__ void load(const PG8_LAS unsigned char* p) { k0 = *(const PG8_LAS bf16x8*)p; k1 = *(const PG8_LAS bf16x8*)(p + 1024); }
    static __device__ __forceinline__ f32x4 mma(const Frag& b, const Frag& a, f32x4 c) { c = __builtin_amdgcn_mfma_f32_16x16x32_bf16(b.k0, a.k0, c, 0, 0, 0); return __builtin_amdgcn_mfma_f32_16x16x32_bf16(b.k1, a.k1, c, 0, 0, 0); } };
template <> struct Frag<2> { v4i32g k0, k1;
    __device__ __forceinline__ void load(const PG8_LAS unsigned char* p) { k0 = *(const PG8_LAS v4i32g*)p; k1 = *(const PG8_LAS v4i32g*)(p + 1024); }
    static __device__ __forceinline__ v4i32g mma(const Frag& b, const Frag& a, v4i32g c) { c = __builtin_amdgcn_mfma_i32_16x16x64_i8(b.k0, a.k0, c, 0, 0, 0); return __builtin_amdgcn_mfma_i32_16x16x64_i8(b.k1, a.k1, c, 0, 0, 0); } };
template <> struct Frag<1> { v8i32 v;
    __device__ __forceinline__ void load(const PG8_LAS unsigned char* p) { const v4i32 lo = *(const PG8_LAS v4i32*)p, hi = *(const PG8_LAS v4i32*)(p + 1024); v = __builtin_shufflevector(lo, hi, 0, 1, 2, 3, 4, 5, 6, 7); }
    static __device__ __forceinline__ f32x4 mma(const Frag& b, const Frag& a, f32x4 c) {
        const int one = 0x7f7f7f7f; asm volatile("v_mfma_scale_f32_16x16x128_f8f6f4 %0, %1, %2, %0, %3, %3 op_sel_hi:[0,0,0]" : "+v"(c) : "v"(b.v), "v"(a.v), "v"(one)); return c; } };
template <class Epi, class Sched, bool ALIGN_EPI, bool GATHER, int OPK = 0>
__device__ __forceinline__ void gemm_phase(PG8_LAS unsigned char* lds, const int K, const Sched& S, const Epi& E, const float* rs = nullptr) {
    const int tid = threadIdx.x, wid = __builtin_amdgcn_readfirstlane(tid >> 6), lane = tid & 63, wr = wid >> 2, wc = wid & 3, fr = lane & 15, fq = lane >> 4;
    const int nt = K / BK;
    int Rr[2], Cc[2]; unsigned voffB[2];
#pragma unroll
    for (int i = 0; i < 2; ++i) { int R, C; stage_rc(tid * 16 + i * 8192, R, C); Rr[i] = R; Cc[i] = C; const int Rb = Epi::PERM ? ((R & ~31) + perm32(R & 31)) : R; voffB[i] = (unsigned)(Rb * K + C) * 2u; }
    const size_t kstep = (size_t)(BK * 2);
    const size_t hstep = (size_t)HALF * K * 2;
    const unsigned ldsw = (unsigned)wid * 1024u;
    const int aoff = lds_byte(wr * 64 + fr, fq * 8), boff = lds_byte(wc * 32 + fr, fq * 8);
#define PG8_SA(b, h) (((b) * 2 + (h)) * HTB)
#define PG8_SB(b, h) ((4 + (b) * 2 + (h)) * HTB)
#define PG8_STAGE(bufoff, gbase, voff) do { _Pragma("unroll") for (int _i = 0; _i < 2; ++_i) \
        __builtin_amdgcn_global_load_lds((const unsigned*)((const char*)(gbase) + (voff)[_i]), (PG8_LAS unsigned*)(lds + (bufoff) + ldsw + _i * 8192), 16, 0, 0); } while (0)
#define PG8_LDA(dst, b, h) do { _Pragma("unroll") for (int m = 0; m < 4; ++m) dst[m].load(lds + PG8_SA(b, h) + aoff + m * 2048); } while (0)
#define PG8_LDB(dst, b, h) do { _Pragma("unroll") for (int n = 0; n < 2; ++n) dst[n].load(lds + PG8_SB(b, h) + boff + n * 2048); } while (0)
#define PG8_MMA(ai, bj, At, Bt) do { __builtin_amdgcn_s_setprio(1); _Pragma("unroll") for (int m = 0; m < 4; ++m) _Pragma("unroll") for (int n = 0; n < 2; ++n) \
        acc[ai][bj][m][n] = Frag<OPK>::mma(Bt[n], At[m], acc[ai][bj][m][n]); __builtin_amdgcn_s_setprio(0); } while (0)
#define PG8_WAIT_V(n) asm volatile("s_waitcnt vmcnt(" #n ")" ::: "memory")
#define PG8_WAIT_L(n) asm volatile("s_waitcnt lgkmcnt(" #n ")" ::: "memory")
#define PG8_BAR __builtin_amdgcn_s_barrier()
#define PG8_SCHED __builtin_amdgcn_sched_barrier(0)
#define PG8_VA(dst, u) do { _Pragma("unroll") for (int _h = 0; _h < 2; ++_h) _Pragma("unroll") for (int _i = 0; _i < 2; ++_i) \
        dst[_h][_i] = GATHER ? (unsigned)S.arow(u, _h * HALF + Rr[_i]) * (unsigned)(K * 2) + (unsigned)Cc[_i] * 2u : (unsigned)((_h * HALF + Rr[_i]) * K + Cc[_i]) * 2u; } while (0)
    Unit cur, nxt; int ui = 0;
    if (!S.next(0, cur)) return;
    typedef typename AccSel<OPK>::T AccT;
    AccT acc[2][2][4][2];
#pragma unroll
    for (int a = 0; a < 2; ++a)
#pragma unroll
        for (int b = 0; b < 2; ++b)
#pragma unroll
            for (int m = 0; m < 4; ++m)
#pragma unroll
                for (int n = 0; n < 2; ++n) acc[a][b][m][n] = AccT{};
    Frag<OPK> At[4], B0[2], B1[2];
    unsigned vA[2][2], vAn[2][2];
    PG8_VA(vA, cur);
#pragma unroll
    for (int h = 0; h < 2; ++h)
#pragma unroll
        for (int i = 0; i < 2; ++i) vAn[h][i] = vA[h][i];
    const char* cA = S.a_base(cur); const char* cB = S.b_base(cur);
    PG8_STAGE(PG8_SB(0, 0), cB, voffB); PG8_STAGE(PG8_SB(0, 1), cB + hstep, voffB); PG8_STAGE(PG8_SA(0, 0), cA, vA[0]); PG8_STAGE(PG8_SA(0, 1), cA, vA[1]);
    if (wr == 1) PG8_BAR;
    PG8_WAIT_V(2); PG8_BAR;
    PG8_STAGE(PG8_SB(1, 0), cB + kstep, voffB); PG8_STAGE(PG8_SA(1, 0), cA + kstep, vA[0]); PG8_STAGE(PG8_SB(1, 1), cB + hstep + kstep, voffB);
    PG8_WAIT_V(6); PG8_BAR;
    for (;;) {
        const bool has_next = S.next(ui + 1, nxt);
        const char* nA = has_next ? S.a_base(nxt) : cA; const char* nB = has_next ? S.b_base(nxt) : cB;
        if constexpr (GATHER) { if (has_next) { PG8_VA(vAn, nxt); } }
        for (int t = 0; t < nt; t += 2) {
            const bool last = (t == nt - 2);
            const char* a1 = cA + (size_t)(t + 1) * kstep;
            const char* a2 = last ? nA : cA + (size_t)(t + 2) * kstep; const char* b2 = last ? nB : cB + (size_t)(t + 2) * kstep;
            const char* a3 = a2 + kstep; const char* b3 = b2 + kstep;
            unsigned v2[2][2];
#pragma unroll
            for (int h = 0; h < 2; ++h)
#pragma unroll
                for (int i = 0; i < 2; ++i) v2[h][i] = (GATHER && last) ? vAn[h][i] : vA[h][i];
            PG8_LDB(B0, 0, 0); PG8_LDB(B1, 0, 1); PG8_SCHED; PG8_LDA(At, 0, 0); PG8_STAGE(PG8_SA(1, 1), a1, vA[1]);
            PG8_WAIT_V(8); PG8_WAIT_L(0); PG8_BAR; PG8_MMA(0, 0, At, B0); PG8_MMA(0, 1, At, B1); PG8_BAR; PG8_SCHED;
            PG8_LDA(At, 0, 1); PG8_STAGE(PG8_SB(0, 0), b2, voffB); PG8_STAGE(PG8_SB(0, 1), b2 + hstep, voffB); PG8_STAGE(PG8_SA(0, 0), a2, v2[0]);
            PG8_WAIT_V(8); PG8_WAIT_L(0); PG8_BAR; PG8_MMA(1, 0, At, B0); PG8_MMA(1, 1, At, B1); PG8_BAR; PG8_SCHED;
            PG8_LDB(B0, 1, 0); PG8_LDB(B1, 1, 1); PG8_SCHED; PG8_LDA(At, 1, 0); PG8_STAGE(PG8_SA(0, 1), a2, v2[1]);
            PG8_WAIT_V(8); PG8_WAIT_L(0); PG8_BAR; PG8_MMA(0, 0, At, B0); PG8_MMA(0, 1, At, B1); PG8_BAR; PG8_SCHED;
            PG8_LDA(At, 1, 1); PG8_STAGE(PG8_SB(1, 0), b3, voffB); PG8_STAGE(PG8_SB(1, 1), b3 + hstep, voffB); PG8_STAGE(PG8_SA(1, 0), a3, v2[0]);
            PG8_WAIT_V(8); PG8_WAIT_L(0); PG8_BAR; PG8_MMA(1, 0, At, B0); PG8_MMA(1, 1, At, B1); PG8_BAR; PG8_SCHED;
        }
        if constexpr (ALIGN_EPI) { if (wr == 0) PG8_BAR; }
        if constexpr (OPK == 2) {
            f32x4 accf[2][2][4][2]; const float* cs = S.cs_ptr(cur) + cur.pn * BM + wc * 32 + (Epi::PERM ? 8 * fq : 4 * fq);
            f32x4 csv[2][2]; float rsv[2][4];
#pragma unroll
            for (int bj = 0; bj < 2; ++bj)
#pragma unroll
                for (int n = 0; n < 2; ++n) csv[bj][n] = *(const f32x4*)(cs + bj * HALF + (Epi::PERM ? 4 * n : 16 * n));
#pragma unroll
            for (int ai = 0; ai < 2; ++ai)
#pragma unroll
                for (int m = 0; m < 4; ++m) { const int lr = ai * HALF + wr * 64 + m * 16 + fr; rsv[ai][m] = rs[GATHER ? S.arow(cur, lr) : cur.pm * BM + lr]; }
#pragma unroll
            for (int ai = 0; ai < 2; ++ai)
#pragma unroll
                for (int bj = 0; bj < 2; ++bj)
#pragma unroll
                    for (int m = 0; m < 4; ++m)
#pragma unroll
                        for (int n = 0; n < 2; ++n) { const v4i32g a = acc[ai][bj][m][n]; accf[ai][bj][m][n] = (f32x4){(float)a[0], (float)a[1], (float)a[2], (float)a[3]} * csv[bj][n] * rsv[ai][m]; }
            E(accf, cur, wr, wc, fr, fq);
        } else E(acc, cur, wr, wc, fr, fq);
        if (!has_next) break;
#pragma unroll
        for (int a = 0; a < 2; ++a)
#pragma unroll
            for (int b = 0; b < 2; ++b)
#pragma unroll
                for (int m = 0; m < 4; ++m)
#pragma unroll
                    for (int n = 0; n < 2; ++n) acc[a][b][m][n] = AccT{};
        cur = nxt; cA = nA; cB = nB; ++ui;
#pragma unroll
        for (int h = 0; h < 2; ++h)
#pragma unroll
            for (int i = 0; i < 2; ++i) vA[h][i] = vAn[h][i];
        if constexpr (ALIGN_EPI) { if (wr == 1) PG8_BAR; }
    }
    PG8_WAIT_V(0);
    if constexpr (!ALIGN_EPI) { if (wr == 0) PG8_BAR; }
    PG8_BAR;
#undef PG8_SA
#undef PG8_SB
#undef PG8_STAGE
#undef PG8_LDA
#undef PG8_LDB
#undef PG8_MMA
#undef PG8_WAIT_V
#undef PG8_WAIT_L
#undef PG8_BAR
#undef PG8_SCHED
#undef PG8_VA
}

template <int L> struct EpiQKV {
    static constexpr bool PERM = true;
    bf16* QKV; bf16* VT; bf16* VT2; const float* cs; PG8_LAS unsigned char* stg;
    __device__ __forceinline__ void operator()(const f32x4 (&acc)[2][2][4][2], const Unit& u, int wr, int wc, int fr, int fq) const {
        const int row0 = u.pm * BM + wr * 64 + fr, pn = u.pn;
        int kind = 0  , dst = 0; float sc = 1.f; bf16* vt = VT; int vnc = 0, vc0 = 0, vcs = 0;
        if (L == 0) {
            if (pn < 4) { kind = 0; dst = 256 * pn + wc * 32; sc = pn < 2 ? C2 : 1.f; }
            else if (pn < 6) { kind = 2; vt = VT; vnc = 512; vc0 = 256 * (pn - 4) + 32 * wc; vcs = 128; }
            else if (pn < 8) { kind = 1; dst = 1536 + (4 * (pn - 6) + wc) * 64; sc = C2; }
            else { if (wc < 2) { kind = 1; dst = 2048 + wc * 64; sc = 1.f; } else { kind = 2; vt = VT2; vnc = 128; vc0 = (wc - 2) * 32; vcs = 64; } }
        } else {
            if (pn < 4) { kind = 1; dst = (4 * pn + wc) * 64; sc = C2; }
            else if (pn == 4) { kind = 1; dst = 1024 + wc * 64; sc = 1.f; }
            else if (pn == 5) { kind = 2; vt = VT; vnc = 256; vc0 = 32 * wc; vcs = 128; }
            else if (pn < 8) { kind = 1; dst = 1536 + (4 * (pn - 6) + wc) * 64; sc = 1.f; }
            else { if (wc == 0) { kind = 1; dst = 2048; sc = 1.f; } else kind = 3; }
        }
        if (kind == 0) {
#pragma unroll
            for (int ai = 0; ai < 2; ++ai)
#pragma unroll
                for (int m = 0; m < 4; ++m) { bf16* rowp = QKV + (size_t)(row0 + ai * HALF + m * 16) * NQ + dst + 8 * fq;
#pragma unroll
                    for (int bj = 0; bj < 2; ++bj) { const f32x4 v0 = acc[ai][bj][m][0] * sc, v1 = acc[ai][bj][m][1] * sc;
                        u32x4 w; w.x = cvtpk(v0[0], v0[1]); w.y = cvtpk(v0[2], v0[3]); w.z = cvtpk(v1[0], v1[1]); w.w = cvtpk(v1[2], v1[3]);
                        *(u32x4*)(rowp + bj * HALF) = w; } }
        } else if (kind == 1) {
#pragma unroll
            for (int ai = 0; ai < 2; ++ai)
#pragma unroll
                for (int m = 0; m < 4; ++m) { const int r = row0 + ai * HALF + m * 16; const f32x4* cp = (const f32x4*)(cs + (size_t)r * 64 + 16 * fq);
                    const f32x4 t0 = cp[0], t1 = cp[1], t2 = cp[2], t3 = cp[3];
                    const f32x4 x1a = acc[ai][0][m][0], x1b = acc[ai][0][m][1], x2a = acc[ai][1][m][0], x2b = acc[ai][1][m][1];
                    float o1[8], o2[8];
                    o1[0] = x1a[0] * t0[0] - x2a[0] * t0[1]; o2[0] = x2a[0] * t0[0] + x1a[0] * t0[1];
                    o1[1] = x1a[1] * t0[2] - x2a[1] * t0[3]; o2[1] = x2a[1] * t0[2] + x1a[1] * t0[3];
                    o1[2] = x1a[2] * t1[0] - x2a[2] * t1[1]; o2[2] = x2a[2] * t1[0] + x1a[2] * t1[1];
                    o1[3] = x1a[3] * t1[2] - x2a[3] * t1[3]; o2[3] = x2a[3] * t1[2] + x1a[3] * t1[3];
                    o1[4] = x1b[0] * t2[0] - x2b[0] * t2[1]; o2[4] = x2b[0] * t2[0] + x1b[0] * t2[1];
                    o1[5] = x1b[1] * t2[2] - x2b[1] * t2[3]; o2[5] = x2b[1] * t2[2] + x1b[1] * t2[3];
                    o1[6] = x1b[2] * t3[0] - x2b[2] * t3[1]; o2[6] = x2b[2] * t3[0] + x1b[2] * t3[1];
                    o1[7] = x1b[3] * t3[2] - x2b[3] * t3[3]; o2[7] = x2b[3] * t3[2] + x1b[3] * t3[3];
                    bf16* rowp = QKV + (size_t)r * NQ + dst + 8 * fq;
                    u32x4 w; w.x = cvtpk(o1[0] * sc, o1[1] * sc); w.y = cvtpk(o1[2] * sc, o1[3] * sc); w.z = cvtpk(o1[4] * sc, o1[5] * sc); w.w = cvtpk(o1[6] * sc, o1[7] * sc);
                    *(u32x4*)(rowp) = w;
                    w.x = cvtpk(o2[0] * sc, o2[1] * sc); w.y = cvtpk(o2[2] * sc, o2[3] * sc); w.z = cvtpk(o2[4] * sc, o2[5] * sc); w.w = cvtpk(o2[6] * sc, o2[7] * sc);
                    *(u32x4*)(rowp + 32) = w; }
        } else if (kind == 2) {
            const int b = (u.pm * BM) / SEQ, s_tile = (u.pm * BM) % SEQ, lane = fq * 16 + fr;
            PG8_LAS unsigned char* sw = stg + (wr * 4 + wc) * VT_STAGE_WAVE;
#pragma unroll
            for (int ai = 0; ai < 2; ++ai)
#pragma unroll
                for (int bj = 0; bj < 2; ++bj)
#pragma unroll
                    for (int mp = 0; mp < 2; ++mp) {
#pragma unroll
                        for (int mm = 0; mm < 2; ++mm)
#pragma unroll
                            for (int n = 0; n < 2; ++n) { const f32x4 v = acc[ai][bj][2 * mp + mm][n]; const unsigned w0 = cvtpk(v[0], v[1]), w1 = cvtpk(v[2], v[3]);
                                PG8_LAS unsigned char* wp = sw + (8 * fq + 4 * n) * 80 + (16 * mm + fr) * 2;
                                *(PG8_LAS unsigned short*)(wp) = (unsigned short)w0; *(PG8_LAS unsigned short*)(wp + 80) = (unsigned short)(w0 >> 16);
                                *(PG8_LAS unsigned short*)(wp + 160) = (unsigned short)w1; *(PG8_LAS unsigned short*)(wp + 240) = (unsigned short)(w1 >> 16); }
#pragma unroll
                        for (int j = 0; j < 2; ++j) { const int colr = (lane >> 2) + 16 * j, seg = lane & 3;
                            const u32x4 v = *(const PG8_LAS u32x4*)(sw + colr * 80 + seg * 16);
                            *(u32x4*)(vt + ((size_t)b * vnc + vc0 + bj * vcs + colr) * SEQ + s_tile + ai * HALF + wr * 64 + mp * 32 + seg * 8) = v; }
                    }
        }
    }
};
template <bool FIRST> struct EpiResid {
    static constexpr bool PERM = true;
    const float* xin; bf16* XR; const float* gate; float oscale;
    __device__ __forceinline__ void operator()(const f32x4 (&acc)[2][2][4][2], const Unit& u, int wr, int wc, int fr, int fq) const {
        const int row0 = u.pm * BM + wr * 64 + fr, col0 = u.pn * BM + wc * 32 + 8 * fq; const int b = (u.pm * BM) / SEQ;
        f32x4 gv[2][2];
#pragma unroll
        for (int bj = 0; bj < 2; ++bj)
#pragma unroll
            for (int n = 0; n < 2; ++n) gv[bj][n] = *(const f32x4*)(gate + (size_t)b * 6144 + col0 + bj * HALF + 4 * n) * oscale;
#pragma unroll
        for (int ai = 0; ai < 2; ++ai)
#pragma unroll
            for (int m = 0; m < 4; ++m) { const size_t ro = (size_t)(row0 + ai * HALF + m * 16) * D + col0;
#pragma unroll
                for (int bj = 0; bj < 2; ++bj) { f32x4 b0, b1;
                    if (FIRST) { b0 = *(const f32x4*)(xin + ro + bj * HALF); b1 = *(const f32x4*)(xin + ro + bj * HALF + 4); }
                    else { const u32x4 w = *(const u32x4*)(XR + ro + bj * HALF); b0 = (f32x4){bflo(w.x), bfhi(w.x), bflo(w.y), bfhi(w.y)}; b1 = (f32x4){bflo(w.z), bfhi(w.z), bflo(w.w), bfhi(w.w)}; }
                    const f32x4 v0 = b0 + gv[bj][0] * acc[ai][bj][m][0], v1 = b1 + gv[bj][1] * acc[ai][bj][m][1];
                    u32x4 o; o.x = cvtpk(v0[0], v0[1]); o.y = cvtpk(v0[2], v0[3]); o.z = cvtpk(v1[0], v1[1]); o.w = cvtpk(v1[2], v1[3]);
                    *(u32x4*)(XR + ro + bj * HALF) = o; } }
    }
};
template <bool FP8OUT> struct EpiSwiGLU {
    static constexpr bool PERM = true;
    void* O; int ldc; float iscale;
    __device__ __forceinline__ void operator()(const f32x4 (&acc)[2][2][4][2], const Unit& u, int wr, int wc, int fr, int fq) const {
        const int row0 = u.pm * BM + wr * 64 + fr, col0 = u.pn * HALF + wc * 32 + 8 * fq;
#pragma unroll
        for (int ai = 0; ai < 2; ++ai)
#pragma unroll
            for (int m = 0; m < 4; ++m) { float v[8];
#pragma unroll
                for (int n = 0; n < 2; ++n)
#pragma unroll
                    for (int i = 0; i < 4; ++i) { const float g = acc[ai][0][m][n][i] * iscale, up = acc[ai][1][m][n][i] * iscale; v[4 * n + i] = g * __builtin_amdgcn_rcpf(1.f + __expf(-g)) * up; }
                if (FP8OUT) { const u32x2 w = (u32x2){pack4_fp8(v[0] * FP8_ACT_SCALE, v[1] * FP8_ACT_SCALE, v[2] * FP8_ACT_SCALE, v[3] * FP8_ACT_SCALE), pack4_fp8(v[4] * FP8_ACT_SCALE, v[5] * FP8_ACT_SCALE, v[6] * FP8_ACT_SCALE, v[7] * FP8_ACT_SCALE)};
                    *(u32x2*)((unsigned char*)O + (size_t)(row0 + ai * HALF + m * 16) * ldc + col0) = w; }
                else { u32x4 w; w.x = cvtpk(v[0], v[1]); w.y = cvtpk(v[2], v[3]); w.z = cvtpk(v[4], v[5]); w.w = cvtpk(v[6], v[7]);
                    *(u32x4*)((bf16*)O + (size_t)(row0 + ai * HALF + m * 16) * ldc + col0) = w; } }
    }
};
struct EpiBf16 {
    static constexpr bool PERM = true;
    bf16* O; int ldc; float oscale;
    __device__ __forceinline__ void operator()(const f32x4 (&acc)[2][2][4][2], const Unit& u, int wr, int wc, int fr, int fq) const {
        const int row0 = u.pm * BM + wr * 64 + fr, col0 = u.pn * BM + wc * 32 + 8 * fq;
#pragma unroll
        for (int ai = 0; ai < 2; ++ai)
#pragma unroll
            for (int m = 0; m < 4; ++m) { bf16* rowp = O + (size_t)(row0 + ai * HALF + m * 16) * ldc + col0;
#pragma unroll
                for (int bj = 0; bj < 2; ++bj) { const f32x4 v0 = acc[ai][bj][m][0] * oscale, v1 = acc[ai][bj][m][1] * oscale;
                    u32x4 w; w.x = cvtpk(v0[0], v0[1]); w.y = cvtpk(v0[2], v0[3]); w.z = cvtpk(v1[0], v1[1]); w.w = cvtpk(v1[2], v1[3]);
                    *(u32x4*)(rowp + bj * HALF) = w; } }
    }
};
}

#define XB_TMO      128
#define XB_XCNT(j)  (256  + 64 * (j))
#define XB_XSUB(j)  (1280 + 64 * (j))
#define XB_XGEN(j)  (2304 + 64 * (j))
#define XB_TOP      3328
#define XB_TOPGEN   3392
#define XCD_BAR_WORDS 3456
#define XB_SPIN_CAP (1u << 18)
__device__ __forceinline__ unsigned xb_ld(unsigned* p)              { return __hip_atomic_load(p, __ATOMIC_RELAXED, __HIP_MEMORY_SCOPE_AGENT); }
__device__ __forceinline__ unsigned xb_add(unsigned* p, unsigned v) { return __hip_atomic_fetch_add(p, v, __ATOMIC_RELAXED, __HIP_MEMORY_SCOPE_AGENT); }
__device__ __forceinline__ unsigned xb_xcc_id() { return (unsigned)__builtin_amdgcn_s_getreg((3 << 11) | 20) & 0xFu; }
#define XB_SPIN(cond, bar) do { unsigned _sp = 0; while (cond) { __builtin_amdgcn_s_sleep(1); \
    if ((++_sp & 255u) == 0u) { if (xb_ld(&(bar)[XB_TMO])) break; if (_sp > XB_SPIN_CAP) { atomicAdd(&(bar)[XB_TMO], 1u); break; } } } } while (0)
struct XcdBarrier { unsigned* bar; unsigned x; volatile LAS unsigned* st; };
__device__ __forceinline__ XcdBarrier xcd_barrier_post(unsigned* bar, volatile LAS unsigned* st) {
    XcdBarrier b; b.bar = bar; b.x = xb_xcc_id(); b.st = st;
    if (threadIdx.x == 0) (void)xb_add(&bar[XB_XCNT(b.x)], 1u);
    return b;
}
__device__ __forceinline__ void xcd_barrier_complete(unsigned* bar, unsigned x, unsigned& nloc, unsigned& nx) {
    const unsigned G = gridDim.x * gridDim.y * gridDim.z;
    unsigned sum, cnt, mine, sp = 0u;
    for (;;) {
        sum = 0u; cnt = 0u; mine = 0u;
#pragma unroll
        for (unsigned j = 0; j < 16; ++j) { const unsigned c = xb_ld(&bar[XB_XCNT(j)]); sum += c; cnt += (c > 0u) ? 1u : 0u; mine = (j == x) ? c : mine; }
        if (sum == G) break;
        __builtin_amdgcn_s_sleep(1);
        if ((++sp & 255u) == 0u) { if (xb_ld(&bar[XB_TMO])) break; if (sp > XB_SPIN_CAP) { atomicAdd(&bar[XB_TMO], 1u); break; } }
    }
    nloc = mine > 0u ? mine : 1u; nx = cnt > 0u ? cnt : 1u;
}
__device__ __forceinline__ void xcd_barrier(const XcdBarrier& b) {
    asm volatile("s_waitcnt vmcnt(0)" ::: "memory");
    __syncthreads();
    if (threadIdx.x == 0) {
        unsigned* bar = b.bar;
        __builtin_amdgcn_s_waitcnt(0);
        unsigned nloc = b.st[0], nx = b.st[1];
        if (nloc == 0u) { xcd_barrier_complete(bar, b.x, nloc, nx); b.st[0] = nloc; b.st[1] = nx; }
        const unsigned old = xb_add(&bar[XB_XSUB(b.x)], 1u);
        const unsigned gen = old / nloc;
        if (old + 1u == (gen + 1u) * nloc) {
            __builtin_amdgcn_fence(__ATOMIC_RELEASE, "agent");
            asm volatile("s_waitcnt vmcnt(0)" ::: "memory");
            const unsigned og = xb_add(&bar[XB_TOP], 1u);
            const unsigned tg = og / nx;
            if (og + 1u == (tg + 1u) * nx) xb_add(&bar[XB_TOPGEN], 1u);
            else XB_SPIN(xb_ld(&bar[XB_TOPGEN]) == tg, bar);
            __builtin_amdgcn_fence(__ATOMIC_ACQUIRE, "agent");
            xb_add(&bar[XB_XGEN(b.x)], 1u);
            asm volatile("s_waitcnt vmcnt(0)" ::: "memory");
        } else {
            XB_SPIN(xb_ld(&bar[XB_XGEN(b.x)]) == gen, bar);
            __builtin_amdgcn_fence(__ATOMIC_ACQUIRE, "agent");
            asm volatile("s_waitcnt vmcnt(0)" ::: "memory");
        }
    }
    __syncthreads();
}

#define DPP_MOV(v, CTRL) __int_as_float(__builtin_amdgcn_update_dpp(0, __float_as_int(v), (CTRL), 0xf, 0xf, true))
__device__ __forceinline__ float wave_sum(float v) {
    v += DPP_MOV(v, 0xB1); v += DPP_MOV(v, 0x4E); v += DPP_MOV(v, 0x141); v += DPP_MOV(v, 0x140);
    v += __shfl_xor(v, 16);
    auto rr = __builtin_amdgcn_permlane32_swap(__float_as_uint(v), __float_as_uint(v), false, false); return __uint_as_float(rr[0]) + __uint_as_float(rr[1]);
}
__device__ __forceinline__ float wave_max(float v) {
    v = fmaxf(v, DPP_MOV(v, 0xB1)); v = fmaxf(v, DPP_MOV(v, 0x4E)); v = fmaxf(v, DPP_MOV(v, 0x141)); v = fmaxf(v, DPP_MOV(v, 0x140));
    v = fmaxf(v, __shfl_xor(v, 16));
    auto rr = __builtin_amdgcn_permlane32_swap(__float_as_uint(v), __float_as_uint(v), false, false); return fmaxf(__uint_as_float(rr[0]), __uint_as_float(rr[1]));
}
__device__ __forceinline__ float swap_max(float v) { auto rr = __builtin_amdgcn_permlane32_swap(__float_as_uint(v), __float_as_uint(v), false, false); return fmaxf(__uint_as_float(rr[0]), __uint_as_float(rr[1])); }
__device__ __forceinline__ float swap_sum(float v) { auto rr = __builtin_amdgcn_permlane32_swap(__float_as_uint(v), __float_as_uint(v), false, false); return __uint_as_float(rr[0]) + __uint_as_float(rr[1]); }

__device__ __forceinline__ void sincos_d(double a, float& sn, float& cn) {
    const double k = __builtin_rint(a * 0.63661977236758134308);
    double r = __builtin_fma(-k, 1.57079632673412561417e+00, a);
    r = __builtin_fma(-k, 6.07710050650619224932e-11, r);
    r = __builtin_fma(-k, 2.02226624879595063154e-21, r);
    const double z = r * r;
    const double sp = r + r * z * (-1.66666666666666324348e-01 + z * (8.33333333332248946124e-03 + z * (-1.98412698298579493134e-04 + z * (2.75573137070700676789e-06 + z * (-2.50507602534068634195e-08 + z * 1.58969099521155010221e-10)))));
    const double cp = 1.0 - 0.5 * z + z * z * (4.16666666666666019037e-02 + z * (-1.38888888888741095749e-03 + z * (2.48015872894767294178e-05 + z * (-2.75573143513906633035e-07 + z * (2.08757232129817482790e-09 + z * -1.13596475577881948265e-11)))));
    const int q = ((int)k) & 3;
    const double s = (q == 0) ? sp : (q == 1) ? cp : (q == 2) ? -sp : -cp;
    const double c = (q == 0) ? cp : (q == 1) ? -sp : (q == 2) ? -cp : sp;
    sn = (float)s; cn = (float)c;
}

struct Args { const void* in[26]; float* out; unsigned char* ws; int ph_lo, ph_hi; };
struct Frame {
    LAS unsigned char* lds; unsigned* ctl; unsigned char* ws;
    int tid, lane, wave, G, blk;
};

__device__ __forceinline__ void conv_item(const float* W, int ld, int col0, bf16* WT, int K, int dstrow0, int k0, LAS float* scr, int lane) {
    if (col0 >= 0) {
#pragma unroll 8
        for (int i = 0; i < 32; ++i) { const int kk = 2 * i + (lane >> 5); scr[kk * 33 + (lane & 31)] = W[(size_t)(k0 + kk) * ld + col0 + (lane & 31)]; }
    } else {
#pragma unroll 8
        for (int i = 0; i < 32; ++i) { const int kk = 2 * i + (lane >> 5); scr[kk * 33 + (lane & 31)] = 0.f; }
    }
    asm volatile("s_waitcnt lgkmcnt(0)" ::: "memory");
    const int c = lane & 7;
#pragma unroll
    for (int j = 0; j < 4; ++j) { const int n = (lane >> 3) + 8 * j; const LAS float* s = scr + (8 * c) * 33 + n;
        u32x4 o; o.x = cvtpk(s[0 * 33], s[1 * 33]); o.y = cvtpk(s[2 * 33], s[3 * 33]); o.z = cvtpk(s[4 * 33], s[5 * 33]); o.w = cvtpk(s[6 * 33], s[7 * 33]);
        *(u32x4*)(WT + (size_t)(dstrow0 + n) * K + k0 + 8 * c) = o; }
    asm volatile("s_waitcnt lgkmcnt(0)" ::: "memory");
}
__device__ __forceinline__ void conv_item_fp8(const float* W, int ld, int col0, unsigned char* WT, int Kp, int dstrow0, int k0, LAS float* scr, int lane) {
#pragma unroll 8
    for (int i = 0; i < 32; ++i) { const int kk = 2 * i + (lane >> 5); scr[kk * 33 + (lane & 31)] = W[(size_t)(k0 + kk) * ld + col0 + (lane & 31)] * FP8_W_SCALE; }
    asm volatile("s_waitcnt lgkmcnt(0)" ::: "memory");
    const int c = lane & 7;
#pragma unroll
    for (int j = 0; j < 4; ++j) { const int n = (lane >> 3) + 8 * j; const LAS float* sp = scr + (8 * c) * 33 + n;
        const u32x2 o = (u32x2){pack4_fp8(sp[0 * 33], sp[1 * 33], sp[2 * 33], sp[3 * 33]), pack4_fp8(sp[4 * 33], sp[5 * 33], sp[6 * 33], sp[7 * 33])};
        *(u32x2*)(WT + (size_t)(dstrow0 + n) * Kp + k0 + 8 * c) = o; }
    asm volatile("s_waitcnt lgkmcnt(0)" ::: "memory");
}
__device__ __forceinline__ int map_win0(int n0) {
    const int pn = n0 >> 8, bj = (n0 >> 7) & 1, x = n0 & 127;
    if (pn < 6) return n0;
    if (pn < 8) return 1544 + (4 * (pn - 6) + (x >> 5)) * 64 + 32 * bj;
    return x < 64 ? 2056 + (x >> 5) * 64 + 32 * bj : 2184 + 64 * bj + (x - 64);
}
__device__ __forceinline__ int map_win1(int n0) {
    const int pn = n0 >> 8, bj = (n0 >> 7) & 1, x = n0 & 127;
    if (pn < 4) return (4 * pn + (x >> 5)) * 64 + 32 * bj;
    if (pn == 4) return 1024 + (x >> 5) * 64 + 32 * bj;
    if (pn == 5) return 1280 + 128 * bj + x;
    if (pn < 8) return 1536 + (4 * (pn - 6) + (x >> 5)) * 64 + 32 * bj;
    return x == 0 ? 2048 + 32 * bj : -1;
}

__device__ __forceinline__ void p0_prologue(Frame& F, const Args& a) {
    const float* c_in = (const float*)a.in[1]; const int* pos = (const int*)a.in[2];
    float* mod = (float*)(F.ws + WS_MOD);
    {
        LAS float* sl = (LAS float*)F.lds; LAS float* red = (LAS float*)(F.lds + 65536);
        bool have = false;
        for (int job = F.blk; job < 192; job += F.G) {
            if (!have) { for (int i = F.tid; i < 16 * 1024; i += 512) { const float c = c_in[i]; sl[i] = c / (1.f + __expf(-c)); } __syncthreads(); have = true; }
            const int l = job / 96, n0 = (job % 96) * 64;
            const float* W = (const float*)a.in[l == 0 ? 3 : 14] + n0 + F.lane; const float* bias = (const float*)a.in[l == 0 ? 4 : 15];
            float acc[16];
#pragma unroll
            for (int b = 0; b < 16; ++b) acc[b] = 0.f;
            const int kb = F.wave * 128;
#pragma unroll 4
            for (int k = 0; k < 128; ++k) { const float wv = W[(size_t)(kb + k) * 6144];
#pragma unroll
                for (int b = 0; b < 16; ++b) acc[b] += sl[b * 1024 + kb + k] * wv; }
#pragma unroll
            for (int b = 0; b < 16; ++b) red[(F.wave * 16 + b) * 64 + F.lane] = acc[b];
            __syncthreads();
            for (int i = F.tid; i < 16 * 64; i += 512) { const int b = i >> 6, ln = i & 63; float s = bias[n0 + ln];
#pragma unroll
                for (int w = 0; w < 8; ++w) s += red[(w * 16 + b) * 64 + ln];
                mod[((size_t)l * 16 + b) * 6144 + n0 + ln] = s; }
            __syncthreads();
        }
        __syncthreads();
    }
    {
        float* cs = (float*)(F.ws + WS_ROPE);
        for (int i = F.blk * 512 + F.tid; i < T * 32; i += F.G * 512) { const int t = i >> 5, f = i & 31;
            const float inv = exp2f(-(float)f * (13.287712379549449f / 32.f));
            const float ang = (float)pos[t] * inv; float sn, cn; sincos_d((double)ang, sn, cn);
            *(f32x2*)(cs + (size_t)i * 2) = (f32x2){cn, sn}; }
    }
    {
        LAS float* scr = (LAS float*)(F.lds + F.wave * 16384);
        const int gw = F.blk * 8 + F.wave, NGW = F.G * 8;
        constexpr int I1 = 16 * (NQ / 32), I2 = 16 * 32, I3 = 16 * (2 * FF / 32), I4 = (FF / 64) * 32, I7 = 16 * (2 * FFE / 32), I8 = (FFE / 64) * 32;
        constexpr int NITEMS = 2 * I2 + I4 + NE * I8;
        for (int it = gw; it < NITEMS; it += NGW) {
            int r = it;
            if (r < I2) { const int nb = r % 32, kb = r / 32; conv_item((const float*)a.in[10], D, 32 * nb, (bf16*)(F.ws + WS_WOUT0), D, 32 * nb, 64 * kb, scr, F.lane); continue; } r -= I2;
            if (r < I4) { const int nb = r % 32, kb = r / 32; conv_item_fp8((const float*)a.in[13], D, 32 * nb, F.ws + WS_WDN0, FF, 32 * nb, 64 * kb, scr, F.lane); continue; } r -= I4;
            if (r < I2) { const int nb = r % 32, kb = r / 32; conv_item((const float*)a.in[19], D, 32 * nb, (bf16*)(F.ws + WS_WOUT1), D, 32 * nb, 64 * kb, scr, F.lane); continue; } r -= I2;
            { const int e = r / I8; r -= e * I8; const int nb = r % 32, kb = r / 32;
                conv_item_fp8((const float*)a.in[24] + (size_t)e * FFE * D, D, 32 * nb, F.ws + WS_WDN1 + (size_t)e * D * FFEP, FFEP, 32 * nb, 64 * kb, scr, F.lane); }
        }
    }
}

struct QItem { const float* W; unsigned char* WT; int ld, col0, drow, k0, cs; };
__device__ __forceinline__ QItem q_item(int it, const Args& a, unsigned char* ws) {
    QItem q; const int kb = it & 15; int nb = it >> 4; q.k0 = 64 * kb; q.cs = 32 * nb;
    if (nb < 72) { q.W = (const float*)a.in[7]; q.ld = E_IN; q.col0 = map_win0(32 * nb); q.WT = ws + WS_WIN0; q.drow = 32 * nb; return q; } nb -= 72;
    if (nb < 176) { const int n0 = 32 * nb, pn = n0 >> 8, bj = (n0 >> 7) & 1, x = n0 & 127; q.W = (const float*)a.in[bj ? 12 : 11]; q.ld = FF; q.col0 = 128 * pn + x; q.WT = ws + WS_WGU0; q.drow = n0; return q; } nb -= 176;
    if (nb < 72) { q.W = (const float*)a.in[18]; q.ld = O_IN; q.col0 = map_win1(32 * nb); q.WT = ws + WS_WIN1; q.drow = 32 * nb; return q; } nb -= 72;
    { const int e = nb / 88; nb -= e * 88; const int n0 = 32 * nb, pn = n0 >> 8, bj = (n0 >> 7) & 1, x = n0 & 127;
      q.W = (const float*)a.in[bj ? 23 : 22] + (size_t)e * D * FFE; q.ld = FFE; q.col0 = 128 * pn + x; q.WT = ws + WS_WGU1 + (size_t)e * 2 * FFE * D; q.drow = n0; return q; }
}
__device__ __forceinline__ void q_strips(Frame& F, const Args& a) {
    LAS float* scr = (LAS float*)(F.lds + F.wave * 16384);
    LAS float* cmx = (LAS float*)(F.lds + VT_STAGE_OFF);
    float* cst = (float*)(F.ws + WS_CS);
    for (int st = F.blk; st < CS_END / 32; st += F.G) {
        const QItem q = q_item(st * 16, a, F.ws);
        float r[2][32]; float am = 0.f;
#pragma unroll
        for (int j = 0; j < 2; ++j) {
            if (q.col0 >= 0) { const float* wp = q.W + (size_t)(64 * (2 * F.wave + j) + (F.lane >> 5)) * q.ld + q.col0 + (F.lane & 31);
#pragma unroll
                for (int i = 0; i < 32; ++i) r[j][i] = wp[(size_t)(2 * i) * q.ld]; }
            else {
#pragma unroll
                for (int i = 0; i < 32; ++i) r[j][i] = 0.f; } }
#pragma unroll
        for (int j = 0; j < 2; ++j)
#pragma unroll
            for (int i = 0; i < 32; ++i) am = fmaxf(am, fabsf(r[j][i]));
        am = fmaxf(am, __shfl_xor(am, 32));
        if (F.lane < 32) cmx[F.wave * 32 + F.lane] = am;
        __syncthreads();
        am = cmx[F.lane & 31];
#pragma unroll
        for (int w = 1; w < 8; ++w) am = fmaxf(am, cmx[w * 32 + (F.lane & 31)]);
        const float inv = am > 0.f ? 127.f / am : 0.f;
        if (F.wave == 0 && F.lane < 32) cst[q.cs + F.lane] = am > 0.f ? am * (1.f / 127.f) : 1.f;
#pragma unroll
        for (int j = 0; j < 2; ++j) { const int k0 = 64 * (2 * F.wave + j);
#pragma unroll
            for (int i = 0; i < 32; ++i) scr[(2 * i + (F.lane >> 5)) * 33 + (F.lane & 31)] = rintf(r[j][i] * inv);
            asm volatile("s_waitcnt lgkmcnt(0)" ::: "memory");
            const int c = F.lane & 7;
#pragma unroll
            for (int jj = 0; jj < 4; ++jj) { const int n = (F.lane >> 3) + 8 * jj; const LAS float* sp = scr + (8 * c) * 33 + n;
                *(u32x2*)(q.WT + (size_t)(q.drow + n) * D + k0 + 8 * c) = (u32x2){pack4_i8(sp[0 * 33], sp[1 * 33], sp[2 * 33], sp[3 * 33]), pack4_i8(sp[4 * 33], sp[5 * 33], sp[6 * 33], sp[7 * 33])}; }
            asm volatile("s_waitcnt lgkmcnt(0)" ::: "memory"); }
        __syncthreads();
    }
}
__device__ __forceinline__ void zero_kpad(Frame& F, unsigned char* base, int rows) {
    constexpr int CH = (FFEP - FFE) / 16;
    for (int i = F.blk * 512 + F.tid; i < rows * CH; i += F.G * 512) { const int row = i / CH, ch = i % CH; *(u32x4*)(base + (size_t)row * FFEP + FFE + 16 * ch) = (u32x4){0u, 0u, 0u, 0u}; }
}
template <int SIDE  , bool SRC_BF16, int HOUT = 0  >
__device__ __forceinline__ void norm_phase(Frame& F, const void* src, const float* gamma, const float* modl, int sh_off, int sc_off, bf16* H,
                                           const float* Wside, int ldw, int wcol0, const float* bside, float* side_out) {
    const int rpb = T / F.G, row_lo = F.blk * rpb;
    LAS int* lcnt = (LAS int*)F.lds;
    LAS int* rinfo = (LAS int*)(F.lds + 256);
    if (SIDE == 3) { if (F.tid < 16) lcnt[F.tid] = 0; __syncthreads(); }
    float wreg[4][4][8];
    if (SIDE != 0) {
#pragma unroll
        for (int jj = 0; jj < 4; ++jj)
#pragma unroll
            for (int i = 0; i < 4; ++i) { const int k = 4 * F.lane + 256 * jj + i; const f32x4 w0 = *(const f32x4*)(Wside + (size_t)k * ldw + wcol0), w1 = *(const f32x4*)(Wside + (size_t)k * ldw + wcol0 + 4);
                wreg[jj][i][0] = w0[0]; wreg[jj][i][1] = w0[1]; wreg[jj][i][2] = w0[2]; wreg[jj][i][3] = w0[3]; wreg[jj][i][4] = w1[0]; wreg[jj][i][5] = w1[1]; wreg[jj][i][6] = w1[2]; wreg[jj][i][7] = w1[3]; }
    }
    f32x4 gm[4], av[4], shv[4];
#pragma unroll
    for (int jj = 0; jj < 4; ++jj) gm[jj] = *(const f32x4*)(gamma + 4 * F.lane + 256 * jj);
    int curb = -1;
    for (int lr = F.wave; lr < rpb; lr += 8) {
        const int row = row_lo + lr, b = row / SEQ;
        if (b != curb) { curb = b;
#pragma unroll
            for (int jj = 0; jj < 4; ++jj) { const f32x4 scv = *(const f32x4*)(modl + (size_t)b * 6144 + sc_off + 4 * F.lane + 256 * jj); shv[jj] = *(const f32x4*)(modl + (size_t)b * 6144 + sh_off + 4 * F.lane + 256 * jj); av[jj] = gm[jj] * (scv + 1.f); } }
        f32x4 v[4]; float ss = 0.f;
#pragma unroll
        for (int jj = 0; jj < 4; ++jj) {
            if (SRC_BF16) { const u32x2 w = ((const u32x2*)((const bf16*)src + (size_t)row * D) + F.lane)[64 * jj]; v[jj] = (f32x4){bflo(w.x), bfhi(w.x), bflo(w.y), bfhi(w.y)}; }
            else v[jj] = ((const f32x4*)((const float*)src + (size_t)row * D) + F.lane)[64 * jj];
            ss += (v[jj][0] * v[jj][0] + v[jj][1] * v[jj][1]) + (v[jj][2] * v[jj][2] + v[jj][3] * v[jj][3]); }
        const float rstd = rsqrtf(wave_sum(ss) * (1.f / D) + NORM_EPS);
        u32x2* o8 = (u32x2*)(H + (size_t)row * D) + F.lane;
#pragma unroll
        for (int jj = 0; jj < 4; ++jj) { v[jj] = v[jj] * rstd * av[jj] + shv[jj];
            if (HOUT == 1) ((unsigned*)((unsigned char*)H + (size_t)row * D) + F.lane)[64 * jj] = pack4_fp8(v[jj][0] * FP8_H_SCALE, v[jj][1] * FP8_H_SCALE, v[jj][2] * FP8_H_SCALE, v[jj][3] * FP8_H_SCALE);
            else if (HOUT == 0) o8[64 * jj] = (u32x2){cvtpk(v[jj][0], v[jj][1]), cvtpk(v[jj][2], v[jj][3])}; }
        if (HOUT == 2) {
            float am = 0.f;
#pragma unroll
            for (int jj = 0; jj < 4; ++jj) am = fmaxf(fmaxf(am, fmaxf(fabsf(v[jj][0]), fabsf(v[jj][1]))), fmaxf(fabsf(v[jj][2]), fabsf(v[jj][3])));
            am = wave_max(am);
            const float inv = am > 0.f ? 127.f / am : 0.f;
#pragma unroll
            for (int jj = 0; jj < 4; ++jj) ((unsigned*)((unsigned char*)H + (size_t)row * D) + F.lane)[64 * jj] = pack4_i8(rintf(v[jj][0] * inv), rintf(v[jj][1] * inv), rintf(v[jj][2] * inv), rintf(v[jj][3] * inv));
            if (F.lane == 0) ((float*)(F.ws + WS_RS))[row] = am > 0.f ? am * (1.f / 127.f) : 1.f;
        }
        if (SIDE != 0) {
            float s[8];
#pragma unroll
            for (int j = 0; j < 8; ++j) { float t = 0.f;
#pragma unroll
                for (int jj = 0; jj < 4; ++jj)
#pragma unroll
                    for (int i = 0; i < 4; ++i) t += v[jj][i] * wreg[jj][i][j];
                s[j] = wave_sum(t); }
            if (SIDE == 1 || SIDE == 2) {
                float mine = 0.f;
#pragma unroll
                for (int j = 0; j < 8; ++j) if (F.lane == j) mine = s[j];
                if (F.lane < 8) {
                    if (SIDE == 1) { const float z = mine + bside[F.lane]; mine = z < 0.f ? z - log1pf(__expf(z)) : -log1pf(__expf(-z)); }
                    else mine *= 0.04419417382415922f;
                    side_out[(size_t)row * 8 + F.lane] = mine; }
            } else {
                float l1 = -INFINITY, l2 = -INFINITY; int e1 = 0, e2 = 0;
#pragma unroll
                for (int j = 0; j < 8; ++j) { const float lg = s[j] + bside[j]; if (lg > l1) { l2 = l1; e2 = e1; l1 = lg; e1 = j; } else if (lg > l2) { l2 = lg; e2 = j; } }
                const float g1 = 1.f / (1.f + __expf(l2 - l1));
                if (F.lane == 0) { const int sl1 = atomicAdd((int*)&lcnt[e1], 1), sl2 = atomicAdd((int*)&lcnt[e2], 1);
                    LAS int* ri = rinfo + lr * 8; ri[0] = e1; ri[1] = e2; ri[2] = sl1; ri[3] = sl2; ri[4] = (int)__float_as_uint(g1); }
            }
        }
    }
    if (SIDE == 3) {
        __syncthreads();
        if (F.tid < 8) lcnt[8 + F.tid] = (int)__hip_atomic_fetch_add(F.ctl + CW_CNT + 64 * F.tid, (unsigned)lcnt[F.tid], __ATOMIC_RELAXED, __HIP_MEMORY_SCOPE_AGENT);
        __syncthreads();
        int* list = (int*)(F.ws + WS_LIST); u32x4* tok = (u32x4*)(F.ws + WS_TOK);
        for (int lr = F.tid; lr < rpb; lr += 512) { const LAS int* ri = rinfo + lr * 8; const int e1 = ri[0], e2 = ri[1]; const int s1 = lcnt[8 + e1] + ri[2], s2 = lcnt[8 + e2] + ri[3]; const int row = row_lo + lr;
            list[(size_t)e1 * T + s1] = row; list[(size_t)e2 * T + s2] = row;
            tok[row] = (u32x4){(unsigned)(e1 | (e2 << 8)), (unsigned)s1, (unsigned)s2, (unsigned)ri[4]}; }
        __syncthreads();
    }
}

__device__ __forceinline__ void cumsum_kaug(Frame& F) {
    const int gw = F.blk * 8 + F.wave;
    if (gw >= BATCH * 8) return;
    const int b = gw >> 3, h = gw & 7;
    const float* lf = (const float*)(F.ws + WS_LOGF) + (size_t)b * SEQ * 8 + h;
    float v[32]; float run = 0.f;
#pragma unroll
    for (int i = 0; i < 32; ++i) { run += lf[(size_t)(32 * F.lane + i) * 8]; v[i] = run; }
    float incl = run;
#pragma unroll
    for (int o = 1; o < 64; o <<= 1) { const float t = __shfl_up(incl, o); if (F.lane >= o) incl += t; }
    const float excl = incl - run;
    u32x4* ka = (u32x4*)(F.ws + WS_KAUG) + (size_t)gw * SEQ + 32 * F.lane;
#pragma unroll
    for (int i = 0; i < 32; ++i) { const float bias = -(excl + v[i]) * 1.4426950408889634f;
        const unsigned h1 = cvtpk(bias, 0.f) & 0xffffu; const float r1 = bias - bflo(h1);
        const unsigned h2 = cvtpk(r1, 0.f) & 0xffffu; const float r2 = r1 - bflo(h2);
        const unsigned h3 = cvtpk(r2, 0.f) & 0xffffu;
        ka[i] = (u32x4){h1 | (h2 << 16), h3, 0u, 0u}; }
}

constexpr int ATT_BUF = 17408;
struct AttnP { const bf16* Kg; const bf16* VTg; const u32x4* kaug; const bf16* Qp; bf16* Op; int q0, tw_lo, tw_hi, T_lo, T_hi; float sink; const unsigned long long* mb; };
template <int MODE  >
__device__ __forceinline__ void attn_unit(LAS unsigned char* lds, const int wave, const int lane, const AttnP& U, const bool pre, const bool has_next, const AttnP& N,
                                          int& bsel, bf16x8 (&qcar)[4], unsigned& wcl, unsigned& wch) {
    const bf16* __restrict__ Kg = U.Kg; const bf16* __restrict__ VTg = U.VTg; const u32x4* __restrict__ kaug_g = U.kaug; const bf16* __restrict__ Qp = U.Qp; bf16* __restrict__ Op = U.Op;
    const int q0 = U.q0, tw_lo = U.tw_lo, tw_hi = U.tw_hi, T_lo = U.T_lo, T_hi = U.T_hi; const float sinkl2 = U.sink; const unsigned long long* __restrict__ mb = U.mb;
    const int r32 = lane & 31, hi = lane >> 5;
    bf16x8 qf[4];
    if (pre) {
#pragma unroll
        for (int d0 = 0; d0 < 4; ++d0) qf[d0] = qcar[d0];
    } else {
#pragma unroll
        for (int d0 = 0; d0 < 4; ++d0) qf[d0] = *(const bf16x8*)(Qp + (size_t)r32 * NQ + d0 * 16 + hi * 8); }
    const int kr = (r32 & ~12) | ((r32 & 4) << 1) | ((r32 & 8) >> 1);
    const int ksw = (kr >> 1) & 7, vsw = (r32 >> 1) & 7;
    int koff[4], voff[2][2];
#pragma unroll
    for (int d0 = 0; d0 < 4; ++d0) koff[d0] = kr * 128 + (((2 * d0 + hi) ^ ksw) << 4);
#pragma unroll
    for (int hf = 0; hf < 2; ++hf)
#pragma unroll
        for (int s = 0; s < 2; ++s) voff[hf][s] = 8192 + r32 * 128 + (((4 * hf + 2 * s + hi) ^ vsw) << 4);
    const int kaoff = 16384 + kr * 16;
    const int drow = 8 * wave + (lane >> 3), dc = (lane & 7) ^ ((drow >> 1) & 7);
    const bf16* ksrc = Kg + (size_t)drow * NQ + dc * 8;
    const bf16* vsrc = VTg + (size_t)drow * SEQ + dc * 8;
#define ATT_DMA(t, b) do { \
        __builtin_amdgcn_global_load_lds((const unsigned*)(ksrc + (size_t)(t) * 64 * NQ), (LAS unsigned*)(lds + (b) * ATT_BUF + wave * 1024), 16, 0, 0); \
        __builtin_amdgcn_global_load_lds((const unsigned*)(vsrc + (t) * 64), (LAS unsigned*)(lds + (b) * ATT_BUF + 8192 + wave * 1024), 16, 0, 0); \
        if (MODE == 0) { if (wave == 0) __builtin_amdgcn_global_load_lds((const unsigned*)(kaug_g + (t) * 64 + lane), (LAS unsigned*)(lds + (b) * ATT_BUF + 16384), 16, 0, 0); } } while (0)
    bf16x8 qaug = (bf16x8){0, 0, 0, 0, 0, 0, 0, 0};
    if (MODE == 0 && hi == 0) { qaug[0] = (short)0x3F80; qaug[1] = (short)0x3F80; qaug[2] = (short)0x3F80; }
    f32x16 o0, o1;
#pragma unroll
    for (int r = 0; r < 16; ++r) { o0[r] = 0.f; o1[r] = 0.f; }
    float m = (MODE == 1) ? sinkl2 : 0.f, l = (MODE == 1 && hi == 0) ? 1.f : 0.f;
    f32x16 negm;
#pragma unroll
    for (int r = 0; r < 16; ++r) negm[r] = -m;
    const int q = q0 + r32;
    unsigned long long wn = 0ull;
    if (pre) wn = ((unsigned long long)wch << 32) | wcl;
    else {
        asm volatile("" ::: "memory"); __builtin_amdgcn_s_barrier(); asm volatile("" ::: "memory");
        ATT_DMA(T_lo, bsel);
        if (MODE == 2) wn = mb[(size_t)r32 * 32 + T_lo];
    }
    for (int t = T_lo; t < T_hi; ++t) {
        const int buf = (t - T_lo + bsel) & 1;
        asm volatile("s_waitcnt vmcnt(0)" ::: "memory"); __builtin_amdgcn_s_barrier(); asm volatile("" ::: "memory");
        const unsigned long long w = wn;
        if (t + 1 < T_hi) { ATT_DMA(t + 1, buf ^ 1); if (MODE == 2) wn = mb[(size_t)r32 * 32 + t + 1]; }
        else if (has_next) {
            const bf16* nks = N.Kg + (size_t)drow * NQ + dc * 8; const bf16* nvs = N.VTg + (size_t)drow * SEQ + dc * 8;
            __builtin_amdgcn_global_load_lds((const unsigned*)(nks + (size_t)N.T_lo * 64 * NQ), (LAS unsigned*)(lds + (buf ^ 1) * ATT_BUF + wave * 1024), 16, 0, 0);
            __builtin_amdgcn_global_load_lds((const unsigned*)(nvs + N.T_lo * 64), (LAS unsigned*)(lds + (buf ^ 1) * ATT_BUF + 8192 + wave * 1024), 16, 0, 0);
            if (MODE == 0) { if (wave == 0) __builtin_amdgcn_global_load_lds((const unsigned*)(N.kaug + N.T_lo * 64 + lane), (LAS unsigned*)(lds + (buf ^ 1) * ATT_BUF + 16384), 16, 0, 0); }
            if (MODE == 2) { const unsigned long long wv = N.mb[(size_t)r32 * 32 + N.T_lo]; wcl = (unsigned)wv; wch = (unsigned)(wv >> 32); }
#pragma unroll
            for (int d0 = 0; d0 < 4; ++d0) qcar[d0] = *(const bf16x8*)(N.Qp + (size_t)r32 * NQ + d0 * 16 + hi * 8);
        }
        if (t < tw_lo || t >= tw_hi) continue;
        const int key0 = t * 64;
        const LAS unsigned char* tb = lds + buf * ATT_BUF;
        f32x16 p0, p1;
#pragma unroll
        for (int d0 = 0; d0 < 4; ++d0) { const bf16x8 k0 = *(const LAS bf16x8*)(tb + koff[d0]), k1 = *(const LAS bf16x8*)(tb + 4096 + koff[d0]);
            p0 = __builtin_amdgcn_mfma_f32_32x32x16_bf16(k0, qf[d0], d0 == 0 ? negm : p0, 0, 0, 0); p1 = __builtin_amdgcn_mfma_f32_32x32x16_bf16(k1, qf[d0], d0 == 0 ? negm : p1, 0, 0, 0); }
        if (MODE == 0) { const bf16x8 a0 = *(const LAS bf16x8*)(tb + kaoff), a1 = *(const LAS bf16x8*)(tb + kaoff + 512);
            p0 = __builtin_amdgcn_mfma_f32_32x32x16_bf16(a0, qaug, p0, 0, 0, 0); p1 = __builtin_amdgcn_mfma_f32_32x32x16_bf16(a1, qaug, p1, 0, 0, 0); }
        bf16x8 vf[2][2][2];
#pragma unroll
        for (int dt = 0; dt < 2; ++dt)
#pragma unroll
            for (int hf = 0; hf < 2; ++hf)
#pragma unroll
                for (int s = 0; s < 2; ++s) vf[dt][hf][s] = *(const LAS bf16x8*)(tb + dt * 4096 + voff[hf][s]);
        if (MODE == 0) { if (key0 + 63 > q0) {
#pragma unroll
            for (int r = 0; r < 16; ++r) { const int key = key0 + 16 * (r >> 3) + 8 * hi + (r & 7); if (key > q) p0[r] = -1e30f; if (key + 32 > q) p1[r] = -1e30f; } } }
        if (MODE == 1) {
#pragma unroll
            for (int r = 0; r < 16; ++r) { const int key = key0 + 16 * (r >> 3) + 8 * hi + (r & 7); if (key > q || key <= q - 128) p0[r] = -1e30f; if (key + 32 > q || key + 32 <= q - 128) p1[r] = -1e30f; } }
        float mx = fmaxf(fmaxf(p0[0], p1[0]), p0[1]);
#pragma unroll
        for (int r = 1; r < 16; ++r) mx = fmaxf(fmaxf(mx, p1[r]), r + 1 < 16 ? p0[r + 1] : p1[r]);
        mx = swap_max(mx);
        if (__any(mx > 8.f)) {
            const float dl = fmaxf(mx, 0.f); const float f = __builtin_amdgcn_exp2f(-dl); m += dl; l *= f;
#pragma unroll
            for (int r = 0; r < 16; ++r) { o0[r] *= f; o1[r] *= f; p0[r] -= dl; p1[r] -= dl; negm[r] = -m; }
        }
#pragma unroll
        for (int r = 0; r < 16; ++r) { p0[r] = __builtin_amdgcn_exp2f(p0[r]); p1[r] = __builtin_amdgcn_exp2f(p1[r]); }
        if (MODE == 2) {
            const unsigned wlo = (unsigned)w >> (8 * hi), whi = (unsigned)(w >> 32) >> (8 * hi);
#pragma unroll
            for (int r = 0; r < 16; ++r) { const int bit = 16 * (r >> 3) + (r & 7); int m0, m1;
                asm("v_bfe_i32 %0, %1, %2, 1" : "=v"(m0) : "v"(wlo), "n"(bit)); asm("v_bfe_i32 %0, %1, %2, 1" : "=v"(m1) : "v"(whi), "n"(bit));
                p0[r] = __uint_as_float(__float_as_uint(p0[r]) & (unsigned)m0); p1[r] = __uint_as_float(__float_as_uint(p1[r]) & (unsigned)m1); }
        }
        float ls = 0.f;
#pragma unroll
        for (int r = 0; r < 16; ++r) ls += p0[r] + p1[r];
        l += ls;
        bf16x8 pb[2][2];
#pragma unroll
        for (int s = 0; s < 2; ++s) {
            u32x4 a, b2;
            a.x = cvtpk(p0[8 * s + 0], p0[8 * s + 1]); a.y = cvtpk(p0[8 * s + 2], p0[8 * s + 3]); a.z = cvtpk(p0[8 * s + 4], p0[8 * s + 5]); a.w = cvtpk(p0[8 * s + 6], p0[8 * s + 7]);
            b2.x = cvtpk(p1[8 * s + 0], p1[8 * s + 1]); b2.y = cvtpk(p1[8 * s + 2], p1[8 * s + 3]); b2.z = cvtpk(p1[8 * s + 4], p1[8 * s + 5]); b2.w = cvtpk(p1[8 * s + 6], p1[8 * s + 7]);
            pb[0][s] = __builtin_bit_cast(bf16x8, a); pb[1][s] = __builtin_bit_cast(bf16x8, b2); }
#pragma unroll
        for (int hf = 0; hf < 2; ++hf)
#pragma unroll
            for (int s = 0; s < 2; ++s) { o0 = __builtin_amdgcn_mfma_f32_32x32x16_bf16(vf[0][hf][s], pb[hf][s], o0, 0, 0, 0); o1 = __builtin_amdgcn_mfma_f32_32x32x16_bf16(vf[1][hf][s], pb[hf][s], o1, 0, 0, 0); }
    }
#undef ATT_DMA
    bsel = (T_hi - T_lo + bsel) & 1;
    l = swap_sum(l);
    const float inv = 1.f / l;
    bf16* orow = Op + (size_t)r32 * D + 4 * hi;
#pragma unroll
    for (int g = 0; g < 4; ++g) {
        *(u32x2*)(orow + 8 * g) = (u32x2){cvtpk(o0[4 * g] * inv, o0[4 * g + 1] * inv), cvtpk(o0[4 * g + 2] * inv, o0[4 * g + 3] * inv)};
        *(u32x2*)(orow + 32 + 8 * g) = (u32x2){cvtpk(o1[4 * g] * inv, o1[4 * g + 1] * inv), cvtpk(o1[4 * g + 2] * inv, o1[4 * g + 3] * inv)}; }
}

__device__ __forceinline__ void attn0_phase(Frame& F, const float* sinks) {
    const bf16* QKV = (const bf16*)(F.ws + WS_QKV); bf16* MIX = (bf16*)(F.ws + WS_MIX);
    const bf16* VTF = (const bf16*)(F.ws + WS_VT); const bf16* VTS = (const bf16*)(F.ws + WS_VT_SWA);
    const u32x4* KA = (const u32x4*)(F.ws + WS_KAUG);
    int bsel = 0; bf16x8 qcar[4]; unsigned wcl = 0u, wch = 0u;
#pragma unroll
    for (int d0 = 0; d0 < 4; ++d0) qcar[d0] = (bf16x8){0, 0, 0, 0, 0, 0, 0, 0};
#define FOX_P(P, idx_) do { const int bh = (idx_) & 127, jn = (idx_) >> 7, itp = jn >> 1, base = 2 * (itp >> 1) + (jn & 1), qb = (itp & 1) ? 7 - base : base; \
        const int b = bh >> 3, h = bh & 7, q0 = 256 * qb + 32 * F.wave; \
        P = AttnP{QKV + (size_t)(b * SEQ) * NQ + 512 + h * 64, VTF + (size_t)(b * 512 + h * 64) * SEQ, KA + (size_t)bh * SEQ, QKV + (size_t)(b * SEQ + q0) * NQ + h * 64, \
                  MIX + (size_t)(b * SEQ + q0) * D + h * 64, q0, 0, (q0 + 32 + 63) / 64, 0, 4 * qb + 4, 0.f, nullptr}; } while (0)
    { const int NU = BATCH * 8 * 8;
      if (F.blk < NU) { AttnP cur, nxt; bool pre = false; FOX_P(cur, F.blk); nxt = cur;
        for (int idx = F.blk; idx < NU; idx += F.G) { const bool hn = idx + F.G < NU; if (hn) FOX_P(nxt, idx + F.G);
            attn_unit<0>(F.lds, F.wave, F.lane, cur, pre, hn, nxt, bsel, qcar, wcl, wch); cur = nxt; pre = hn; } } }
#undef FOX_P
#define SWA_P(P, idx_) do { const int b = ((idx_) & 31) >> 1, kvh = (idx_) & 1, qp = (idx_) >> 5, h = kvh * 4 + (F.wave & 3), q0 = 64 * qp + 32 * (F.wave >> 2); \
        const int lo = q0 - 127, tw_lo = lo > 0 ? lo / 64 : 0, Lo = 64 * qp - 127, T_lo = Lo > 0 ? Lo / 64 : 0; \
        P = AttnP{QKV + (size_t)(b * SEQ) * NQ + 2048 + kvh * 64, VTS + (size_t)(b * 128 + kvh * 64) * SEQ, nullptr, QKV + (size_t)(b * SEQ + q0) * NQ + 1536 + h * 64, \
                  MIX + (size_t)(b * SEQ + q0) * D + 512 + h * 64, q0, tw_lo, (q0 + 32 + 63) / 64, T_lo, qp + 1, sinks[h] * 1.4426950408889634f, nullptr}; } while (0)
    { const int NU = BATCH * 2 * 32;
      if (F.blk < NU) { AttnP cur, nxt; bool pre = false; SWA_P(cur, F.blk); nxt = cur;
        for (int idx = F.blk; idx < NU; idx += F.G) { const bool hn = idx + F.G < NU; if (hn) SWA_P(nxt, idx + F.G);
            attn_unit<1>(F.lds, F.wave, F.lane, cur, pre, hn, nxt, bsel, qcar, wcl, wch); cur = nxt; pre = hn; } } }
#undef SWA_P
}
__device__ __forceinline__ void attn1_phase(Frame& F) {
    const bf16* QKV = (const bf16*)(F.ws + WS_QKV); bf16* MIX = (bf16*)(F.ws + WS_MIX);
    const bf16* VTD = (const bf16*)(F.ws + WS_VT); const unsigned long long* MB = (const unsigned long long*)(F.ws + WS_MASK);
    int bsel = 0; bf16x8 qcar[4]; unsigned wcl = 0u, wch = 0u;
#pragma unroll
    for (int d0 = 0; d0 < 4; ++d0) qcar[d0] = (bf16x8){0, 0, 0, 0, 0, 0, 0, 0};
#define DSA_P(P, idx_) do { const int b = ((idx_) & 63) >> 2, kvh = (idx_) & 3, jn = (idx_) >> 6, h3 = jn >> 2, a2 = jn & 3; \
        const int qp = 4 * ((h3 & 1) ? 7 - (h3 >> 1) : (h3 >> 1)) + ((h3 & 1) ? 3 - a2 : a2), h = kvh * 4 + (F.wave & 3), q0 = 64 * qp + 32 * (F.wave >> 2); \
        P = AttnP{QKV + (size_t)(b * SEQ) * NQ + 1024 + kvh * 64, VTD + (size_t)(b * 256 + kvh * 64) * SEQ, nullptr, QKV + (size_t)(b * SEQ + q0) * NQ + h * 64, \
                  MIX + (size_t)(b * SEQ + q0) * D + h * 64, q0, 0, qp + 1, 0, qp + 1, 0.f, MB + (size_t)(b * SEQ + q0) * 32}; } while (0)
    { const int NU = BATCH * 4 * 32;
      if (F.blk < NU) { AttnP cur, nxt; bool pre = false; DSA_P(cur, F.blk); nxt = cur;
        for (int idx = F.blk; idx < NU; idx += F.G) { const bool hn = idx + F.G < NU; if (hn) DSA_P(nxt, idx + F.G);
            attn_unit<2>(F.lds, F.wave, F.lane, cur, pre, hn, nxt, bsel, qcar, wcl, wch); cur = nxt; pre = hn; } } }
#undef DSA_P
}

#define WRLANE(dst, val, LANE) asm("s_nop 1\n\tv_writelane_b32 %0, %1, %2" : "+v"(dst) : "s"(val), "n"(LANE))
template <int NR>
__device__ __forceinline__ unsigned select_query(const LAS float* srow_in, LAS unsigned* hist, const int q, const int lane_in, unsigned& Tprev) {
    unsigned myword = 0u;
    int lane = lane_in; asm volatile("" : "+v"(lane));
    const LAS float* srow = srow_in; asm volatile("" : "+v"(srow));
    unsigned ky[NR];
#pragma unroll
    for (int i = 0; i < NR; ++i) { const unsigned bits = __float_as_uint(srow[64 * i]); const unsigned key = (bits & 0x80000000u) ? ~bits : (bits | 0x80000000u); ky[i] = (lane <= q - 64 * i) ? key : 0u; }
#define SEL_COUNT(dst, thr) do { int c0_ = 0, c1_ = 0, c2_ = 0, c3_ = 0; \
        _Pragma("unroll") for (int i = 0; i < NR; i += 4) { c0_ += __popcll(__ballot(ky[i] >= (thr))); c1_ += __popcll(__ballot(ky[i + 1] >= (thr))); c2_ += __popcll(__ballot(ky[i + 2] >= (thr))); c3_ += __popcll(__ballot(ky[i + 3] >= (thr))); } \
        dst = (c0_ + c1_) + (c2_ + c3_); } while (0)
    unsigned Tk = 0u; bool exact = false; int above = 0;
    bool have = false;
    if (Tprev != 0u && (Tprev >> 23) != 0x1ffu) {
        const unsigned lo = Tprev & 0xff800000u, hi = lo + 0x00800000u; int clo, chi;
        SEL_COUNT(clo, lo); SEL_COUNT(chi, hi);
        if (clo >= 256 && chi < 256) { Tk = lo; above = chi; have = true; if (clo == 256) exact = true; }
    }
    if (!have) {
#pragma unroll 1
        for (int bit = 31; bit >= 23; --bit) { const unsigned cand = Tk | (1u << bit); int cnt; SEL_COUNT(cnt, cand);
            if (cnt >= 256) Tk = cand; else above = cnt;
            if (cnt == 256) { exact = true; break; } }
    }
    int lowbit = 22;
    if (!exact) {
        *(LAS u32x4*)(hist + 4 * lane) = (u32x4){0u, 0u, 0u, 0u};
#pragma unroll
        for (int i = 0; i < NR; ++i) { if ((ky[i] >> 23) == (Tk >> 23)) __hip_atomic_fetch_add(hist + ((ky[i] >> 15) & 255u), 1u, __ATOMIC_RELAXED, __HIP_MEMORY_SCOPE_WORKGROUP); }
        const u32x4 c = *(LAS u32x4*)(hist + 4 * lane);
        const int kk = 256 - above;
        const int s4 = (int)(c.x + c.y + c.z + c.w); int suf = s4;
#pragma unroll
        for (int o = 1; o < 64; o <<= 1) { const int t = __shfl_down(suf, o); if (lane + o < 64) suf += t; }
        const int ab3 = suf - s4, ab2 = ab3 + (int)c.w, ab1 = ab2 + (int)c.z, ab0 = ab1 + (int)c.y;
        int dmine = -1, kmine = 0, cmine = 0;
        if (ab3 < kk && kk <= ab3 + (int)c.w) { dmine = 4 * lane + 3; kmine = kk - ab3; cmine = (int)c.w; }
        else if (ab2 < kk && kk <= ab2 + (int)c.z) { dmine = 4 * lane + 2; kmine = kk - ab2; cmine = (int)c.z; }
        else if (ab1 < kk && kk <= ab1 + (int)c.y) { dmine = 4 * lane + 1; kmine = kk - ab1; cmine = (int)c.y; }
        else if (ab0 < kk && kk <= ab0 + (int)c.x) { dmine = 4 * lane; kmine = kk - ab0; cmine = (int)c.x; }
        const unsigned long long fb = __ballot(dmine >= 0);
        if (fb != 0ull) { const int src = __ffsll((long long)fb) - 1; const int dsel = __shfl(dmine, src), ksel = __shfl(kmine, src), csel = __shfl(cmine, src);
            Tk |= (unsigned)(dsel & 255) << 15; lowbit = 14; if (csel == ksel) exact = true; }
    }
    if (!exact) {
#pragma unroll 1
        for (int bit = lowbit; bit >= 0; --bit) { const unsigned cand = Tk | (1u << bit); int cnt; SEL_COUNT(cnt, cand);
            if (cnt >= 256) Tk = cand;
            if (cnt == 256) { exact = true; break; } }
    }
#undef SEL_COUNT
    asm volatile("" : "+v"(Tk));
    Tprev = Tk;
    if (exact) {
#pragma unroll
        for (int i = 0; i < NR; ++i) { const unsigned long long bs = __ballot(ky[i] >= Tk);
            WRLANE(myword, (unsigned)bs, 2 * i); WRLANE(myword, (unsigned)(bs >> 32), 2 * i + 1); }
    } else {
        int cgt = 0;
#pragma unroll
        for (int i = 0; i < NR; ++i) cgt += __popcll(__ballot(ky[i] > Tk));
        const int need = 256 - cgt; int running = 0;
        const unsigned long long ltmask = (1ull << lane) - 1ull;
#pragma unroll
        for (int i = 0; i < NR; ++i) { const bool eq = ky[i] == Tk; const unsigned long long beq = __ballot(eq);
            const int rank = running + __popcll(beq & ltmask); const bool sel = (ky[i] > Tk || (eq && rank < need)) && (lane <= q - 64 * i);
            const unsigned long long bs = __ballot(sel); running += __popcll(beq);
            WRLANE(myword, (unsigned)bs, 2 * i); WRLANE(myword, (unsigned)(bs >> 32), 2 * i + 1); }
    }
    return myword;
}
__device__ __forceinline__ void indexer_phase(Frame& F) {
    const bf16* QKV = (const bf16*)(F.ws + WS_QKV); const float* IW = (const float*)(F.ws + WS_IW); unsigned* MASK = (unsigned*)(F.ws + WS_MASK);
    LAS float* sc = (LAS float*)F.lds;
    constexpr int SP = 2052;
    const int fr = F.lane & 15, fq = F.lane >> 4;
    LAS unsigned* hist = (LAS unsigned*)(F.lds + 16 * SP * 4 + F.wave * 1024);
    unsigned Tprev = 0u;
#define IDX_DECODE(it_, valid_, rb_, q0_) do { const int idx_ = (it_) * F.G + F.blk; valid_ = idx_ < BATCH * 128; const int jn_ = (idx_ >> 4) & 127, h3_ = jn_ >> 4, a4_ = jn_ & 15; \
        q0_ = 16 * (16 * ((h3_ & 1) ? 7 - (h3_ >> 1) : (h3_ >> 1)) + ((h3_ & 1) ? 15 - a4_ : a4_)); rb_ = (size_t)(idx_ & 15) * SEQ; } while (0)
#define IDX_LOAD(rb_, q0_) do { const int nt_ = (q0_) / 16 + 1; const bf16* kb_ = QKV + ((rb_) + fr) * NQ + 2048 + fq * 8; \
        _Pragma("unroll") for (int k = 0; k < 8; ++k) { const int tl = F.wave + 8 * k < nt_ ? F.wave + 8 * k : 0; ik[k][0] = *(const bf16x8*)(kb_ + (size_t)tl * 16 * NQ); ik[k][1] = *(const bf16x8*)(kb_ + (size_t)tl * 16 * NQ + 32); } \
        iw0 = *(const f32x4*)(IW + ((rb_) + (q0_) + fr) * 8); iw1 = *(const f32x4*)(IW + ((rb_) + (q0_) + fr) * 8 + 4); \
        _Pragma("unroll") for (int h = 0; h < 8; ++h) _Pragma("unroll") for (int ks = 0; ks < 2; ++ks) iqf[h][ks] = *(const bf16x8*)(QKV + ((rb_) + (q0_) + fr) * NQ + 1536 + h * 64 + ks * 32 + fq * 8); } while (0)
#define IDX_TILE(IKF, tile_) do { f32x4 s_ = (f32x4){0.f, 0.f, 0.f, 0.f}; \
        _Pragma("unroll") for (int h = 0; h < 8; ++h) { f32x4 a_ = (f32x4){0.f, 0.f, 0.f, 0.f}; const float iwh = h < 4 ? iw0[h & 3] : iw1[h & 3]; \
            a_ = __builtin_amdgcn_mfma_f32_16x16x32_bf16((IKF)[0], iqf[h][0], a_, 0, 0, 0); a_ = __builtin_amdgcn_mfma_f32_16x16x32_bf16((IKF)[1], iqf[h][1], a_, 0, 0, 0); \
            _Pragma("unroll") for (int i = 0; i < 4; ++i) { const int ai_ = __float_as_int(a_[i]); const float r_ = __int_as_float(ai_ > 0 ? ai_ : 0);     asm("v_fmac_f32 %0, %1, %2" : "+v"(s_[i]) : "v"(iwh), "v"(r_)); } } \
        *(LAS f32x4*)(sc + fr * SP + (tile_) * 16 + 4 * fq) = s_; } while (0)
    bf16x8 iqf[8][2], ik[8][2]; f32x4 iw0, iw1;
    bool valid; size_t rb; int q0;
    IDX_DECODE(0, valid, rb, q0);
    if (valid && q0 + 16 > 256) IDX_LOAD(rb, q0);
    for (int it = 0; valid; ++it) {
        const bool light = q0 + 16 <= 256;
        const int ntile = light ? 0 : q0 / 16 + 1;
        if (ntile > 0) {
#pragma unroll
            for (int k = 0; k < 8; ++k) { if (F.wave + 8 * k < ntile) IDX_TILE(ik[k], F.wave + 8 * k); }
            if (ntile > 64) {
                const bf16* kb = QKV + (rb + fr) * NQ + 2048 + fq * 8;
#pragma unroll
                for (int k = 0; k < 8; ++k) { const int tl = F.wave + 64 + 8 * k < ntile ? F.wave + 64 + 8 * k : 0; ik[k][0] = *(const bf16x8*)(kb + (size_t)tl * 16 * NQ); ik[k][1] = *(const bf16x8*)(kb + (size_t)tl * 16 * NQ + 32); }
#pragma unroll
                for (int k = 0; k < 8; ++k) { if (F.wave + 64 + 8 * k < ntile) IDX_TILE(ik[k], F.wave + 64 + 8 * k); } }
        }
        __syncthreads();
        bool nvalid; size_t nrb; int nq0;
        IDX_DECODE(it + 1, nvalid, nrb, nq0);
        if (nvalid && nq0 + 16 > 256) IDX_LOAD(nrb, nq0);
#pragma unroll 1
        for (int k = 0; k < 2; ++k) {
            const int ql = 2 * F.wave + k, q = q0 + ql;
            unsigned myword = 0u;
            if (light) { const int n = q + 1 - 32 * F.lane; myword = n >= 32 ? 0xffffffffu : (n <= 0 ? 0u : ((1u << n) - 1u)); }
            else {
            const int nrb = (((q0 + 15) >> 6) + 8) >> 3;
            const LAS float* srow = sc + ql * SP + F.lane;
            if (nrb == 1) myword = select_query<8>(srow, hist, q, F.lane, Tprev); else if (nrb == 2) myword = select_query<16>(srow, hist, q, F.lane, Tprev);
            else if (nrb == 3) myword = select_query<24>(srow, hist, q, F.lane, Tprev); else myword = select_query<32>(srow, hist, q, F.lane, Tprev);
            }
            MASK[(rb + q) * 64 + F.lane] = myword;
        }
        __syncthreads();
        valid = nvalid; rb = nrb; q0 = nq0;
    }
#undef IDX_DECODE
#undef IDX_LOAD
#undef IDX_TILE
}

template <bool MOE, bool SRC_BF16>
__device__ __forceinline__ void final_phase(Frame& F, const void* src, float* out, const float* fnorm, const float* mod1) {
    const int gw = F.blk * 8 + F.wave, NGW = F.G * 8;
    int P[9]; P[0] = 0;
    if (MOE) {
#pragma unroll
        for (int e = 0; e < 8; ++e) { int ce = (int)F.ctl[CW_CNT + 64 * e]; ce = ce < 0 ? 0 : (ce > T ? T : ce); P[e + 1] = P[e] + (ce + 255) / 256; }
    }
    const bf16* Y = (const bf16*)(F.ws + WS_Y); const u32x4* tok = (const u32x4*)(F.ws + WS_TOK);
    f32x4 fn[4];
#pragma unroll
    for (int jj = 0; jj < 4; ++jj) fn[jj] = *(const f32x4*)(fnorm + 4 * F.lane + 256 * jj);
    for (int row = gw; row < T; row += NGW) {
        f32x4 v[4];
#pragma unroll
        for (int jj = 0; jj < 4; ++jj) {
            if (SRC_BF16) { const u32x2 w = ((const u32x2*)((const bf16*)src + (size_t)row * D) + F.lane)[64 * jj]; v[jj] = (f32x4){bflo(w.x), bfhi(w.x), bflo(w.y), bfhi(w.y)}; }
            else v[jj] = ((const f32x4*)((const float*)src + (size_t)row * D) + F.lane)[64 * jj]; }
        if (MOE) {
            const u32x4 ti = tok[row]; const int e1 = ti.x & 0xff, e2 = (ti.x >> 8) & 0xff; int p1 = 0, p2 = 0;
#pragma unroll
            for (int e = 0; e < 8; ++e) { if (e1 == e) p1 = P[e]; if (e2 == e) p2 = P[e]; }
            const size_t r1 = (size_t)p1 * 256 + ti.y, r2 = (size_t)p2 * 256 + ti.z; const float g1 = __uint_as_float(ti.w), g2 = 1.f - g1;
            const int b = row / SEQ;
            const u32x2* y1 = (const u32x2*)(Y + r1 * D) + F.lane; const u32x2* y2 = (const u32x2*)(Y + r2 * D) + F.lane;
#pragma unroll
            for (int jj = 0; jj < 4; ++jj) { const u32x2 a = y1[64 * jj], c = y2[64 * jj]; const f32x4 gf = *(const f32x4*)(mod1 + (size_t)b * 6144 + 5 * 1024 + 4 * F.lane + 256 * jj);
                v[jj][0] += gf[0] * (g1 * bflo(a.x) + g2 * bflo(c.x)); v[jj][1] += gf[1] * (g1 * bfhi(a.x) + g2 * bfhi(c.x));
                v[jj][2] += gf[2] * (g1 * bflo(a.y) + g2 * bflo(c.y)); v[jj][3] += gf[3] * (g1 * bfhi(a.y) + g2 * bfhi(c.y)); }
        }
        float ss = 0.f;
#pragma unroll
        for (int jj = 0; jj < 4; ++jj) ss += (v[jj][0] * v[jj][0] + v[jj][1] * v[jj][1]) + (v[jj][2] * v[jj][2] + v[jj][3] * v[jj][3]);
        const float rstd = rsqrtf(wave_sum(ss) * (1.f / D) + NORM_EPS);
        f32x4* orow = (f32x4*)(out + (size_t)row * D) + F.lane;
#pragma unroll
        for (int jj = 0; jj < 4; ++jj) orow[64 * jj] = v[jj] * rstd * fn[jj];
    }
}

constexpr int NPHASE = 17;
constexpr int LASTPH = (MK_STAGE == 0) ? 0 : (MK_STAGE == 1) ? 4 : (MK_STAGE == 2) ? 7 : (MK_STAGE == 3) ? 12 : 15;
__global__ void __launch_bounds__(512, 2) fwd_kernel(Args args) {
    extern __shared__ __attribute__((aligned(16))) unsigned char lds_raw[];
    Frame F;
    F.lds = (LAS unsigned char*)lds_raw; F.ws = args.ws; F.ctl = (unsigned*)(args.ws + WS_CTL);
    F.tid = threadIdx.x; F.lane = F.tid & 63; F.wave = __builtin_amdgcn_readfirstlane(F.tid >> 6); F.G = gridDim.x; F.blk = blockIdx.x;
    volatile LAS unsigned* MISC = (volatile LAS unsigned*)(F.lds + MISC_OFF);
    if (F.tid < 64) MISC[F.tid] = 0u;
    __syncthreads();
    XcdBarrier bar; bar.bar = F.ctl + CW_BAR; bar.x = 0; bar.st = MISC + 8;
    if (MK_ONE_LAUNCH) bar = xcd_barrier_post(F.ctl + CW_BAR, MISC + 8);
    const int lo = args.ph_lo, hi = args.ph_hi;
#define IN(k) (lo <= (k) && (k) < hi && ((k) <= LASTPH || (k) == NPHASE - 1))
#define SEAM(k) do { if (MK_ONE_LAUNCH && (k) + 1 < hi) xcd_barrier(bar); } while (0)
    const float* x = (const float*)args.in[0];
    float* mod0 = (float*)(F.ws + WS_MOD); float* mod1 = mod0 + 16 * 6144;
    bf16* Hb = (bf16*)(F.ws + WS_H); bf16* QKV = (bf16*)(F.ws + WS_QKV); bf16* MIX = (bf16*)(F.ws + WS_MIX); unsigned char* ACT0 = F.ws + WS_ACT0; unsigned char* ACT1 = F.ws + WS_ACT1; bf16* Yb = (bf16*)(F.ws + WS_Y); bf16* XR = (bf16*)(F.ws + WS_XR);
    const float* cs = (const float*)(F.ws + WS_ROPE);
    LAS unsigned char* ring = F.lds;

#define PHASE(k, ...) do { if (IN(k)) { __VA_ARGS__; if (MK_DUP & (1 << (k))) { xcd_barrier(bar); __VA_ARGS__; } } SEAM(k); } while (0)
    PHASE(0, { p0_prologue(F, args); q_strips(F, args); zero_kpad(F, F.ws + WS_WDN1, NE * D); });
    PHASE(1, { norm_phase<1, false, 2>(F, x, (const float*)args.in[5], mod0, 0, 1024, Hb, (const float*)args.in[7], E_IN, 1536, (const float*)args.in[8], (float*)(F.ws + WS_LOGF)); });
    const float* rsc = (const float*)(F.ws + WS_RS); const float* csc = (const float*)(F.ws + WS_CS);
    PHASE(2, { cumsum_kaug(F);
        pg8::StaticOrder S; S.init(T, NQ, D / 2, F.G, F.blk, Hb, F.ws + WS_WIN0, csc + CS_WIN0);
        pg8::EpiQKV<0> E{QKV, (bf16*)(F.ws + WS_VT), (bf16*)(F.ws + WS_VT_SWA), cs, F.lds + VT_STAGE_OFF};
        pg8::gemm_phase<pg8::EpiQKV<0>, pg8::StaticOrder, true, false, 2>(ring, D / 2, S, E, rsc); });
    PHASE(3, attn0_phase(F, (const float*)args.in[9]));
    PHASE(4, { pg8::StaticOrder S; S.init(T, D, D, F.G, F.blk, MIX, F.ws + WS_WOUT0);
        pg8::EpiResid<true> E{x, XR, mod0 + 2048, 1.f};
        pg8::gemm_phase<pg8::EpiResid<true>, pg8::StaticOrder, true, false>(ring, D, S, E); });
    PHASE(5, norm_phase<0, true, 2>(F, XR, (const float*)args.in[6], mod0, 3072, 4096, Hb, nullptr, 0, 0, nullptr, nullptr));
    PHASE(6, { pg8::StaticOrder S; S.init(T, 2 * FF, D / 2, F.G, F.blk, Hb, F.ws + WS_WGU0, csc + CS_WGU0);
        pg8::EpiSwiGLU<true> E{ACT0, FF, 1.f};
        pg8::gemm_phase<pg8::EpiSwiGLU<true>, pg8::StaticOrder, true, false, 2>(ring, D / 2, S, E, rsc); });
    PHASE(7, { pg8::StaticOrder S; S.init(T, D, FF / 2, F.G, F.blk, ACT0, F.ws + WS_WDN0);
        pg8::EpiResid<false> E{nullptr, XR, mod0 + 5120, FP8_OUT_SCALE};
        pg8::gemm_phase<pg8::EpiResid<false>, pg8::StaticOrder, true, false, 1>(ring, FF / 2, S, E); });
    PHASE(8, norm_phase<2, true, 2>(F, XR, (const float*)args.in[16], mod1, 0, 1024, Hb, (const float*)args.in[18], O_IN, 2112, nullptr, (float*)(F.ws + WS_IW)));
    PHASE(9, { pg8::StaticOrder S; S.init(T, NQ, D / 2, F.G, F.blk, Hb, F.ws + WS_WIN1, csc + CS_WIN1);
        pg8::EpiQKV<1> E{QKV, (bf16*)(F.ws + WS_VT), nullptr, cs, F.lds + VT_STAGE_OFF};
        pg8::gemm_phase<pg8::EpiQKV<1>, pg8::StaticOrder, true, false, 2>(ring, D / 2, S, E, rsc); });
    PHASE(10, indexer_phase(F));
    PHASE(11, attn1_phase(F));
    PHASE(12, { pg8::StaticOrder S; S.init(T, D, D, F.G, F.blk, MIX, F.ws + WS_WOUT1);
        pg8::EpiResid<false> E{nullptr, XR, mod1 + 2048, 1.f};
        pg8::gemm_phase<pg8::EpiResid<false>, pg8::StaticOrder, true, false>(ring, D, S, E); });
    PHASE(13, { zero_kpad(F, F.ws + WS_ACT1, YROWS); norm_phase<3, true, 2>(F, XR, (const float*)args.in[17], mod1, 3072, 4096, Hb, (const float*)args.in[20], 8, 0, (const float*)args.in[21], nullptr); });
    PHASE(14, { pg8::MoeOrder S; S.init(F.ctl + CW_CNT, 2 * FFE, D / 2, F.G, F.blk, Hb, F.ws + WS_WGU1, (size_t)2 * FFE * D, (const int*)(F.ws + WS_LIST), true, csc + CS_WGU1, 2 * FFE);
        pg8::EpiSwiGLU<true> E{ACT1, FFEP, 1.f};
        pg8::gemm_phase<pg8::EpiSwiGLU<true>, pg8::MoeOrder, true, true, 2>(ring, D / 2, S, E, rsc); });
    PHASE(15, { pg8::MoeOrder S; S.init(F.ctl + CW_CNT, D, FFEP / 2, F.G, F.blk, ACT1, F.ws + WS_WDN1, (size_t)D * FFEP, nullptr, false);
        pg8::EpiBf16 E{Yb, D, FP8_OUT_SCALE};
        pg8::gemm_phase<pg8::EpiBf16, pg8::MoeOrder, true, false, 1>(ring, FFEP / 2, S, E); });
    if (IN(16)) {
        if (MK_STAGE == 0) final_phase<false, false>(F, x, args.out, (const float*)args.in[25], mod1);
        else if (MK_STAGE < 4) final_phase<false, true>(F, XR, args.out, (const float*)args.in[25], mod1);
        else final_phase<true, true>(F, XR, args.out, (const float*)args.in[25], mod1);
    }
#undef IN
#undef SEAM
#undef PHASE
}

extern "C" void kernel_launch(void* const* d_in, const int* in_sizes, int n_in, void* d_out, int out_size, void* d_ws, size_t ws_size, hipStream_t stream) {
    static int grid = 0;
    if (grid == 0) {
        if (n_in != 26 || out_size != T * D || ws_size < WS_END) { fprintf(stderr, "kernel_launch: unexpected shapes (n_in %d out %d ws %zu)\n", n_in, out_size, ws_size); grid = -1; return; }
        int dev = 0, cus = 0;
        if (hipGetDevice(&dev) != hipSuccess || hipDeviceGetAttribute(&cus, hipDeviceAttributeMultiprocessorCount, dev) != hipSuccess) { grid = -1; return; }
        if (hipFuncSetAttribute((const void*)fwd_kernel, hipFuncAttributeMaxDynamicSharedMemorySize, LDS_BYTES) != hipSuccess) { fprintf(stderr, "kernel_launch: hipFuncSetAttribute failed\n"); grid = -1; return; }
        int per_cu = 0;
        if (hipOccupancyMaxActiveBlocksPerMultiprocessor(&per_cu, (const void*)fwd_kernel, 512, LDS_BYTES) != hipSuccess || per_cu < 1) fprintf(stderr, "kernel_launch: occupancy query reports %d\n", per_cu);
        (void)hipGetLastError();
        grid = 256;
        while (grid > cus && grid > 1) grid >>= 1;
    }
    if (grid < 0) return;
    (void)hipMemsetAsync((char*)d_ws + WS_CTL, 0, CTL_ZERO_BYTES, stream);
    Args a{};
    for (int i = 0; i < 26; ++i) a.in[i] = d_in[i];
    a.out = (float*)d_out; a.ws = (unsigned char*)d_ws;
#if MK_ONE_LAUNCH
    a.ph_lo = 0; a.ph_hi = NPHASE;
    hipLaunchKernelGGL(fwd_kernel, dim3(grid), dim3(512), LDS_BYTES, stream, a);
#else
    for (int p = 0; p < NPHASE; ++p) {
        if (!(p <= LASTPH || p == NPHASE - 1)) continue;
        a.ph_lo = p; a.ph_hi = p + 1;
        hipLaunchKernelGGL(fwd_kernel, dim3(grid), dim3(512), LDS_BYTES, stream, a);
        if (p == MK_REP_PHASE) for (int r = 0; r < MK_REP_N; ++r) hipLaunchKernelGGL(fwd_kernel, dim3(grid), dim3(512), LDS_BYTES, stream, a);
    }
#endif
}
```

```cpp
#include <hip/hip_runtime.h>
#include <cstdio>
#include <cstdint>

#ifndef MK_STAGE
#define MK_STAGE 4
#endif
#ifndef MK_ONE_LAUNCH
#define MK_ONE_LAUNCH 1
#endif

#ifndef MK_REP_PHASE
#define MK_REP_PHASE -1
#define MK_REP_N 0
#endif
#ifndef MK_DUP
#define MK_DUP 0
#endif
#define GAS __attribute__((address_space(1)))
#define LAS __attribute__((address_space(3)))
typedef unsigned short bf16;
typedef unsigned u32x4 __attribute__((ext_vector_type(4)));
typedef unsigned u32x2 __attribute__((ext_vector_type(2)));
typedef float f32x4 __attribute__((ext_vector_type(4)));
typedef float f32x2 __attribute__((ext_vector_type(2)));
typedef float f32x16 __attribute__((ext_vector_type(16)));
typedef short bf16x8 __attribute__((ext_vector_type(8)));
typedef __bf16 bf16x2_t __attribute__((ext_vector_type(2)));

__device__ __forceinline__ unsigned cvtpk(float lo, float hi) { f32x2 v = {lo, hi}; bf16x2_t b = __builtin_convertvector(v, bf16x2_t); return __builtin_bit_cast(unsigned, b); }
typedef int v8i32 __attribute__((ext_vector_type(8)));
typedef int v4i32g __attribute__((ext_vector_type(4)));
__device__ __forceinline__ unsigned pack4_i8(float a, float b, float c, float d) {
    unsigned w = 0u; w = __builtin_amdgcn_cvt_pk_u8_f32(a + 128.f, 0, w); w = __builtin_amdgcn_cvt_pk_u8_f32(b + 128.f, 1, w); w = __builtin_amdgcn_cvt_pk_u8_f32(c + 128.f, 2, w); w = __builtin_amdgcn_cvt_pk_u8_f32(d + 128.f, 3, w);
    return w ^ 0x80808080u; }
typedef short bf16x16v __attribute__((ext_vector_type(16)));
constexpr float FP8_ACT_SCALE = 8.f, FP8_W_SCALE = 32.f, FP8_OUT_SCALE = 1.f / (8.f * 32.f), FP8_H_SCALE = 16.f, FP8_GU_SCALE = 1.f / (16.f * 32.f);
__device__ __forceinline__ unsigned pack4_fp8(float a, float b, float c, float d) {
    a = __builtin_amdgcn_fmed3f(a, -448.f, 448.f); b = __builtin_amdgcn_fmed3f(b, -448.f, 448.f); c = __builtin_amdgcn_fmed3f(c, -448.f, 448.f); d = __builtin_amdgcn_fmed3f(d, -448.f, 448.f);
    int w = 0; w = __builtin_amdgcn_cvt_pk_fp8_f32(a, b, w, false); w = __builtin_amdgcn_cvt_pk_fp8_f32(c, d, w, true); return (unsigned)w; }
__device__ __forceinline__ float bf2f(unsigned short b) { return __uint_as_float((unsigned)b << 16); }
__device__ __forceinline__ float bflo(unsigned w) { return __uint_as_float(w << 16); }
__device__ __forceinline__ float bfhi(unsigned w) { return __uint_as_float(w & 0xffff0000u); }

constexpr int BATCH = 16, SEQ = 2048, T = BATCH * SEQ, D = 1024;
constexpr int NQ = 2304;
constexpr int FF = 2816, FFE = 1408, NE = 8;
constexpr int FFEP = 1536;
constexpr int E_IN = 2312, O_IN = 2120;
constexpr float C2 = 0.125f * 1.4426950408889634f;
constexpr float NORM_EPS = 1e-6f;
constexpr int YROWS = 2 * T + NE * 256;

constexpr size_t MiB = 1u << 20;
constexpr size_t WS_CTL = 0, CTL_ZERO_BYTES = 1 * MiB;
constexpr size_t WS_MOD = 1 * MiB;
constexpr size_t WS_ROPE = 2 * MiB;
constexpr size_t WS_LOGF = 10 * MiB;
constexpr size_t WS_RSS = WS_LOGF;
constexpr size_t WS_KAUG = 11 * MiB;
constexpr size_t WS_IW = 15 * MiB;
constexpr size_t WS_TOK = 16 * MiB;
constexpr size_t WS_RS = 16 * MiB + 512 * 1024;
constexpr size_t WS_CS = WS_RS + 128 * 1024;
constexpr int CS_WIN0 = 0, CS_WGU0 = 2304, CS_WIN1 = CS_WGU0 + 2 * 2816, CS_WGU1 = CS_WIN1 + 2304, CS_END = CS_WGU1 + 8 * 2 * 1408;

static_assert(CS_END == 32768, "column scale table");
constexpr size_t WS_LIST = 17 * MiB;
constexpr size_t WS_MASK = 18 * MiB;
constexpr size_t WS_WIN0 = 26 * MiB, WS_WOUT0 = WS_WIN0 + (size_t)NQ * D * 2, WS_WGU0 = WS_WOUT0 + (size_t)D * D * 2, WS_WDN0 = WS_WGU0 + (size_t)2 * FF * D * 2;
constexpr size_t WS_WIN1 = WS_WDN0 + (size_t)D * FF * 2, WS_WOUT1 = WS_WIN1 + (size_t)NQ * D * 2, WS_WGU1 = WS_WOUT1 + (size_t)D * D * 2, WS_WDN1 = WS_WGU1 + (size_t)NE * 2 * FFE * D * 2;
constexpr size_t WS_WEND = WS_WDN1 + (size_t)NE * D * FFE * 2;
constexpr size_t WS_XR = 122 * MiB;
constexpr size_t WS_H = 186 * MiB;
constexpr size_t WS_Y = WS_H, WS_MIX = WS_H;
constexpr size_t WS_QKV = 250 * MiB;
constexpr size_t WS_VT = 394 * MiB;
constexpr size_t WS_VT_SWA = WS_VT + 32 * MiB;
constexpr size_t WS_ACT0 = WS_QKV;
constexpr size_t WS_ACT1 = 318 * MiB;
constexpr size_t WS_END = 500 * MiB;
static_assert(WS_WEND <= WS_XR && WS_XR + (size_t)T * D * 2 <= WS_H && WS_Y + (size_t)YROWS * D * 2 <= WS_ACT1 && WS_H + (size_t)T * D * 2 <= WS_QKV && WS_QKV + (size_t)T * NQ * 2 <= WS_VT && WS_VT_SWA + (size_t)16 * 128 * SEQ * 2 <= WS_END
              && WS_ACT0 + (size_t)T * FF * 2 <= WS_END && WS_ACT1 + (size_t)YROWS * FFE * 2 <= WS_END, "d_ws map");
constexpr int CW_TMO = 0;
constexpr int CW_BAR = 4096;
constexpr int CW_CNT = 16384;

constexpr int VT_STAGE_OFF = 131072, VT_STAGE_WAVE = 2560;
constexpr int SCR_BYTES = 151552;
constexpr int MISC_OFF = SCR_BYTES;
constexpr int GS_OFF = SCR_BYTES + 1024;
constexpr int LDS_BYTES = SCR_BYTES + 1024 + 4096;

namespace pg8 {
#define PG8_LAS __attribute__((address_space(3)))
constexpr int BM = 256, BK = 64, HALF = 128, HTB = HALF * BK * 2, NXCD = 8, WGM = 8;
__host__ __device__ __forceinline__ int lds_byte(int r, int c) { const int st = (r >> 4) * 2 + (c >> 5), rr = r & 15, cc = c & 31, ob = rr * 64 + cc * 2; return st * 1024 + (ob ^ (((ob >> 9) & 1) << 5)); }
__host__ __device__ __forceinline__ void stage_rc(int b, int& R, int& C) { const int st = b / 1024, sb = b % 1024, swz = sb ^ (((sb >> 9) & 1) << 5); R = (st >> 1) * 16 + swz / 64; C = (st & 1) * 32 + (swz % 64) / 2; }
__host__ __device__ __forceinline__ int perm32(int rho) { const int n = rho >> 4, i = rho & 15; return 8 * (i >> 2) + 4 * n + (i & 3); }
struct Unit { int pm, pn, e; };

struct StaticOrder {
    int nM, nN, nwg, G, c; const char* A; const char* B; size_t tA, tB; const float* cs;
    __device__ __forceinline__ void init(int M, int N, int K, int G_, int c_, const void* A_, const void* B_, const float* cs_ = nullptr) { nM = M / BM; nN = N / BM; nwg = nM * nN; G = G_; c = c_; A = (const char*)A_; B = (const char*)B_; tA = (size_t)BM * K * 2; tB = tA; cs = cs_; }
    __device__ __forceinline__ const float* cs_ptr(const Unit&) const { return cs; }
    __device__ __forceinline__ bool next(int i, Unit& u) const {
        const long L = (long)i * G + c; if (L >= nwg) return false;
        int wgid = (int)L; { const int q = nwg / NXCD, r = nwg % NXCD, xcd = wgid % NXCD, off = wgid / NXCD; wgid = (xcd < r ? xcd * (q + 1) : r * (q + 1) + (xcd - r) * q) + off; }
        const int nig = WGM * nN, gid = wgid / nig, fm = gid * WGM, gsz = (nM - fm) < WGM ? (nM - fm) : WGM;
        u.pm = fm + ((wgid % nig) % gsz); u.pn = (wgid % nig) / gsz; u.e = 0; return true;
    }
    __device__ __forceinline__ const char* a_base(const Unit& u) const { return A + (size_t)u.pm * tA; }
    __device__ __forceinline__ const char* b_base(const Unit& u) const { return B + (size_t)u.pn * tB; }
    __device__ __forceinline__ int arow(const Unit&, int) const { return 0; }
    __device__ __forceinline__ const float* rs_src(const Unit& u, const float* rs) const { return rs + (size_t)u.pm * BM; }
    __device__ __forceinline__ int rows_valid(const Unit&) const { return BM; }
};

struct MoeOrder {
    int nN, G, c; int P[9]; int cnt[8];
    const char* A; const char* B; size_t tA, tB, bstride; const int* list; bool gather; const float* cs; int cs_estride;
    __device__ __forceinline__ void init(const unsigned* gcnt, int N, int K, int G_, int c_, const void* A_, const void* B_, size_t bstride_, const int* list_, bool gather_, const float* cs_ = nullptr, int cs_estride_ = 0) {
        nN = N / BM; G = G_; c = c_; A = (const char*)A_; B = (const char*)B_; tA = (size_t)BM * K * 2; tB = tA; bstride = bstride_; list = list_; gather = gather_; cs = cs_; cs_estride = cs_estride_;
        P[0] = 0;
#pragma unroll
        for (int e = 0; e < 8; ++e) { int ce = (int)gcnt[64 * e]; ce = ce < 0 ? 0 : (ce > T ? T : ce); cnt[e] = ce; P[e + 1] = P[e] + (ce + 255) / 256; }
    }
    __device__ __forceinline__ bool next(int i, Unit& u) const {
        const long L = (long)i * G + c; if (L >= (long)P[8] * nN) return false;
        const int g = (int)(L / nN); u.pm = g; u.pn = (int)(L - (long)g * nN); int e = 0;
#pragma unroll
        for (int j = 1; j < 8; ++j) if (g >= P[j]) e = j;
        u.e = e; return true;
    }
    __device__ __forceinline__ const char* a_base(const Unit& u) const { return gather ? A : A + (size_t)u.pm * tA; }
    __device__ __forceinline__ const char* b_base(const Unit& u) const { return B + (size_t)u.e * bstride + (size_t)u.pn * tB; }
    __device__ __forceinline__ const float* cs_ptr(const Unit& u) const { return cs + (size_t)u.e * cs_estride; }
    __device__ __forceinline__ int arow(const Unit& u, int r) const {
        int Pe = 0, ce = 0;
#pragma unroll
        for (int j = 0; j < 8; ++j) if (u.e == j) { Pe = P[j]; ce = cnt[j]; }
        const int slot = (u.pm - Pe) * 256 + r;
        return slot < ce ? list[(size_t)u.e * T + slot] : 0;
    }
    __device__ __forceinline__ const float* rs_src(const Unit& u, const float* rs) const { int Pe = 0;
#pragma unroll
        for (int j = 0; j < 8; ++j) if (u.e == j) Pe = P[j];
        return rs + (size_t)u.e * T + (size_t)(u.pm - Pe) * BM; }
    __device__ __forceinline__ int rows_valid(const Unit& u) const { int Pe = 0, ce = 0;
#pragma unroll
        for (int j = 0; j < 8; ++j) if (u.e == j) { Pe = P[j]; ce = cnt[j]; }
        const int v = ce - (u.pm - Pe) * BM; return v < BM ? v : BM; }
};

typedef int v4i32 __attribute__((ext_vector_type(4)));
template <int OPK> struct AccSel { typedef f32x4 T; };
template <> struct AccSel<2> { typedef v4i32g T; };
template <int OPK  > struct Frag;
template <> struct Frag<0> { bf16x8 k0, k1;
    __device__ __forceinline__ void load(const PG8_LAS unsigned char* p) { k0 = *(const PG8_LAS bf16x8*)p; k1 = *(const PG8_LAS bf16x8*)(p + 1024); }
    static __device__ __forceinline__ f32x4 mma(const Frag& b, const Frag& a, f32x4 c) { c = __builtin_amdgcn_mfma_f32_16x16x32_bf16(b.k0, a.k0, c, 0, 0, 0); return __builtin_amdgcn_mfma_f32_16x16x32_bf16(b.k1, a.k1, c, 0, 0, 0); } };
template <> struct Frag<2> { v4i32g k0, k1;
    __device__ __forceinline__ void load(const PG8_LAS unsigned char* p) { k0 = *(const PG8_LAS v4i32g*)p; k1 = *(const PG8_LAS v4i32g*)(p + 1024); }
    static __device__ __forceinline__ v4i32g mma(const Frag& b, const Frag& a, v4i32g c) { c = __builtin_amdgcn_mfma_i32_16x16x64_i8(b.k0, a.k0, c, 0, 0, 0); return __builtin_amdgcn_mfma_i32_16x16x64_i8(b.k1, a.k1, c, 0, 0, 0); } };
template <> struct Frag<1> { v8i32 v;
    __device__ __forceinline__ void load(const PG8_LAS unsigned char* p) { const v4i32 lo = *(const PG8_LAS v4i32*)p, hi = *(const PG8_LAS v4i32*)(p + 1024); v = __builtin_shufflevector(lo, hi, 0, 1, 2, 3, 4, 5, 6, 7); }
    static __device__ __forceinline__ f32x4 mma(const Frag& b, const Frag& a, f32x4 c) {
        const int one = 0x7f7f7f7f; asm volatile("v_mfma_scale_f32_16x16x128_f8f6f4 %0, %1, %2, %0, %3, %3 op_sel_hi:[0,0,0]" : "+v"(c) : "v"(b.v), "v"(a.v), "v"(one)); return c; } };
template <class Epi, class Sched, bool ALIGN_EPI, bool GATHER, int OPK = 0>
__device__ __forceinline__ void gemm_phase(PG8_LAS unsigned char* lds, const int K, const Sched& S, const Epi& E, const int wave, const float* rs = nullptr) {
    int lane; asm volatile("v_mbcnt_lo_u32_b32 %0, -1, 0\n\tv_mbcnt_hi_u32_b32 %0, -1, %0" : "=v"(lane));
    const int wid = __builtin_amdgcn_readfirstlane(wave), tid = wid * 64 + lane, wr = wid >> 2, wc = wid & 3, fr = lane & 15, fq = lane >> 4;
    const int nt = K / BK;
    int Rr[2], Cc[2]; unsigned voffB[2];
#pragma unroll
    for (int i = 0; i < 2; ++i) { int R, C; stage_rc(tid * 16 + i * 8192, R, C); Rr[i] = R; Cc[i] = C; const int Rb = Epi::PERM ? ((R & ~31) + perm32(R & 31)) : R; voffB[i] = (unsigned)(Rb * K + C) * 2u; }
    const size_t kstep = (size_t)(BK * 2);
    const size_t hstep = (size_t)HALF * K * 2;
    const unsigned ldsw = (unsigned)wid * 1024u;
    const int aoff = lds_byte(wr * 64 + fr, fq * 8), boff = lds_byte(wc * 32 + fr, fq * 8);
#define PG8_SA(b, h) (((b) * 2 + (h)) * HTB)
#define PG8_SB(b, h) ((4 + (b) * 2 + (h)) * HTB)
#define PG8_STAGE(bufoff, gbase, voff) do { _Pragma("unroll") for (int _i = 0; _i < 2; ++_i) \
        __builtin_amdgcn_global_load_lds((const unsigned*)((const char*)(gbase) + (voff)[_i]), (PG8_LAS unsigned*)(lds + (bufoff) + ldsw + _i * 8192), 16, 0, 0); } while (0)
#define PG8_LDA(dst, b, h) do { _Pragma("unroll") for (int m = 0; m < 4; ++m) dst[m].load(lds + PG8_SA(b, h) + aoff + m * 2048); } while (0)
#define PG8_LDB(dst, b, h) do { _Pragma("unroll") for (int n = 0; n < 2; ++n) dst[n].load(lds + PG8_SB(b, h) + boff + n * 2048); } while (0)
#define PG8_MMA(ai, bj, At, Bt) do { __builtin_amdgcn_s_setprio(1); _Pragma("unroll") for (int m = 0; m < 4; ++m) _Pragma("unroll") for (int n = 0; n < 2; ++n) \
        acc[ai][bj][m][n] = Frag<OPK>::mma(Bt[n], At[m], acc[ai][bj][m][n]); __builtin_amdgcn_s_setprio(0); } while (0)
#define PG8_WAIT_V(n) asm volatile("s_waitcnt vmcnt(" #n ")" ::: "memory")
#define PG8_WAIT_L(n) asm volatile("s_waitcnt lgkmcnt(" #n ")" ::: "memory")
#define PG8_BAR __builtin_amdgcn_s_barrier()
#define PG8_SCHED __builtin_amdgcn_sched_barrier(0)
#define PG8_VA(dst, u) do { _Pragma("unroll") for (int _h = 0; _h < 2; ++_h) _Pragma("unroll") for (int _i = 0; _i < 2; ++_i) \
        dst[_h][_i] = GATHER ? (unsigned)S.arow(u, _h * HALF + Rr[_i]) * (unsigned)(K * 2) + (unsigned)Cc[_i] * 2u : (unsigned)((_h * HALF + Rr[_i]) * K + Cc[_i]) * 2u; } while (0)
    Unit cur, nxt; int ui = 0;
    if (!S.next(0, cur)) return;
    typedef typename AccSel<OPK>::T AccT;
    AccT acc[2][2][4][2];
#pragma unroll
    for (int a = 0; a < 2; ++a)
#pragma unroll
        for (int b = 0; b < 2; ++b)
#pragma unroll
            for (int m = 0; m < 4; ++m)
#pragma unroll
                for (int n = 0; n < 2; ++n) acc[a][b][m][n] = AccT{};
    Frag<OPK> At[4], B0[2], B1[2];
    unsigned vA[2][2], vAn[2][2];
    PG8_VA(vA, cur);
#pragma unroll
    for (int h = 0; h < 2; ++h)
#pragma unroll
        for (int i = 0; i < 2; ++i) vAn[h][i] = vA[h][i];
    const char* cA = S.a_base(cur); const char* cB = S.b_base(cur);
    PG8_STAGE(PG8_SB(0, 0), cB, voffB); PG8_STAGE(PG8_SB(0, 1), cB + hstep, voffB); PG8_STAGE(PG8_SA(0, 0), cA, vA[0]); PG8_STAGE(PG8_SA(0, 1), cA, vA[1]);
    if (wr == 1) PG8_BAR;
    PG8_WAIT_V(2); PG8_BAR;
    PG8_STAGE(PG8_SB(1, 0), cB + kstep, voffB); PG8_STAGE(PG8_SA(1, 0), cA + kstep, vA[0]); PG8_STAGE(PG8_SB(1, 1), cB + hstep + kstep, voffB);
    PG8_WAIT_V(6); PG8_BAR;
    for (;;) {
        const bool has_next = S.next(ui + 1, nxt);
        const char* nA = has_next ? S.a_base(nxt) : cA; const char* nB = has_next ? S.b_base(nxt) : cB;
        if constexpr (GATHER) { if (has_next) { PG8_VA(vAn, nxt); } }
        if constexpr (OPK == 2) {
            int ln; asm volatile("v_mbcnt_lo_u32_b32 %0, -1, 0\n\tv_mbcnt_hi_u32_b32 %0, -1, %0" : "=v"(ln));
            const float* sp = (wid < 4 ? S.rs_src(cur, rs) + 64 * wid : S.cs_ptr(cur) + cur.pn * BM + 64 * (wid - 4)) + ln;
            __builtin_amdgcn_global_load_lds((const unsigned*)sp, (PG8_LAS unsigned*)(lds + GS_OFF + (ui & 1) * 2048 + wid * 256), 4, 0, 0); }
        for (int t = 0; t < nt; t += 2) {
            const bool last = (t == nt - 2);
            const char* a1 = cA + (size_t)(t + 1) * kstep;
            const char* a2 = last ? nA : cA + (size_t)(t + 2) * kstep; const char* b2 = last ? nB : cB + (size_t)(t + 2) * kstep;
            const char* a3 = a2 + kstep; const char* b3 = b2 + kstep;
            unsigned v2[2][2];
#pragma unroll
            for (int h = 0; h < 2; ++h)
#pragma unroll
                for (int i = 0; i < 2; ++i) v2[h][i] = (GATHER && last) ? vAn[h][i] : vA[h][i];
            PG8_LDB(B0, 0, 0); PG8_LDB(B1, 0, 1); PG8_SCHED; PG8_LDA(At, 0, 0); PG8_STAGE(PG8_SA(1, 1), a1, vA[1]);
            PG8_WAIT_V(8); PG8_WAIT_L(0); PG8_BAR; PG8_MMA(0, 0, At, B0); PG8_MMA(0, 1, At, B1); PG8_BAR; PG8_SCHED;
            PG8_LDA(At, 0, 1); PG8_STAGE(PG8_SB(0, 0), b2, voffB); PG8_STAGE(PG8_SB(0, 1), b2 + hstep, voffB); PG8_STAGE(PG8_SA(0, 0), a2, v2[0]);
            PG8_WAIT_V(8); PG8_WAIT_L(0); PG8_BAR; PG8_MMA(1, 0, At, B0); PG8_MMA(1, 1, At, B1); PG8_BAR; PG8_SCHED;
            PG8_LDB(B0, 1, 0); PG8_LDB(B1, 1, 1); PG8_SCHED; PG8_LDA(At, 1, 0); PG8_STAGE(PG8_SA(0, 1), a2, v2[1]);
            PG8_WAIT_V(8); PG8_WAIT_L(0); PG8_BAR; PG8_MMA(0, 0, At, B0); PG8_MMA(0, 1, At, B1); PG8_BAR; PG8_SCHED;
            PG8_LDA(At, 1, 1); PG8_STAGE(PG8_SB(1, 0), b3, voffB); PG8_STAGE(PG8_SB(1, 1), b3 + hstep, voffB); PG8_STAGE(PG8_SA(1, 0), a3, v2[0]);
            PG8_WAIT_V(8); PG8_WAIT_L(0); PG8_BAR; PG8_MMA(1, 0, At, B0); PG8_MMA(1, 1, At, B1); PG8_BAR; PG8_SCHED;
        }
        if constexpr (ALIGN_EPI) { if (wr == 0) PG8_BAR; }
        if constexpr (OPK == 2) {
            f32x4 accf[2][2][4][2]; const PG8_LAS float* gs = (const PG8_LAS float*)(lds + GS_OFF + (ui & 1) * 2048);
            const PG8_LAS float* cs = gs + 256 + wc * 32 + (Epi::PERM ? 8 * fq : 4 * fq);
            f32x4 csv[2][2]; float rsv[2][4];
#pragma unroll
            for (int bj = 0; bj < 2; ++bj)
#pragma unroll
                for (int n = 0; n < 2; ++n) csv[bj][n] = *(const PG8_LAS f32x4*)(cs + bj * HALF + (Epi::PERM ? 4 * n : 16 * n));
            const int nvalid = S.rows_valid(cur);
#pragma unroll
            for (int ai = 0; ai < 2; ++ai)
#pragma unroll
                for (int m = 0; m < 4; ++m) { const int lr = ai * HALF + wr * 64 + m * 16 + fr; const float v = gs[lr]; rsv[ai][m] = (GATHER && lr >= nvalid) ? 1.f : v; }
#pragma unroll
            for (int ai = 0; ai < 2; ++ai)
#pragma unroll
                for (int bj = 0; bj < 2; ++bj)
#pragma unroll
                    for (int m = 0; m < 4; ++m)
#pragma unroll
                        for (int n = 0; n < 2; ++n) { const v4i32g a = acc[ai][bj][m][n]; accf[ai][bj][m][n] = (f32x4){(float)a[0], (float)a[1], (float)a[2], (float)a[3]} * csv[bj][n] * rsv[ai][m]; }
            E(accf, cur, wr, wc, fr, fq);
        } else E(acc, cur, wr, wc, fr, fq);
        if (!has_next) break;
#pragma unroll
        for (int a = 0; a < 2; ++a)
#pragma unroll
            for (int b = 0; b < 2; ++b)
#pragma unroll
                for (int m = 0; m < 4; ++m)
#pragma unroll
                    for (int n = 0; n < 2; ++n) acc[a][b][m][n] = AccT{};
        cur = nxt; cA = nA; cB = nB; ++ui;
#pragma unroll
        for (int h = 0; h < 2; ++h)
#pragma unroll
            for (int i = 0; i < 2; ++i) vA[h][i] = vAn[h][i];
        if constexpr (ALIGN_EPI) { if (wr == 1) PG8_BAR; }
    }
    PG8_WAIT_V(0);
    if constexpr (!ALIGN_EPI) { if (wr == 0) PG8_BAR; }
    PG8_BAR;
#undef PG8_SA
#undef PG8_SB
#undef PG8_STAGE
#undef PG8_LDA
#undef PG8_LDB
#undef PG8_MMA
#undef PG8_WAIT_V
#undef PG8_WAIT_L
#undef PG8_BAR
#undef PG8_SCHED
#undef PG8_VA
}

template <int L> struct EpiQKV {
    static constexpr bool PERM = true;
    bf16* QKV; bf16* VT; bf16* VT2; const float* cs; PG8_LAS unsigned char* stg;
    __device__ __forceinline__ void operator()(const f32x4 (&acc)[2][2][4][2], const Unit& u, int wr, int wc, int fr, int fq) const {
        const int row0 = u.pm * BM + wr * 64 + fr, pn = u.pn;
        int kind = 0  , dst = 0; float sc = 1.f; bf16* vt = VT; int vnc = 0, vc0 = 0, vcs = 0;
        if (L == 0) {
            if (pn < 4) { kind = 0; dst = 256 * pn + wc * 32; sc = pn < 2 ? C2 : 1.f; }
            else if (pn < 6) { kind = 2; vt = VT; vnc = 512; vc0 = 256 * (pn - 4) + 32 * wc; vcs = 128; }
            else if (pn < 8) { kind = 1; dst = 1536 + (4 * (pn - 6) + wc) * 64; sc = C2; }
            else { if (wc < 2) { kind = 1; dst = 2048 + wc * 64; sc = 1.f; } else { kind = 2; vt = VT2; vnc = 128; vc0 = (wc - 2) * 32; vcs = 64; } }
        } else {
            if (pn < 4) { kind = 1; dst = (4 * pn + wc) * 64; sc = C2; }
            else if (pn == 4) { kind = 1; dst = 1024 + wc * 64; sc = 1.f; }
            else if (pn == 5) { kind = 2; vt = VT; vnc = 256; vc0 = 32 * wc; vcs = 128; }
            else if (pn < 8) { kind = 1; dst = 1536 + (4 * (pn - 6) + wc) * 64; sc = 1.f; }
            else { if (wc == 0) { kind = 1; dst = 2048; sc = 1.f; } else kind = 3; }
        }
        if (kind == 0) {
#pragma unroll
            for (int ai = 0; ai < 2; ++ai)
#pragma unroll
                for (int m = 0; m < 4; ++m) { bf16* rowp = QKV + (size_t)(row0 + ai * HALF + m * 16) * NQ + dst + 8 * fq;
#pragma unroll
                    for (int bj = 0; bj < 2; ++bj) { const f32x4 v0 = acc[ai][bj][m][0] * sc, v1 = acc[ai][bj][m][1] * sc;
                        u32x4 w; w.x = cvtpk(v0[0], v0[1]); w.y = cvtpk(v0[2], v0[3]); w.z = cvtpk(v1[0], v1[1]); w.w = cvtpk(v1[2], v1[3]);
                        *(u32x4*)(rowp + bj * HALF) = w; } }
        } else if (kind == 1) {
#pragma unroll
            for (int ai = 0; ai < 2; ++ai)
#pragma unroll
                for (int m = 0; m < 4; ++m) { const int r = row0 + ai * HALF + m * 16; const f32x4* cp = (const f32x4*)(cs + (size_t)r * 64 + 16 * fq);
                    const f32x4 t0 = cp[0], t1 = cp[1], t2 = cp[2], t3 = cp[3];
                    const f32x4 x1a = acc[ai][0][m][0], x1b = acc[ai][0][m][1], x2a = acc[ai][1][m][0], x2b = acc[ai][1][m][1];
                    float o1[8], o2[8];
                    o1[0] = x1a[0] * t0[0] - x2a[0] * t0[1]; o2[0] = x2a[0] * t0[0] + x1a[0] * t0[1];
                    o1[1] = x1a[1] * t0[2] - x2a[1] * t0[3]; o2[1] = x2a[1] * t0[2] + x1a[1] * t0[3];
                    o1[2] = x1a[2] * t1[0] - x2a[2] * t1[1]; o2[2] = x2a[2] * t1[0] + x1a[2] * t1[1];
                    o1[3] = x1a[3] * t1[2] - x2a[3] * t1[3]; o2[3] = x2a[3] * t1[2] + x1a[3] * t1[3];
                    o1[4] = x1b[0] * t2[0] - x2b[0] * t2[1]; o2[4] = x2b[0] * t2[0] + x1b[0] * t2[1];
                    o1[5] = x1b[1] * t2[2] - x2b[1] * t2[3]; o2[5] = x2b[1] * t2[2] + x1b[1] * t2[3];
                    o1[6] = x1b[2] * t3[0] - x2b[2] * t3[1]; o2[6] = x2b[2] * t3[0] + x1b[2] * t3[1];
                    o1[7] = x1b[3] * t3[2] - x2b[3] * t3[3]; o2[7] = x2b[3] * t3[2] + x1b[3] * t3[3];
                    bf16* rowp = QKV + (size_t)r * NQ + dst + 8 * fq;
                    u32x4 w; w.x = cvtpk(o1[0] * sc, o1[1] * sc); w.y = cvtpk(o1[2] * sc, o1[3] * sc); w.z = cvtpk(o1[4] * sc, o1[5] * sc); w.w = cvtpk(o1[6] * sc, o1[7] * sc);
                    *(u32x4*)(rowp) = w;
                    w.x = cvtpk(o2[0] * sc, o2[1] * sc); w.y = cvtpk(o2[2] * sc, o2[3] * sc); w.z = cvtpk(o2[4] * sc, o2[5] * sc); w.w = cvtpk(o2[6] * sc, o2[7] * sc);
                    *(u32x4*)(rowp + 32) = w; }
        } else if (kind == 2) {
            const int b = (u.pm * BM) / SEQ, s_tile = (u.pm * BM) % SEQ, lane = fq * 16 + fr;
            PG8_LAS unsigned char* sw = stg + (wr * 4 + wc) * VT_STAGE_WAVE;
#pragma unroll
            for (int ai = 0; ai < 2; ++ai)
#pragma unroll
                for (int bj = 0; bj < 2; ++bj)
#pragma unroll
                    for (int mp = 0; mp < 2; ++mp) {
#pragma unroll
                        for (int mm = 0; mm < 2; ++mm)
#pragma unroll
                            for (int n = 0; n < 2; ++n) { const f32x4 v = acc[ai][bj][2 * mp + mm][n]; const unsigned w0 = cvtpk(v[0], v[1]), w1 = cvtpk(v[2], v[3]);
                                PG8_LAS unsigned char* wp = sw + (8 * fq + 4 * n) * 80 + (16 * mm + fr) * 2;
                                *(PG8_LAS unsigned short*)(wp) = (unsigned short)w0; *(PG8_LAS unsigned short*)(wp + 80) = (unsigned short)(w0 >> 16);
                                *(PG8_LAS unsigned short*)(wp + 160) = (unsigned short)w1; *(PG8_LAS unsigned short*)(wp + 240) = (unsigned short)(w1 >> 16); }
#pragma unroll
                        for (int j = 0; j < 2; ++j) { const int colr = (lane >> 2) + 16 * j, seg = lane & 3;
                            const u32x4 v = *(const PG8_LAS u32x4*)(sw + colr * 80 + seg * 16);
                            *(u32x4*)(vt + ((size_t)b * vnc + vc0 + bj * vcs + colr) * SEQ + s_tile + ai * HALF + wr * 64 + mp * 32 + seg * 8) = v; }
                    }
        }
    }
};
template <bool FIRST> struct EpiResid {
    static constexpr bool PERM = true;
    const float* xin; bf16* XR; const float* gate; float oscale;
    __device__ __forceinline__ void operator()(const f32x4 (&acc)[2][2][4][2], const Unit& u, int wr, int wc, int fr, int fq) const {
        const int row0 = u.pm * BM + wr * 64 + fr, col0 = u.pn * BM + wc * 32 + 8 * fq; const int b = (u.pm * BM) / SEQ;
        f32x4 gv[2][2];
#pragma unroll
        for (int bj = 0; bj < 2; ++bj)
#pragma unroll
            for (int n = 0; n < 2; ++n) gv[bj][n] = *(const f32x4*)(gate + (size_t)b * 6144 + col0 + bj * HALF + 4 * n) * oscale;
#pragma unroll
        for (int ai = 0; ai < 2; ++ai)
#pragma unroll
            for (int m = 0; m < 4; ++m) { const size_t ro = (size_t)(row0 + ai * HALF + m * 16) * D + col0;
#pragma unroll
                for (int bj = 0; bj < 2; ++bj) { f32x4 b0, b1;
                    if (FIRST) { b0 = *(const f32x4*)(xin + ro + bj * HALF); b1 = *(const f32x4*)(xin + ro + bj * HALF + 4); }
                    else { const u32x4 w = *(const u32x4*)(XR + ro + bj * HALF); b0 = (f32x4){bflo(w.x), bfhi(w.x), bflo(w.y), bfhi(w.y)}; b1 = (f32x4){bflo(w.z), bfhi(w.z), bflo(w.w), bfhi(w.w)}; }
                    const f32x4 v0 = b0 + gv[bj][0] * acc[ai][bj][m][0], v1 = b1 + gv[bj][1] * acc[ai][bj][m][1];
                    u32x4 o; o.x = cvtpk(v0[0], v0[1]); o.y = cvtpk(v0[2], v0[3]); o.z = cvtpk(v1[0], v1[1]); o.w = cvtpk(v1[2], v1[3]);
                    *(u32x4*)(XR + ro + bj * HALF) = o; } }
    }
};
template <bool FP8OUT> struct EpiSwiGLU {
    static constexpr bool PERM = true;
    void* O; int ldc; float iscale;
    __device__ __forceinline__ void operator()(const f32x4 (&acc)[2][2][4][2], const Unit& u, int wr, int wc, int fr, int fq) const {
        const int row0 = u.pm * BM + wr * 64 + fr, col0 = u.pn * HALF + wc * 32 + 8 * fq;
#pragma unroll
        for (int ai = 0; ai < 2; ++ai)
#pragma unroll
            for (int m = 0; m < 4; ++m) { float v[8];
#pragma unroll
                for (int n = 0; n < 2; ++n)
#pragma unroll
                    for (int i = 0; i < 4; ++i) { const float g = acc[ai][0][m][n][i] * iscale, up = acc[ai][1][m][n][i] * iscale; v[4 * n + i] = g * __builtin_amdgcn_rcpf(1.f + __expf(-g)) * up; }
                if (FP8OUT) { const u32x2 w = (u32x2){pack4_fp8(v[0] * FP8_ACT_SCALE, v[1] * FP8_ACT_SCALE, v[2] * FP8_ACT_SCALE, v[3] * FP8_ACT_SCALE), pack4_fp8(v[4] * FP8_ACT_SCALE, v[5] * FP8_ACT_SCALE, v[6] * FP8_ACT_SCALE, v[7] * FP8_ACT_SCALE)};
                    *(u32x2*)((unsigned char*)O + (size_t)(row0 + ai * HALF + m * 16) * ldc + col0) = w; }
                else { u32x4 w; w.x = cvtpk(v[0], v[1]); w.y = cvtpk(v[2], v[3]); w.z = cvtpk(v[4], v[5]); w.w = cvtpk(v[6], v[7]);
                    *(u32x4*)((bf16*)O + (size_t)(row0 + ai * HALF + m * 16) * ldc + col0) = w; } }
    }
};
struct EpiBf16 {
    static constexpr bool PERM = true;
    bf16* O; int ldc; float oscale;
    __device__ __forceinline__ void operator()(const f32x4 (&acc)[2][2][4][2], const Unit& u, int wr, int wc, int fr, int fq) const {
        const int row0 = u.pm * BM + wr * 64 + fr, col0 = u.pn * BM + wc * 32 + 8 * fq;
#pragma unroll
        for (int ai = 0; ai < 2; ++ai)
#pragma unroll
            for (int m = 0; m < 4; ++m) { bf16* rowp = O + (size_t)(row0 + ai * HALF + m * 16) * ldc + col0;
#pragma unroll
                for (int bj = 0; bj < 2; ++bj) { const f32x4 v0 = acc[ai][bj][m][0] * oscale, v1 = acc[ai][bj][m][1] * oscale;
                    u32x4 w; w.x = cvtpk(v0[0], v0[1]); w.y = cvtpk(v0[2], v0[3]); w.z = cvtpk(v1[0], v1[1]); w.w = cvtpk(v1[2], v1[3]);
                    *(u32x4*)(rowp + bj * HALF) = w; } }
    }
};
}

#define XB_TMO      128
#define XB_XCNT(j)  (256  + 64 * (j))
#define XB_XSUB(j)  (1280 + 64 * (j))
#define XB_XGEN(j)  (2304 + 64 * (j))
#define XB_TOP      3328
#define XB_TOPGEN   3392
#define XCD_BAR_WORDS 3456
#define XB_SPIN_CAP (1u << 18)
__device__ __forceinline__ unsigned xb_ld(unsigned* p)              { return __hip_atomic_load(p, __ATOMIC_RELAXED, __HIP_MEMORY_SCOPE_AGENT); }
__device__ __forceinline__ unsigned xb_add(unsigned* p, unsigned v) { return __hip_atomic_fetch_add(p, v, __ATOMIC_RELAXED, __HIP_MEMORY_SCOPE_AGENT); }
__device__ __forceinline__ unsigned xb_xcc_id() { return (unsigned)__builtin_amdgcn_s_getreg((3 << 11) | 20) & 0xFu; }
#define XB_SPIN(cond, bar) do { unsigned _sp = 0; while (cond) { __builtin_amdgcn_s_sleep(1); \
    if ((++_sp & 255u) == 0u) { if (xb_ld(&(bar)[XB_TMO])) break; if (_sp > XB_SPIN_CAP) { atomicAdd(&(bar)[XB_TMO], 1u); break; } } } } while (0)
struct XcdBarrier { unsigned* bar; unsigned x; volatile LAS unsigned* st; };
__device__ __forceinline__ XcdBarrier xcd_barrier_post(unsigned* bar, volatile LAS unsigned* st) {
    XcdBarrier b; b.bar = bar; b.x = xb_xcc_id(); b.st = st;
    if (threadIdx.x == 0) (void)xb_add(&bar[XB_XCNT(b.x)], 1u);
    return b;
}
__device__ __forceinline__ void xcd_barrier_complete(unsigned* bar, unsigned x, unsigned& nloc, unsigned& nx) {
    const unsigned G = gridDim.x * gridDim.y * gridDim.z;
    unsigned sum, cnt, mine, sp = 0u;
    for (;;) {
        sum = 0u; cnt = 0u; mine = 0u;
#pragma unroll
        for (unsigned j = 0; j < 16; ++j) { const unsigned c = xb_ld(&bar[XB_XCNT(j)]); sum += c; cnt += (c > 0u) ? 1u : 0u; mine = (j == x) ? c : mine; }
        if (sum == G) break;
        __builtin_amdgcn_s_sleep(1);
        if ((++sp & 255u) == 0u) { if (xb_ld(&bar[XB_TMO])) break; if (sp > XB_SPIN_CAP) { atomicAdd(&bar[XB_TMO], 1u); break; } }
    }
    nloc = mine > 0u ? mine : 1u; nx = cnt > 0u ? cnt : 1u;
}
__device__ __forceinline__ void xcd_barrier(const XcdBarrier& b) {
    asm volatile("s_waitcnt vmcnt(0)" ::: "memory");
    __syncthreads();
    if (threadIdx.x == 0) {
        unsigned* bar = b.bar;
        __builtin_amdgcn_s_waitcnt(0);
        unsigned nloc = b.st[0], nx = b.st[1];
        if (nloc == 0u) { xcd_barrier_complete(bar, b.x, nloc, nx); b.st[0] = nloc; b.st[1] = nx; }
        const unsigned old = xb_add(&bar[XB_XSUB(b.x)], 1u);
        const unsigned gen = old / nloc;
        if (old + 1u == (gen + 1u) * nloc) {
            __builtin_amdgcn_fence(__ATOMIC_RELEASE, "agent");
            asm volatile("s_waitcnt vmcnt(0)" ::: "memory");
            const unsigned og = xb_add(&bar[XB_TOP], 1u);
            const unsigned tg = og / nx;
            if (og + 1u == (tg + 1u) * nx) xb_add(&bar[XB_TOPGEN], 1u);
            else XB_SPIN(xb_ld(&bar[XB_TOPGEN]) == tg, bar);
            __builtin_amdgcn_fence(__ATOMIC_ACQUIRE, "agent");
            xb_add(&bar[XB_XGEN(b.x)], 1u);
            asm volatile("s_waitcnt vmcnt(0)" ::: "memory");
        } else {
            XB_SPIN(xb_ld(&bar[XB_XGEN(b.x)]) == gen, bar);
            __builtin_amdgcn_fence(__ATOMIC_ACQUIRE, "agent");
            asm volatile("s_waitcnt vmcnt(0)" ::: "memory");
        }
    }
    __syncthreads();
}

#define DPP_MOV(v, CTRL) __int_as_float(__builtin_amdgcn_update_dpp(0, __float_as_int(v), (CTRL), 0xf, 0xf, true))
__device__ __forceinline__ float wave_sum(float v) {
    v += DPP_MOV(v, 0xB1); v += DPP_MOV(v, 0x4E); v += DPP_MOV(v, 0x141); v += DPP_MOV(v, 0x140);
    v += __shfl_xor(v, 16);
    auto rr = __builtin_amdgcn_permlane32_swap(__float_as_uint(v), __float_as_uint(v), false, false); return __uint_as_float(rr[0]) + __uint_as_float(rr[1]);
}
__device__ __forceinline__ float wave_max(float v) {
    v = fmaxf(v, DPP_MOV(v, 0xB1)); v = fmaxf(v, DPP_MOV(v, 0x4E)); v = fmaxf(v, DPP_MOV(v, 0x141)); v = fmaxf(v, DPP_MOV(v, 0x140));
    v = fmaxf(v, __shfl_xor(v, 16));
    auto rr = __builtin_amdgcn_permlane32_swap(__float_as_uint(v), __float_as_uint(v), false, false); return fmaxf(__uint_as_float(rr[0]), __uint_as_float(rr[1]));
}
__device__ __forceinline__ float swap_max(float v) { auto rr = __builtin_amdgcn_permlane32_swap(__float_as_uint(v), __float_as_uint(v), false, false); return fmaxf(__uint_as_float(rr[0]), __uint_as_float(rr[1])); }
__device__ __forceinline__ float swap_sum(float v) { auto rr = __builtin_amdgcn_permlane32_swap(__float_as_uint(v), __float_as_uint(v), false, false); return __uint_as_float(rr[0]) + __uint_as_float(rr[1]); }

__device__ __forceinline__ void sincos_d(double a, float& sn, float& cn) {
    const double k = __builtin_rint(a * 0.63661977236758134308);
    double r = __builtin_fma(-k, 1.57079632673412561417e+00, a);
    r = __builtin_fma(-k, 6.07710050650619224932e-11, r);
    r = __builtin_fma(-k, 2.02226624879595063154e-21, r);
    const double z = r * r;
    const double sp = r + r * z * (-1.66666666666666324348e-01 + z * (8.33333333332248946124e-03 + z * (-1.98412698298579493134e-04 + z * (2.75573137070700676789e-06 + z * (-2.50507602534068634195e-08 + z * 1.58969099521155010221e-10)))));
    const double cp = 1.0 - 0.5 * z + z * z * (4.16666666666666019037e-02 + z * (-1.38888888888741095749e-03 + z * (2.48015872894767294178e-05 + z * (-2.75573143513906633035e-07 + z * (2.08757232129817482790e-09 + z * -1.13596475577881948265e-11)))));
    const int q = ((int)k) & 3;
    const double s = (q == 0) ? sp : (q == 1) ? cp : (q == 2) ? -sp : -cp;
    const double c = (q == 0) ? cp : (q == 1) ? -sp : (q == 2) ? -cp : sp;
    sn = (float)s; cn = (float)c;
}

struct Args { const void* in[26]; float* out; unsigned char* ws; int ph_lo, ph_hi; };
struct Frame {
    LAS unsigned char* lds; unsigned* ctl; unsigned char* ws;
    int tid, lane, wave, G, blk;
};

__device__ __forceinline__ void conv_item(const float* W, int ld, int col0, bf16* WT, int K, int dstrow0, int k0, LAS float* scr, int lane) {
    if (col0 >= 0) {
#pragma unroll 8
        for (int i = 0; i < 32; ++i) { const int kk = 2 * i + (lane >> 5); scr[kk * 33 + (lane & 31)] = W[(size_t)(k0 + kk) * ld + col0 + (lane & 31)]; }
    } else {
#pragma unroll 8
        for (int i = 0; i < 32; ++i) { const int kk = 2 * i + (lane >> 5); scr[kk * 33 + (lane & 31)] = 0.f; }
    }
    asm volatile("s_waitcnt lgkmcnt(0)" ::: "memory");
    const int c = lane & 7;
#pragma unroll
    for (int j = 0; j < 4; ++j) { const int n = (lane >> 3) + 8 * j; const LAS float* s = scr + (8 * c) * 33 + n;
        u32x4 o; o.x = cvtpk(s[0 * 33], s[1 * 33]); o.y = cvtpk(s[2 * 33], s[3 * 33]); o.z = cvtpk(s[4 * 33], s[5 * 33]); o.w = cvtpk(s[6 * 33], s[7 * 33]);
        *(u32x4*)(WT + (size_t)(dstrow0 + n) * K + k0 + 8 * c) = o; }
    asm volatile("s_waitcnt lgkmcnt(0)" ::: "memory");
}
__device__ __forceinline__ void conv_item_fp8(const float* W, int ld, int col0, unsigned char* WT, int Kp, int dstrow0, int k0, LAS float* scr, int lane) {
#pragma unroll 8
    for (int i = 0; i < 32; ++i) { const int kk = 2 * i + (lane >> 5); scr[kk * 33 + (lane & 31)] = W[(size_t)(k0 + kk) * ld + col0 + (lane & 31)] * FP8_W_SCALE; }
    asm volatile("s_waitcnt lgkmcnt(0)" ::: "memory");
    const int c = lane & 7;
#pragma unroll
    for (int j = 0; j < 4; ++j) { const int n = (lane >> 3) + 8 * j; const LAS float* sp = scr + (8 * c) * 33 + n;
        const u32x2 o = (u32x2){pack4_fp8(sp[0 * 33], sp[1 * 33], sp[2 * 33], sp[3 * 33]), pack4_fp8(sp[4 * 33], sp[5 * 33], sp[6 * 33], sp[7 * 33])};
        *(u32x2*)(WT + (size_t)(dstrow0 + n) * Kp + k0 + 8 * c) = o; }
    asm volatile("s_waitcnt lgkmcnt(0)" ::: "memory");
}
__device__ __forceinline__ int map_win0(int n0) {
    const int pn = n0 >> 8, bj = (n0 >> 7) & 1, x = n0 & 127;
    if (pn < 6) return n0;
    if (pn < 8) return 1544 + (4 * (pn - 6) + (x >> 5)) * 64 + 32 * bj;
    return x < 64 ? 2056 + (x >> 5) * 64 + 32 * bj : 2184 + 64 * bj + (x - 64);
}
__device__ __forceinline__ int map_win1(int n0) {
    const int pn = n0 >> 8, bj = (n0 >> 7) & 1, x = n0 & 127;
    if (pn < 4) return (4 * pn + (x >> 5)) * 64 + 32 * bj;
    if (pn == 4) return 1024 + (x >> 5) * 64 + 32 * bj;
    if (pn == 5) return 1280 + 128 * bj + x;
    if (pn < 8) return 1536 + (4 * (pn - 6) + (x >> 5)) * 64 + 32 * bj;
    return x == 0 ? 2048 + 32 * bj : -1;
}

__device__ __forceinline__ void p0_prologue(Frame& F, const Args& a) {
    const float* c_in = (const float*)a.in[1]; const int* pos = (const int*)a.in[2];
    float* mod = (float*)(F.ws + WS_MOD);
    {
        LAS float* sl = (LAS float*)F.lds; LAS float* red = (LAS float*)(F.lds + 65536);
        bool have = false;
        for (int job = F.blk; job < 192; job += F.G) {
            if (!have) { for (int i = F.tid; i < 16 * 1024; i += 512) { const float c = c_in[i]; sl[i] = c / (1.f + __expf(-c)); } __syncthreads(); have = true; }
            const int l = job / 96, n0 = (job % 96) * 64;
            const float* W = (const float*)a.in[l == 0 ? 3 : 14] + n0 + F.lane; const float* bias = (const float*)a.in[l == 0 ? 4 : 15];
            float acc[16];
#pragma unroll
            for (int b = 0; b < 16; ++b) acc[b] = 0.f;
            const int kb = F.wave * 128;
#pragma unroll 4
            for (int k = 0; k < 128; ++k) { const float wv = W[(size_t)(kb + k) * 6144];
#pragma unroll
                for (int b = 0; b < 16; ++b) acc[b] += sl[b * 1024 + kb + k] * wv; }
#pragma unroll
            for (int b = 0; b < 16; ++b) red[(F.wave * 16 + b) * 64 + F.lane] = acc[b];
            __syncthreads();
            for (int i = F.tid; i < 16 * 64; i += 512) { const int b = i >> 6, ln = i & 63; float s = bias[n0 + ln];
#pragma unroll
                for (int w = 0; w < 8; ++w) s += red[(w * 16 + b) * 64 + ln];
                mod[((size_t)l * 16 + b) * 6144 + n0 + ln] = s; }
            __syncthreads();
        }
        __syncthreads();
    }
    {
        float* cs = (float*)(F.ws + WS_ROPE);
        for (int i = F.blk * 512 + F.tid; i < T * 32; i += F.G * 512) { const int t = i >> 5, f = i & 31;
            const float inv = exp2f(-(float)f * (13.287712379549449f / 32.f));
            const float ang = (float)pos[t] * inv; float sn, cn; sincos_d((double)ang, sn, cn);
            *(f32x2*)(cs + (size_t)i * 2) = (f32x2){cn, sn}; }
    }
    {
        LAS float* scr = (LAS float*)(F.lds + F.wave * 16384);
        const int gw = F.blk * 8 + F.wave, NGW = F.G * 8;
        constexpr int I1 = 16 * (NQ / 32), I2 = 16 * 32, I3 = 16 * (2 * FF / 32), I4 = (FF / 64) * 32, I7 = 16 * (2 * FFE / 32), I8 = (FFE / 64) * 32;
        constexpr int NITEMS = 2 * I2 + I4 + NE * I8;
        for (int it = gw; it < NITEMS; it += NGW) {
            int r = it;
            if (r < I2) { const int nb = r % 32, kb = r / 32; conv_item((const float*)a.in[10], D, 32 * nb, (bf16*)(F.ws + WS_WOUT0), D, 32 * nb, 64 * kb, scr, F.lane); continue; } r -= I2;
            if (r < I4) { const int nb = r % 32, kb = r / 32; conv_item_fp8((const float*)a.in[13], D, 32 * nb, F.ws + WS_WDN0, FF, 32 * nb, 64 * kb, scr, F.lane); continue; } r -= I4;
            if (r < I2) { const int nb = r % 32, kb = r / 32; conv_item((const float*)a.in[19], D, 32 * nb, (bf16*)(F.ws + WS_WOUT1), D, 32 * nb, 64 * kb, scr, F.lane); continue; } r -= I2;
            { const int e = r / I8; r -= e * I8; const int nb = r % 32, kb = r / 32;
                conv_item_fp8((const float*)a.in[24] + (size_t)e * FFE * D, D, 32 * nb, F.ws + WS_WDN1 + (size_t)e * D * FFEP, FFEP, 32 * nb, 64 * kb, scr, F.lane); }
        }
    }
}

struct QItem { const float* W; unsigned char* WT; int ld, col0, drow, k0, cs; };
__device__ __forceinline__ QItem q_item(int it, const Args& a, unsigned char* ws) {
    QItem q; const int kb = it & 15; int nb = it >> 4; q.k0 = 64 * kb; q.cs = 32 * nb;
    if (nb < 72) { q.W = (const float*)a.in[7]; q.ld = E_IN; q.col0 = map_win0(32 * nb); q.WT = ws + WS_WIN0; q.drow = 32 * nb; return q; } nb -= 72;
    if (nb < 176) { const int n0 = 32 * nb, pn = n0 >> 8, bj = (n0 >> 7) & 1, x = n0 & 127; q.W = (const float*)a.in[bj ? 12 : 11]; q.ld = FF; q.col0 = 128 * pn + x; q.WT = ws + WS_WGU0; q.drow = n0; return q; } nb -= 176;
    if (nb < 72) { q.W = (const float*)a.in[18]; q.ld = O_IN; q.col0 = map_win1(32 * nb); q.WT = ws + WS_WIN1; q.drow = 32 * nb; return q; } nb -= 72;
    { const int e = nb / 88; nb -= e * 88; const int n0 = 32 * nb, pn = n0 >> 8, bj = (n0 >> 7) & 1, x = n0 & 127;
      q.W = (const float*)a.in[bj ? 23 : 22] + (size_t)e * D * FFE; q.ld = FFE; q.col0 = 128 * pn + x; q.WT = ws + WS_WGU1 + (size_t)e * 2 * FFE * D; q.drow = n0; return q; }
}
__device__ __forceinline__ void q_strips(Frame& F, const Args& a) {
    LAS float* scr = (LAS float*)(F.lds + F.wave * 16384);
    LAS float* cmx = (LAS float*)(F.lds + VT_STAGE_OFF);
    float* cst = (float*)(F.ws + WS_CS);
    for (int st = F.blk; st < CS_END / 32; st += F.G) {
        const QItem q = q_item(st * 16, a, F.ws);
        float r[2][32]; float am = 0.f;
#pragma unroll
        for (int j = 0; j < 2; ++j) {
            if (q.col0 >= 0) { const float* wp = q.W + (size_t)(64 * (2 * F.wave + j) + (F.lane >> 5)) * q.ld + q.col0 + (F.lane & 31);
#pragma unroll
                for (int i = 0; i < 32; ++i) r[j][i] = wp[(size_t)(2 * i) * q.ld]; }
            else {
#pragma unroll
                for (int i = 0; i < 32; ++i) r[j][i] = 0.f; } }
#pragma unroll
        for (int j = 0; j < 2; ++j)
#pragma unroll
            for (int i = 0; i < 32; ++i) am = fmaxf(am, fabsf(r[j][i]));
        am = fmaxf(am, __shfl_xor(am, 32));
        if (F.lane < 32) cmx[F.wave * 32 + F.lane] = am;
        __syncthreads();
        am = cmx[F.lane & 31];
#pragma unroll
        for (int w = 1; w < 8; ++w) am = fmaxf(am, cmx[w * 32 + (F.lane & 31)]);
        const float inv = am > 0.f ? 127.f / am : 0.f;
        if (F.wave == 0 && F.lane < 32) cst[q.cs + F.lane] = am > 0.f ? am * (1.f / 127.f) : 1.f;
#pragma unroll
        for (int j = 0; j < 2; ++j) { const int k0 = 64 * (2 * F.wave + j);
#pragma unroll
            for (int i = 0; i < 32; ++i) scr[(2 * i + (F.lane >> 5)) * 33 + (F.lane & 31)] = rintf(r[j][i] * inv);
            asm volatile("s_waitcnt lgkmcnt(0)" ::: "memory");
            const int c = F.lane & 7;
#pragma unroll
            for (int jj = 0; jj < 4; ++jj) { const int n = (F.lane >> 3) + 8 * jj; const LAS float* sp = scr + (8 * c) * 33 + n;
                *(u32x2*)(q.WT + (size_t)(q.drow + n) * D + k0 + 8 * c) = (u32x2){pack4_i8(sp[0 * 33], sp[1 * 33], sp[2 * 33], sp[3 * 33]), pack4_i8(sp[4 * 33], sp[5 * 33], sp[6 * 33], sp[7 * 33])}; }
            asm volatile("s_waitcnt lgkmcnt(0)" ::: "memory"); }
        __syncthreads();
    }
}
__device__ __forceinline__ void zero_kpad(Frame& F, unsigned char* base, int rows) {
    constexpr int CH = (FFEP - FFE) / 16;
    for (int i = F.blk * 512 + F.tid; i < rows * CH; i += F.G * 512) { const int row = i / CH, ch = i % CH; *(u32x4*)(base + (size_t)row * FFEP + FFE + 16 * ch) = (u32x4){0u, 0u, 0u, 0u}; }
}
template <int SIDE  , bool SRC_BF16, int HOUT = 0  >
__device__ __forceinline__ void norm_phase(Frame& F, const void* src, const float* gamma, const float* modl, int sh_off, int sc_off, bf16* H,
                                           const float* Wside, int ldw, int wcol0, const float* bside, float* side_out) {
    const int rpb = T / F.G, row_lo = F.blk * rpb;
    LAS int* lcnt = (LAS int*)F.lds;
    LAS int* rinfo = (LAS int*)(F.lds + 256);
    if (SIDE == 3) { if (F.tid < 16) lcnt[F.tid] = 0; __syncthreads(); }
    float wreg[4][4][8];
    if (SIDE != 0) {
#pragma unroll
        for (int jj = 0; jj < 4; ++jj)
#pragma unroll
            for (int i = 0; i < 4; ++i) { const int k = 4 * F.lane + 256 * jj + i; const f32x4 w0 = *(const f32x4*)(Wside + (size_t)k * ldw + wcol0), w1 = *(const f32x4*)(Wside + (size_t)k * ldw + wcol0 + 4);
                wreg[jj][i][0] = w0[0]; wreg[jj][i][1] = w0[1]; wreg[jj][i][2] = w0[2]; wreg[jj][i][3] = w0[3]; wreg[jj][i][4] = w1[0]; wreg[jj][i][5] = w1[1]; wreg[jj][i][6] = w1[2]; wreg[jj][i][7] = w1[3]; }
    }
    f32x4 gm[4], av[4], shv[4];
#pragma unroll
    for (int jj = 0; jj < 4; ++jj) gm[jj] = *(const f32x4*)(gamma + 4 * F.lane + 256 * jj);
    int curb = -1;
    for (int lr = F.wave; lr < rpb; lr += 8) {
        const int row = row_lo + lr, b = row / SEQ;
        if (b != curb) { curb = b;
#pragma unroll
            for (int jj = 0; jj < 4; ++jj) { const f32x4 scv = *(const f32x4*)(modl + (size_t)b * 6144 + sc_off + 4 * F.lane + 256 * jj); shv[jj] = *(const f32x4*)(modl + (size_t)b * 6144 + sh_off + 4 * F.lane + 256 * jj); av[jj] = gm[jj] * (scv + 1.f); } }
        f32x4 v[4]; float ss = 0.f, rowscale = 1.f;
#pragma unroll
        for (int jj = 0; jj < 4; ++jj) {
            if (SRC_BF16) { const u32x2 w = ((const u32x2*)((const bf16*)src + (size_t)row * D) + F.lane)[64 * jj]; v[jj] = (f32x4){bflo(w.x), bfhi(w.x), bflo(w.y), bfhi(w.y)}; }
            else v[jj] = ((const f32x4*)((const float*)src + (size_t)row * D) + F.lane)[64 * jj];
            ss += (v[jj][0] * v[jj][0] + v[jj][1] * v[jj][1]) + (v[jj][2] * v[jj][2] + v[jj][3] * v[jj][3]); }
        const float rstd = rsqrtf(wave_sum(ss) * (1.f / D) + NORM_EPS);
        u32x2* o8 = (u32x2*)(H + (size_t)row * D) + F.lane;
#pragma unroll
        for (int jj = 0; jj < 4; ++jj) { v[jj] = v[jj] * rstd * av[jj] + shv[jj];
            if (HOUT == 1) ((unsigned*)((unsigned char*)H + (size_t)row * D) + F.lane)[64 * jj] = pack4_fp8(v[jj][0] * FP8_H_SCALE, v[jj][1] * FP8_H_SCALE, v[jj][2] * FP8_H_SCALE, v[jj][3] * FP8_H_SCALE);
            else if (HOUT == 0) o8[64 * jj] = (u32x2){cvtpk(v[jj][0], v[jj][1]), cvtpk(v[jj][2], v[jj][3])}; }
        if (HOUT == 2) {
            float am = 0.f;
#pragma unroll
            for (int jj = 0; jj < 4; ++jj) am = fmaxf(fmaxf(am, fmaxf(fabsf(v[jj][0]), fabsf(v[jj][1]))), fmaxf(fabsf(v[jj][2]), fabsf(v[jj][3])));
            am = wave_max(am);
            const float inv = am > 0.f ? 127.f / am : 0.f;
#pragma unroll
            for (int jj = 0; jj < 4; ++jj) ((unsigned*)((unsigned char*)H + (size_t)row * D) + F.lane)[64 * jj] = pack4_i8(rintf(v[jj][0] * inv), rintf(v[jj][1] * inv), rintf(v[jj][2] * inv), rintf(v[jj][3] * inv));
            rowscale = am > 0.f ? am * (1.f / 127.f) : 1.f;
            if (F.lane == 0) ((float*)(F.ws + WS_RS))[row] = rowscale;
        }
        if (SIDE != 0) {
            float s[8];
#pragma unroll
            for (int j = 0; j < 8; ++j) { float t = 0.f;
#pragma unroll
                for (int jj = 0; jj < 4; ++jj)
#pragma unroll
                    for (int i = 0; i < 4; ++i) t += v[jj][i] * wreg[jj][i][j];
                s[j] = wave_sum(t); }
            if (SIDE == 1 || SIDE == 2) {
                float mine = 0.f;
#pragma unroll
                for (int j = 0; j < 8; ++j) if (F.lane == j) mine = s[j];
                if (F.lane < 8) {
                    if (SIDE == 1) { const float z = mine + bside[F.lane]; mine = z < 0.f ? z - log1pf(__expf(z)) : -log1pf(__expf(-z)); }
                    else mine *= 0.04419417382415922f;
                    side_out[(size_t)row * 8 + F.lane] = mine; }
            } else {
                float l1 = -INFINITY, l2 = -INFINITY; int e1 = 0, e2 = 0;
#pragma unroll
                for (int j = 0; j < 8; ++j) { const float lg = s[j] + bside[j]; if (lg > l1) { l2 = l1; e2 = e1; l1 = lg; e1 = j; } else if (lg > l2) { l2 = lg; e2 = j; } }
                const float g1 = 1.f / (1.f + __expf(l2 - l1));
                if (F.lane == 0) { const int sl1 = atomicAdd((int*)&lcnt[e1], 1), sl2 = atomicAdd((int*)&lcnt[e2], 1);
                    LAS int* ri = rinfo + lr * 8; ri[0] = e1; ri[1] = e2; ri[2] = sl1; ri[3] = sl2; ri[4] = (int)__float_as_uint(g1); ri[5] = (int)__float_as_uint(rowscale); }
            }
        }
    }
    if (SIDE == 3) {
        __syncthreads();
        if (F.tid < 8) lcnt[8 + F.tid] = (int)__hip_atomic_fetch_add(F.ctl + CW_CNT + 64 * F.tid, (unsigned)lcnt[F.tid], __ATOMIC_RELAXED, __HIP_MEMORY_SCOPE_AGENT);
        __syncthreads();
        int* list = (int*)(F.ws + WS_LIST); u32x4* tok = (u32x4*)(F.ws + WS_TOK);
        for (int lr = F.tid; lr < rpb; lr += 512) { const LAS int* ri = rinfo + lr * 8; const int e1 = ri[0], e2 = ri[1]; const int s1 = lcnt[8 + e1] + ri[2], s2 = lcnt[8 + e2] + ri[3]; const int row = row_lo + lr;
            list[(size_t)e1 * T + s1] = row; list[(size_t)e2 * T + s2] = row;
            { float* rss = (float*)(F.ws + WS_RSS); const float sc = __uint_as_float((unsigned)ri[5]); rss[(size_t)e1 * T + s1] = sc; rss[(size_t)e2 * T + s2] = sc; }
            tok[row] = (u32x4){(unsigned)(e1 | (e2 << 8)), (unsigned)s1, (unsigned)s2, (unsigned)ri[4]}; }
        __syncthreads();
    }
}

__device__ __forceinline__ void cumsum_kaug(Frame& F) {
    const int gw = F.blk * 8 + F.wave;
    if (gw >= BATCH * 8) return;
    const int b = gw >> 3, h = gw & 7;
    const float* lf = (const float*)(F.ws + WS_LOGF) + (size_t)b * SEQ * 8 + h;
    float v[32]; float run = 0.f;
#pragma unroll
    for (int i = 0; i < 32; ++i) { run += lf[(size_t)(32 * F.lane + i) * 8]; v[i] = run; }
    float incl = run;
#pragma unroll
    for (int o = 1; o < 64; o <<= 1) { const float t = __shfl_up(incl, o); if (F.lane >= o) incl += t; }
    const float excl = incl - run;
    u32x4* ka = (u32x4*)(F.ws + WS_KAUG) + (size_t)gw * SEQ + 32 * F.lane;
#pragma unroll
    for (int i = 0; i < 32; ++i) { const float bias = -(excl + v[i]) * 1.4426950408889634f;
        const unsigned h1 = cvtpk(bias, 0.f) & 0xffffu; const float r1 = bias - bflo(h1);
        const unsigned h2 = cvtpk(r1, 0.f) & 0xffffu; const float r2 = r1 - bflo(h2);
        const unsigned h3 = cvtpk(r2, 0.f) & 0xffffu;
        ka[i] = (u32x4){h1 | (h2 << 16), h3, 0u, 0u}; }
}

constexpr int ATT_BUF = 17408;
template <int MODE  >
__device__ __forceinline__ void attn_unit(LAS unsigned char* lds, const int wave, const int lane,
                                          const bf16* __restrict__ Kg, const bf16* __restrict__ VTg, const u32x4* __restrict__ kaug_g,
                                          const bf16* __restrict__ Qp, bf16* __restrict__ Op, const int q0, const int tw_lo, const int tw_hi, const int T_lo, const int T_hi,
                                          const float sinkl2, const unsigned long long* __restrict__ mb) {
    const int r32 = lane & 31, hi = lane >> 5;
    bf16x8 qf[4];
#pragma unroll
    for (int d0 = 0; d0 < 4; ++d0) qf[d0] = *(const bf16x8*)(Qp + (size_t)r32 * NQ + d0 * 16 + hi * 8);
    const int kr = (r32 & ~12) | ((r32 & 4) << 1) | ((r32 & 8) >> 1);
    const int ksw = (kr >> 1) & 7, vsw = (r32 >> 1) & 7;
    int koff[4], voff[2][2];
#pragma unroll
    for (int d0 = 0; d0 < 4; ++d0) koff[d0] = kr * 128 + (((2 * d0 + hi) ^ ksw) << 4);
#pragma unroll
    for (int hf = 0; hf < 2; ++hf)
#pragma unroll
        for (int s = 0; s < 2; ++s) voff[hf][s] = 8192 + r32 * 128 + (((4 * hf + 2 * s + hi) ^ vsw) << 4);
    const int kaoff = 16384 + kr * 16;
    const int drow = 8 * wave + (lane >> 3), dc = (lane & 7) ^ ((drow >> 1) & 7);
    const bf16* ksrc = Kg + (size_t)drow * NQ + dc * 8;
    const bf16* vsrc = VTg + (size_t)drow * SEQ + dc * 8;
#define ATT_DMA(t, b) do { \
        __builtin_amdgcn_global_load_lds((const unsigned*)(ksrc + (size_t)(t) * 64 * NQ), (LAS unsigned*)(lds + (b) * ATT_BUF + wave * 1024), 16, 0, 0); \
        __builtin_amdgcn_global_load_lds((const unsigned*)(vsrc + (t) * 64), (LAS unsigned*)(lds + (b) * ATT_BUF + 8192 + wave * 1024), 16, 0, 0); \
        if (MODE == 0) { if (wave == 0) __builtin_amdgcn_global_load_lds((const unsigned*)(kaug_g + (t) * 64 + lane), (LAS unsigned*)(lds + (b) * ATT_BUF + 16384), 16, 0, 0); } } while (0)
    bf16x8 qaug = (bf16x8){0, 0, 0, 0, 0, 0, 0, 0};
    if (MODE == 0 && hi == 0) { qaug[0] = (short)0x3F80; qaug[1] = (short)0x3F80; qaug[2] = (short)0x3F80; }
    f32x16 o0, o1;
#pragma unroll
    for (int r = 0; r < 16; ++r) { o0[r] = 0.f; o1[r] = 0.f; }
    float m = (MODE == 1) ? sinkl2 : 0.f, l = (MODE == 1 && hi == 0) ? 1.f : 0.f;
    f32x16 negm;
#pragma unroll
    for (int r = 0; r < 16; ++r) negm[r] = -m;
    const int q = q0 + r32;
    asm volatile("" ::: "memory"); __builtin_amdgcn_s_barrier(); asm volatile("" ::: "memory");
    ATT_DMA(T_lo, 0);
    unsigned long long wn = 0ull;
    if (MODE == 2) wn = mb[(size_t)r32 * 32 + T_lo];
    for (int t = T_lo; t < T_hi; ++t) {
        const int buf = (t - T_lo) & 1;
        asm volatile("s_waitcnt vmcnt(0)" ::: "memory"); __builtin_amdgcn_s_barrier(); asm volatile("" ::: "memory");
        if (t + 1 < T_hi) ATT_DMA(t + 1, buf ^ 1);
        const unsigned long long w = wn;
        if (MODE == 2) { if (t + 1 < T_hi) wn = mb[(size_t)r32 * 32 + t + 1]; }
        if (t < tw_lo || t >= tw_hi) continue;
        const int key0 = t * 64;
        const LAS unsigned char* tb = lds + buf * ATT_BUF;
        f32x16 p0, p1;
#pragma unroll
        for (int d0 = 0; d0 < 4; ++d0) { const bf16x8 k0 = *(const LAS bf16x8*)(tb + koff[d0]), k1 = *(const LAS bf16x8*)(tb + 4096 + koff[d0]);
            p0 = __builtin_amdgcn_mfma_f32_32x32x16_bf16(k0, qf[d0], d0 == 0 ? negm : p0, 0, 0, 0); p1 = __builtin_amdgcn_mfma_f32_32x32x16_bf16(k1, qf[d0], d0 == 0 ? negm : p1, 0, 0, 0); }
        if (MODE == 0) { const bf16x8 a0 = *(const LAS bf16x8*)(tb + kaoff), a1 = *(const LAS bf16x8*)(tb + kaoff + 512);
            p0 = __builtin_amdgcn_mfma_f32_32x32x16_bf16(a0, qaug, p0, 0, 0, 0); p1 = __builtin_amdgcn_mfma_f32_32x32x16_bf16(a1, qaug, p1, 0, 0, 0); }
        bf16x8 vf[2][2][2];
#pragma unroll
        for (int dt = 0; dt < 2; ++dt)
#pragma unroll
            for (int hf = 0; hf < 2; ++hf)
#pragma unroll
                for (int s = 0; s < 2; ++s) vf[dt][hf][s] = *(const LAS bf16x8*)(tb + dt * 4096 + voff[hf][s]);
        if (MODE == 0) { if (key0 + 63 > q0) {
#pragma unroll
            for (int r = 0; r < 16; ++r) { const int key = key0 + 16 * (r >> 3) + 8 * hi + (r & 7); if (key > q) p0[r] = -1e30f; if (key + 32 > q) p1[r] = -1e30f; } } }
        if (MODE == 1) {
#pragma unroll
            for (int r = 0; r < 16; ++r) { const int key = key0 + 16 * (r >> 3) + 8 * hi + (r & 7); if (key > q || key <= q - 128) p0[r] = -1e30f; if (key + 32 > q || key + 32 <= q - 128) p1[r] = -1e30f; } }
        float mx = fmaxf(fmaxf(p0[0], p1[0]), p0[1]);
#pragma unroll
        for (int r = 1; r < 16; ++r) mx = fmaxf(fmaxf(mx, p1[r]), r + 1 < 16 ? p0[r + 1] : p1[r]);
        mx = swap_max(mx);
        if (__any(mx > 8.f)) {
            const float dl = fmaxf(mx, 0.f); const float f = __builtin_amdgcn_exp2f(-dl); m += dl; l *= f;
#pragma unroll
            for (int r = 0; r < 16; ++r) { o0[r] *= f; o1[r] *= f; p0[r] -= dl; p1[r] -= dl; negm[r] = -m; }
        }
#pragma unroll
        for (int r = 0; r < 16; ++r) { p0[r] = __builtin_amdgcn_exp2f(p0[r]); p1[r] = __builtin_amdgcn_exp2f(p1[r]); }
        if (MODE == 2) {
            const unsigned wlo = (unsigned)w >> (8 * hi), whi = (unsigned)(w >> 32) >> (8 * hi);
#pragma unroll
            for (int r = 0; r < 16; ++r) { const int bit = 16 * (r >> 3) + (r & 7); int m0, m1;
                asm("v_bfe_i32 %0, %1, %2, 1" : "=v"(m0) : "v"(wlo), "n"(bit)); asm("v_bfe_i32 %0, %1, %2, 1" : "=v"(m1) : "v"(whi), "n"(bit));
                p0[r] = __uint_as_float(__float_as_uint(p0[r]) & (unsigned)m0); p1[r] = __uint_as_float(__float_as_uint(p1[r]) & (unsigned)m1); }
        }
        float ls = 0.f;
#pragma unroll
        for (int r = 0; r < 16; ++r) ls += p0[r] + p1[r];
        l += ls;
        bf16x8 pb[2][2];
#pragma unroll
        for (int s = 0; s < 2; ++s) {
            u32x4 a, b2;
            a.x = cvtpk(p0[8 * s + 0], p0[8 * s + 1]); a.y = cvtpk(p0[8 * s + 2], p0[8 * s + 3]); a.z = cvtpk(p0[8 * s + 4], p0[8 * s + 5]); a.w = cvtpk(p0[8 * s + 6], p0[8 * s + 7]);
            b2.x = cvtpk(p1[8 * s + 0], p1[8 * s + 1]); b2.y = cvtpk(p1[8 * s + 2], p1[8 * s + 3]); b2.z = cvtpk(p1[8 * s + 4], p1[8 * s + 5]); b2.w = cvtpk(p1[8 * s + 6], p1[8 * s + 7]);
            pb[0][s] = __builtin_bit_cast(bf16x8, a); pb[1][s] = __builtin_bit_cast(bf16x8, b2); }
#pragma unroll
        for (int hf = 0; hf < 2; ++hf)
#pragma unroll
            for (int s = 0; s < 2; ++s) { o0 = __builtin_amdgcn_mfma_f32_32x32x16_bf16(vf[0][hf][s], pb[hf][s], o0, 0, 0, 0); o1 = __builtin_amdgcn_mfma_f32_32x32x16_bf16(vf[1][hf][s], pb[hf][s], o1, 0, 0, 0); }
    }
#undef ATT_DMA
    l = swap_sum(l);
    const float inv = 1.f / l;
    bf16* orow = Op + (size_t)r32 * D + 4 * hi;
#pragma unroll
    for (int g = 0; g < 4; ++g) {
        *(u32x2*)(orow + 8 * g) = (u32x2){cvtpk(o0[4 * g] * inv, o0[4 * g + 1] * inv), cvtpk(o0[4 * g + 2] * inv, o0[4 * g + 3] * inv)};
        *(u32x2*)(orow + 32 + 8 * g) = (u32x2){cvtpk(o1[4 * g] * inv, o1[4 * g + 1] * inv), cvtpk(o1[4 * g + 2] * inv, o1[4 * g + 3] * inv)}; }
}

__device__ __forceinline__ void attn0_phase(Frame& F, const float* sinks) {
    const bf16* QKV = (const bf16*)(F.ws + WS_QKV); bf16* MIX = (bf16*)(F.ws + WS_MIX);
    const bf16* VTF = (const bf16*)(F.ws + WS_VT); const bf16* VTS = (const bf16*)(F.ws + WS_VT_SWA);
    const u32x4* KA = (const u32x4*)(F.ws + WS_KAUG);
    for (int it = 0;; ++it) {
        const int idx = it * F.G + F.blk; if (idx >= BATCH * 8 * 8) break;
        const int bh = idx & 127, jn = idx >> 7, itp = jn >> 1, base = 2 * (itp >> 1) + (jn & 1), qb = (itp & 1) ? 7 - base : base;
        const int b = bh >> 3, h = bh & 7, q0 = 256 * qb + 32 * F.wave;
        attn_unit<0>(F.lds, F.wave, F.lane, QKV + (size_t)(b * SEQ) * NQ + 512 + h * 64, VTF + (size_t)(b * 512 + h * 64) * SEQ, KA + (size_t)bh * SEQ,
                     QKV + (size_t)(b * SEQ + q0) * NQ + h * 64, MIX + (size_t)(b * SEQ + q0) * D + h * 64, q0, 0, (q0 + 32 + 63) / 64, 0, 4 * qb + 4, 0.f, nullptr);
    }
    for (int it = 0;; ++it) {
        const int idx = it * F.G + F.blk; if (idx >= BATCH * 2 * 32) break;
        const int b = (idx & 31) >> 1, kvh = idx & 1, qp = idx >> 5, h = kvh * 4 + (F.wave & 3), q0 = 64 * qp + 32 * (F.wave >> 2);
        const int lo = q0 - 127, tw_lo = lo > 0 ? lo / 64 : 0, Lo = 64 * qp - 127, T_lo = Lo > 0 ? Lo / 64 : 0;
        attn_unit<1>(F.lds, F.wave, F.lane, QKV + (size_t)(b * SEQ) * NQ + 2048 + kvh * 64, VTS + (size_t)(b * 128 + kvh * 64) * SEQ, nullptr,
                     QKV + (size_t)(b * SEQ + q0) * NQ + 1536 + h * 64, MIX + (size_t)(b * SEQ + q0) * D + 512 + h * 64, q0, tw_lo, (q0 + 32 + 63) / 64, T_lo, qp + 1,
                     sinks[h] * 1.4426950408889634f, nullptr);
    }
}
__device__ __forceinline__ void attn1_phase(Frame& F) {
    const bf16* QKV = (const bf16*)(F.ws + WS_QKV); bf16* MIX = (bf16*)(F.ws + WS_MIX);
    const bf16* VTD = (const bf16*)(F.ws + WS_VT); const unsigned long long* MB = (const unsigned long long*)(F.ws + WS_MASK);
    for (int it = 0;; ++it) {
        const int idx = it * F.G + F.blk; if (idx >= BATCH * 4 * 32) break;
        const int b = (idx & 63) >> 2, kvh = idx & 3, jn = idx >> 6, h3 = jn >> 2, a2 = jn & 3;
        const int qp = 4 * ((h3 & 1) ? 7 - (h3 >> 1) : (h3 >> 1)) + ((h3 & 1) ? 3 - a2 : a2);
        const int h = kvh * 4 + (F.wave & 3), q0 = 64 * qp + 32 * (F.wave >> 2);
        attn_unit<2>(F.lds, F.wave, F.lane, QKV + (size_t)(b * SEQ) * NQ + 1024 + kvh * 64, VTD + (size_t)(b * 256 + kvh * 64) * SEQ, nullptr,
                     QKV + (size_t)(b * SEQ + q0) * NQ + h * 64, MIX + (size_t)(b * SEQ + q0) * D + h * 64, q0, 0, qp + 1, 0, qp + 1, 0.f, MB + (size_t)(b * SEQ + q0) * 32);
    }
}

#define WRLANE(dst, val, LANE) asm("s_nop 1\n\tv_writelane_b32 %0, %1, %2" : "+v"(dst) : "s"(val), "n"(LANE))
template <int NR>
__device__ __forceinline__ unsigned select_query(const LAS float* srow_in, LAS unsigned* hist, const int q, const int lane_in, unsigned& Tprev) {
    unsigned myword = 0u;
    int lane = lane_in; asm volatile("" : "+v"(lane));
    const LAS float* srow = srow_in; asm volatile("" : "+v"(srow));
    unsigned ky[NR];
#pragma unroll
    for (int i = 0; i < NR; ++i) { const unsigned bits = __float_as_uint(srow[64 * i]); const unsigned key = (bits & 0x80000000u) ? ~bits : (bits | 0x80000000u); ky[i] = (lane <= q - 64 * i) ? key : 0u; }
#define SEL_COUNT(dst, thr) do { int c0_ = 0, c1_ = 0, c2_ = 0, c3_ = 0; \
        _Pragma("unroll") for (int i = 0; i < NR; i += 4) { c0_ += __popcll(__ballot(ky[i] >= (thr))); c1_ += __popcll(__ballot(ky[i + 1] >= (thr))); c2_ += __popcll(__ballot(ky[i + 2] >= (thr))); c3_ += __popcll(__ballot(ky[i + 3] >= (thr))); } \
        dst = (c0_ + c1_) + (c2_ + c3_); } while (0)
    unsigned Tk = 0u; bool exact = false; int above = 0;
    bool have = false;
    if (Tprev != 0u && (Tprev >> 23) != 0x1ffu) {
        const unsigned lo = Tprev & 0xff800000u, hi = lo + 0x00800000u; int clo, chi;
        SEL_COUNT(clo, lo); SEL_COUNT(chi, hi);
        if (clo >= 256 && chi < 256) { Tk = lo; above = chi; have = true; if (clo == 256) exact = true; }
    }
    if (!have) {
#pragma unroll 1
        for (int bit = 31; bit >= 23; --bit) { const unsigned cand = Tk | (1u << bit); int cnt; SEL_COUNT(cnt, cand);
            if (cnt >= 256) Tk = cand; else above = cnt;
            if (cnt == 256) { exact = true; break; } }
    }
    int lowbit = 22;
    if (!exact) {
        *(LAS u32x4*)(hist + 4 * lane) = (u32x4){0u, 0u, 0u, 0u};
#pragma unroll
        for (int i = 0; i < NR; ++i) { if ((ky[i] >> 23) == (Tk >> 23)) __hip_atomic_fetch_add(hist + ((ky[i] >> 15) & 255u), 1u, __ATOMIC_RELAXED, __HIP_MEMORY_SCOPE_WORKGROUP); }
        const u32x4 c = *(LAS u32x4*)(hist + 4 * lane);
        const int kk = 256 - above;
        const int s4 = (int)(c.x + c.y + c.z + c.w); int suf = s4;
#pragma unroll
        for (int o = 1; o < 64; o <<= 1) { const int t = __shfl_down(suf, o); if (lane + o < 64) suf += t; }
        const int ab3 = suf - s4, ab2 = ab3 + (int)c.w, ab1 = ab2 + (int)c.z, ab0 = ab1 + (int)c.y;
        int dmine = -1, kmine = 0, cmine = 0;
        if (ab3 < kk && kk <= ab3 + (int)c.w) { dmine = 4 * lane + 3; kmine = kk - ab3; cmine = (int)c.w; }
        else if (ab2 < kk && kk <= ab2 + (int)c.z) { dmine = 4 * lane + 2; kmine = kk - ab2; cmine = (int)c.z; }
        else if (ab1 < kk && kk <= ab1 + (int)c.y) { dmine = 4 * lane + 1; kmine = kk - ab1; cmine = (int)c.y; }
        else if (ab0 < kk && kk <= ab0 + (int)c.x) { dmine = 4 * lane; kmine = kk - ab0; cmine = (int)c.x; }
        const unsigned long long fb = __ballot(dmine >= 0);
        if (fb != 0ull) { const int src = __ffsll((long long)fb) - 1; const int dsel = __shfl(dmine, src), ksel = __shfl(kmine, src), csel = __shfl(cmine, src);
            Tk |= (unsigned)(dsel & 255) << 15; lowbit = 14; if (csel == ksel) exact = true; }
    }
    if (!exact) {
#pragma unroll 1
        for (int bit = lowbit; bit >= 0; --bit) { const unsigned cand = Tk | (1u << bit); int cnt; SEL_COUNT(cnt, cand);
            if (cnt >= 256) Tk = cand;
            if (cnt == 256) { exact = true; break; } }
    }
#undef SEL_COUNT
    asm volatile("" : "+v"(Tk));
    Tprev = Tk;
    if (exact) {
#pragma unroll
        for (int i = 0; i < NR; ++i) { const unsigned long long bs = __ballot(ky[i] >= Tk);
            WRLANE(myword, (unsigned)bs, 2 * i); WRLANE(myword, (unsigned)(bs >> 32), 2 * i + 1); }
    } else {
        int cgt = 0;
#pragma unroll
        for (int i = 0; i < NR; ++i) cgt += __popcll(__ballot(ky[i] > Tk));
        const int need = 256 - cgt; int running = 0;
        const unsigned long long ltmask = (1ull << lane) - 1ull;
#pragma unroll
        for (int i = 0; i < NR; ++i) { const bool eq = ky[i] == Tk; const unsigned long long beq = __ballot(eq);
            const int rank = running + __popcll(beq & ltmask); const bool sel = (ky[i] > Tk || (eq && rank < need)) && (lane <= q - 64 * i);
            const unsigned long long bs = __ballot(sel); running += __popcll(beq);
            WRLANE(myword, (unsigned)bs, 2 * i); WRLANE(myword, (unsigned)(bs >> 32), 2 * i + 1); }
    }
    return myword;
}
__device__ __forceinline__ void indexer_phase(Frame& F) {
    const bf16* QKV = (const bf16*)(F.ws + WS_QKV); const float* IW = (const float*)(F.ws + WS_IW); unsigned* MASK = (unsigned*)(F.ws + WS_MASK);
    LAS float* sc = (LAS float*)F.lds;
    constexpr int SP = 2052;
    const int fr = F.lane & 15, fq = F.lane >> 4;
    LAS unsigned* hist = (LAS unsigned*)(F.lds + 16 * SP * 4 + F.wave * 1024);
    unsigned Tprev = 0u;
#define IDX_DECODE(it_, valid_, rb_, q0_) do { const int idx_ = (it_) * F.G + F.blk; valid_ = idx_ < BATCH * 128; const int jn_ = (idx_ >> 4) & 127, h3_ = jn_ >> 4, a4_ = jn_ & 15; \
        q0_ = 16 * (16 * ((h3_ & 1) ? 7 - (h3_ >> 1) : (h3_ >> 1)) + ((h3_ & 1) ? 15 - a4_ : a4_)); rb_ = (size_t)(idx_ & 15) * SEQ; } while (0)
#define IDX_LOAD(rb_, q0_) do { const int nt_ = (q0_) / 16 + 1; const bf16* kb_ = QKV + ((rb_) + fr) * NQ + 2048 + fq * 8; \
        _Pragma("unroll") for (int k = 0; k < 8; ++k) { const int tl = F.wave + 8 * k < nt_ ? F.wave + 8 * k : 0; ik[k][0] = *(const bf16x8*)(kb_ + (size_t)tl * 16 * NQ); ik[k][1] = *(const bf16x8*)(kb_ + (size_t)tl * 16 * NQ + 32); } \
        iw0 = *(const f32x4*)(IW + ((rb_) + (q0_) + fr) * 8); iw1 = *(const f32x4*)(IW + ((rb_) + (q0_) + fr) * 8 + 4); \
        _Pragma("unroll") for (int h = 0; h < 8; ++h) _Pragma("unroll") for (int ks = 0; ks < 2; ++ks) iqf[h][ks] = *(const bf16x8*)(QKV + ((rb_) + (q0_) + fr) * NQ + 1536 + h * 64 + ks * 32 + fq * 8); } while (0)
#define IDX_TILE(IKF, tile_) do { f32x4 s_ = (f32x4){0.f, 0.f, 0.f, 0.f}; \
        _Pragma("unroll") for (int h = 0; h < 8; ++h) { f32x4 a_ = (f32x4){0.f, 0.f, 0.f, 0.f}; const float iwh = h < 4 ? iw0[h & 3] : iw1[h & 3]; \
            a_ = __builtin_amdgcn_mfma_f32_16x16x32_bf16((IKF)[0], iqf[h][0], a_, 0, 0, 0); a_ = __builtin_amdgcn_mfma_f32_16x16x32_bf16((IKF)[1], iqf[h][1], a_, 0, 0, 0); \
            _Pragma("unroll") for (int i = 0; i < 4; ++i) { const int ai_ = __float_as_int(a_[i]); const float r_ = __int_as_float(ai_ > 0 ? ai_ : 0);     asm("v_fmac_f32 %0, %1, %2" : "+v"(s_[i]) : "v"(iwh), "v"(r_)); } } \
        *(LAS f32x4*)(sc + fr * SP + (tile_) * 16 + 4 * fq) = s_; } while (0)
    bf16x8 iqf[8][2], ik[8][2]; f32x4 iw0, iw1;
    bool valid; size_t rb; int q0;
    IDX_DECODE(0, valid, rb, q0);
    if (valid && q0 + 16 > 256) IDX_LOAD(rb, q0);
    for (int it = 0; valid; ++it) {
        const bool light = q0 + 16 <= 256;
        const int ntile = light ? 0 : q0 / 16 + 1;
        if (ntile > 0) {
#pragma unroll
            for (int k = 0; k < 8; ++k) { if (F.wave + 8 * k < ntile) IDX_TILE(ik[k], F.wave + 8 * k); }
            if (ntile > 64) {
                const bf16* kb = QKV + (rb + fr) * NQ + 2048 + fq * 8;
#pragma unroll
                for (int k = 0; k < 8; ++k) { const int tl = F.wave + 64 + 8 * k < ntile ? F.wave + 64 + 8 * k : 0; ik[k][0] = *(const bf16x8*)(kb + (size_t)tl * 16 * NQ); ik[k][1] = *(const bf16x8*)(kb + (size_t)tl * 16 * NQ + 32); }
#pragma unroll
                for (int k = 0; k < 8; ++k) { if (F.wave + 64 + 8 * k < ntile) IDX_TILE(ik[k], F.wave + 64 + 8 * k); } }
        }
        __syncthreads();
        bool nvalid; size_t nrb; int nq0;
        IDX_DECODE(it + 1, nvalid, nrb, nq0);
        if (nvalid && nq0 + 16 > 256) IDX_LOAD(nrb, nq0);
#pragma unroll 1
        for (int k = 0; k < 2; ++k) {
            const int ql = 2 * F.wave + k, q = q0 + ql;
            unsigned myword = 0u;
            if (light) { const int n = q + 1 - 32 * F.lane; myword = n >= 32 ? 0xffffffffu : (n <= 0 ? 0u : ((1u << n) - 1u)); }
            else {
            const int nrb = (((q0 + 15) >> 6) + 8) >> 3;
            const LAS float* srow = sc + ql * SP + F.lane;
            if (nrb == 1) myword = select_query<8>(srow, hist, q, F.lane, Tprev); else if (nrb == 2) myword = select_query<16>(srow, hist, q, F.lane, Tprev);
            else if (nrb == 3) myword = select_query<24>(srow, hist, q, F.lane, Tprev); else myword = select_query<32>(srow, hist, q, F.lane, Tprev);
            }
            MASK[(rb + q) * 64 + F.lane] = myword;
        }
        __syncthreads();
        valid = nvalid; rb = nrb; q0 = nq0;
    }
#undef IDX_DECODE
#undef IDX_LOAD
#undef IDX_TILE
}

template <bool MOE, bool SRC_BF16>
__device__ __forceinline__ void final_phase(Frame& F, const void* src, float* out, const float* fnorm, const float* mod1) {
    const int gw = F.blk * 8 + F.wave, NGW = F.G * 8;
    int P[9]; P[0] = 0;
    if (MOE) {
#pragma unroll
        for (int e = 0; e < 8; ++e) { int ce = (int)F.ctl[CW_CNT + 64 * e]; ce = ce < 0 ? 0 : (ce > T ? T : ce); P[e + 1] = P[e] + (ce + 255) / 256; }
    }
    const bf16* Y = (const bf16*)(F.ws + WS_Y); const u32x4* tok = (const u32x4*)(F.ws + WS_TOK);
    f32x4 fn[4];
#pragma unroll
    for (int jj = 0; jj < 4; ++jj) fn[jj] = *(const f32x4*)(fnorm + 4 * F.lane + 256 * jj);
    for (int row = gw; row < T; row += NGW) {
        f32x4 v[4];
#pragma unroll
        for (int jj = 0; jj < 4; ++jj) {
            if (SRC_BF16) { const u32x2 w = ((const u32x2*)((const bf16*)src + (size_t)row * D) + F.lane)[64 * jj]; v[jj] = (f32x4){bflo(w.x), bfhi(w.x), bflo(w.y), bfhi(w.y)}; }
            else v[jj] = ((const f32x4*)((const float*)src + (size_t)row * D) + F.lane)[64 * jj]; }
        if (MOE) {
            const u32x4 ti = tok[row]; const int e1 = ti.x & 0xff, e2 = (ti.x >> 8) & 0xff; int p1 = 0, p2 = 0;
#pragma unroll
            for (int e = 0; e < 8; ++e) { if (e1 == e) p1 = P[e]; if (e2 == e) p2 = P[e]; }
            const size_t r1 = (size_t)p1 * 256 + ti.y, r2 = (size_t)p2 * 256 + ti.z; const float g1 = __uint_as_float(ti.w), g2 = 1.f - g1;
            const int b = row / SEQ;
            const u32x2* y1 = (const u32x2*)(Y + r1 * D) + F.lane; const u32x2* y2 = (const u32x2*)(Y + r2 * D) + F.lane;
#pragma unroll
            for (int jj = 0; jj < 4; ++jj) { const u32x2 a = y1[64 * jj], c = y2[64 * jj]; const f32x4 gf = *(const f32x4*)(mod1 + (size_t)b * 6144 + 5 * 1024 + 4 * F.lane + 256 * jj);
                v[jj][0] += gf[0] * (g1 * bflo(a.x) + g2 * bflo(c.x)); v[jj][1] += gf[1] * (g1 * bfhi(a.x) + g2 * bfhi(c.x));
                v[jj][2] += gf[2] * (g1 * bflo(a.y) + g2 * bflo(c.y)); v[jj][3] += gf[3] * (g1 * bfhi(a.y) + g2 * bfhi(c.y)); }
        }
        float ss = 0.f;
#pragma unroll
        for (int jj = 0; jj < 4; ++jj) ss += (v[jj][0] * v[jj][0] + v[jj][1] * v[jj][1]) + (v[jj][2] * v[jj][2] + v[jj][3] * v[jj][3]);
        const float rstd = rsqrtf(wave_sum(ss) * (1.f / D) + NORM_EPS);
        f32x4* orow = (f32x4*)(out + (size_t)row * D) + F.lane;
#pragma unroll
        for (int jj = 0; jj < 4; ++jj) orow[64 * jj] = v[jj] * rstd * fn[jj];
    }
}

constexpr int NPHASE = 17;
constexpr int LASTPH = (MK_STAGE == 0) ? 0 : (MK_STAGE == 1) ? 4 : (MK_STAGE == 2) ? 7 : (MK_STAGE == 3) ? 12 : 15;
__global__ void __launch_bounds__(512, 2) fwd_kernel(Args args) {
    extern __shared__ __attribute__((aligned(16))) unsigned char lds_raw[];
    Frame F;
    F.lds = (LAS unsigned char*)lds_raw; F.ws = args.ws; F.ctl = (unsigned*)(args.ws + WS_CTL);
    F.tid = threadIdx.x; F.lane = F.tid & 63; F.wave = __builtin_amdgcn_readfirstlane(F.tid >> 6); F.G = gridDim.x; F.blk = blockIdx.x;
    volatile LAS unsigned* MISC = (volatile LAS unsigned*)(F.lds + MISC_OFF);
    if (F.tid < 64) MISC[F.tid] = 0u;
    __syncthreads();
    XcdBarrier bar; bar.bar = F.ctl + CW_BAR; bar.x = 0; bar.st = MISC + 8;
    if (MK_ONE_LAUNCH) bar = xcd_barrier_post(F.ctl + CW_BAR, MISC + 8);
    const int lo = args.ph_lo, hi = args.ph_hi;
#define IN(k) (lo <= (k) && (k) < hi && ((k) <= LASTPH || (k) == NPHASE - 1))
#define SEAM(k) do { if (MK_ONE_LAUNCH && (k) + 1 < hi) xcd_barrier(bar); } while (0)
    const float* x = (const float*)args.in[0];
    float* mod0 = (float*)(F.ws + WS_MOD); float* mod1 = mod0 + 16 * 6144;
    bf16* Hb = (bf16*)(F.ws + WS_H); bf16* QKV = (bf16*)(F.ws + WS_QKV); bf16* MIX = (bf16*)(F.ws + WS_MIX); unsigned char* ACT0 = F.ws + WS_ACT0; unsigned char* ACT1 = F.ws + WS_ACT1; bf16* Yb = (bf16*)(F.ws + WS_Y); bf16* XR = (bf16*)(F.ws + WS_XR);
    const float* cs = (const float*)(F.ws + WS_ROPE);
    LAS unsigned char* ring = F.lds;

#define PHASE(k, ...) do { if (IN(k)) { { int l_; asm volatile("v_mbcnt_lo_u32_b32 %0, -1, 0\n\tv_mbcnt_hi_u32_b32 %0, -1, %0" : "=v"(l_)); F.lane = l_; F.tid = F.wave * 64 + l_; } __VA_ARGS__; if (MK_DUP & (1 << (k))) { xcd_barrier(bar); __VA_ARGS__; } } SEAM(k); } while (0)
    PHASE(0, { p0_prologue(F, args); q_strips(F, args); zero_kpad(F, F.ws + WS_WDN1, NE * D); });
    PHASE(1, { norm_phase<1, false, 2>(F, x, (const float*)args.in[5], mod0, 0, 1024, Hb, (const float*)args.in[7], E_IN, 1536, (const float*)args.in[8], (float*)(F.ws + WS_LOGF)); });
    const float* rsc = (const float*)(F.ws + WS_RS); const float* csc = (const float*)(F.ws + WS_CS);
    PHASE(2, { cumsum_kaug(F);
        pg8::StaticOrder S; S.init(T, NQ, D / 2, F.G, F.blk, Hb, F.ws + WS_WIN0, csc + CS_WIN0);
        pg8::EpiQKV<0> E{QKV, (bf16*)(F.ws + WS_VT), (bf16*)(F.ws + WS_VT_SWA), cs, F.lds + VT_STAGE_OFF};
        pg8::gemm_phase<pg8::EpiQKV<0>, pg8::StaticOrder, true, false, 2>(ring, D / 2, S, E, F.wave, rsc); });
    PHASE(3, attn0_phase(F, (const float*)args.in[9]));
    PHASE(4, { pg8::StaticOrder S; S.init(T, D, D, F.G, F.blk, MIX, F.ws + WS_WOUT0);
        pg8::EpiResid<true> E{x, XR, mod0 + 2048, 1.f};
        pg8::gemm_phase<pg8::EpiResid<true>, pg8::StaticOrder, true, false>(ring, D, S, E, F.wave); });
    PHASE(5, norm_phase<0, true, 2>(F, XR, (const float*)args.in[6], mod0, 3072, 4096, Hb, nullptr, 0, 0, nullptr, nullptr));
    PHASE(6, { pg8::StaticOrder S; S.init(T, 2 * FF, D / 2, F.G, F.blk, Hb, F.ws + WS_WGU0, csc + CS_WGU0);
        pg8::EpiSwiGLU<true> E{ACT0, FF, 1.f};
        pg8::gemm_phase<pg8::EpiSwiGLU<true>, pg8::StaticOrder, true, false, 2>(ring, D / 2, S, E, F.wave, rsc); });
    PHASE(7, { pg8::StaticOrder S; S.init(T, D, FF / 2, F.G, F.blk, ACT0, F.ws + WS_WDN0);
        pg8::EpiResid<false> E{nullptr, XR, mod0 + 5120, FP8_OUT_SCALE};
        pg8::gemm_phase<pg8::EpiResid<false>, pg8::StaticOrder, true, false, 1>(ring, FF / 2, S, E, F.wave); });
    PHASE(8, norm_phase<2, true, 2>(F, XR, (const float*)args.in[16], mod1, 0, 1024, Hb, (const float*)args.in[18], O_IN, 2112, nullptr, (float*)(F.ws + WS_IW)));
    PHASE(9, { pg8::StaticOrder S; S.init(T, NQ, D / 2, F.G, F.blk, Hb, F.ws + WS_WIN1, csc + CS_WIN1);
        pg8::EpiQKV<1> E{QKV, (bf16*)(F.ws + WS_VT), nullptr, cs, F.lds + VT_STAGE_OFF};
        pg8::gemm_phase<pg8::EpiQKV<1>, pg8::StaticOrder, true, false, 2>(ring, D / 2, S, E, F.wave, rsc); });
    PHASE(10, indexer_phase(F));
    PHASE(11, attn1_phase(F));
    PHASE(12, { pg8::StaticOrder S; S.init(T, D, D, F.G, F.blk, MIX, F.ws + WS_WOUT1);
        pg8::EpiResid<false> E{nullptr, XR, mod1 + 2048, 1.f};
        pg8::gemm_phase<pg8::EpiResid<false>, pg8::StaticOrder, true, false>(ring, D, S, E, F.wave); });
    PHASE(13, { zero_kpad(F, F.ws + WS_ACT1, YROWS); norm_phase<3, true, 2>(F, XR, (const float*)args.in[17], mod1, 3072, 4096, Hb, (const float*)args.in[20], 8, 0, (const float*)args.in[21], nullptr); });
    PHASE(14, { pg8::MoeOrder S; S.init(F.ctl + CW_CNT, 2 * FFE, D / 2, F.G, F.blk, Hb, F.ws + WS_WGU1, (size_t)2 * FFE * D, (const int*)(F.ws + WS_LIST), true, csc + CS_WGU1, 2 * FFE);
        pg8::EpiSwiGLU<true> E{ACT1, FFEP, 1.f};
        pg8::gemm_phase<pg8::EpiSwiGLU<true>, pg8::MoeOrder, true, true, 2>(ring, D / 2, S, E, F.wave, (const float*)(F.ws + WS_RSS)); });
    PHASE(15, { pg8::MoeOrder S; S.init(F.ctl + CW_CNT, D, FFEP / 2, F.G, F.blk, ACT1, F.ws + WS_WDN1, (size_t)D * FFEP, nullptr, false);
        pg8::EpiBf16 E{Yb, D, FP8_OUT_SCALE};
        pg8::gemm_phase<pg8::EpiBf16, pg8::MoeOrder, true, false, 1>(ring, FFEP / 2, S, E, F.wave); });
    if (IN(16)) {
        if (MK_STAGE == 0) final_phase<false, false>(F, x, args.out, (const float*)args.in[25], mod1);
        else if (MK_STAGE < 4) final_phase<false, true>(F, XR, args.out, (const float*)args.in[25], mod1);
        else final_phase<true, true>(F, XR, args.out, (const float*)args.in[25], mod1);
    }
#undef IN
#undef SEAM
#undef PHASE
}

extern "C" void kernel_launch(void* const* d_in, const int* in_sizes, int n_in, void* d_out, int out_size, void* d_ws, size_t ws_size, hipStream_t stream) {
    static int grid = 0;
    if (grid == 0) {
        if (n_in != 26 || out_size != T * D || ws_size < WS_END) { fprintf(stderr, "kernel_launch: unexpected shapes (n_in %d out %d ws %zu)\n", n_in, out_size, ws_size); grid = -1; return; }
        int dev = 0, cus = 0;
        if (hipGetDevice(&dev) != hipSuccess || hipDeviceGetAttribute(&cus, hipDeviceAttributeMultiprocessorCount, dev) != hipSuccess) { grid = -1; return; }
        if (hipFuncSetAttribute((const void*)fwd_kernel, hipFuncAttributeMaxDynamicSharedMemorySize, LDS_BYTES) != hipSuccess) { fprintf(stderr, "kernel_launch: hipFuncSetAttribute failed\n"); grid = -1; return; }
        int per_cu = 0;
        if (hipOccupancyMaxActiveBlocksPerMultiprocessor(&per_cu, (const void*)fwd_kernel, 512, LDS_BYTES) != hipSuccess || per_cu < 1) fprintf(stderr, "kernel_launch: occupancy query reports %d\n", per_cu);
        (void)hipGetLastError();
        grid = 256;
        while (grid > cus && grid > 1) grid >>= 1;
    }
    if (grid < 0) return;
    (void)hipMemsetAsync((char*)d_ws + WS_CTL, 0, CTL_ZERO_BYTES, stream);
    Args a{};
    for (int i = 0; i < 26; ++i) a.in[i] = d_in[i];
    a.out = (float*)d_out; a.ws = (unsigned char*)d_ws;
#if MK_ONE_LAUNCH
    a.ph_lo = 0; a.ph_hi = NPHASE;
    hipLaunchKernelGGL(fwd_kernel, dim3(grid), dim3(512), LDS_BYTES, stream, a);
#else
    for (int p = 0; p < NPHASE; ++p) {
        if (!(p <= LASTPH || p == NPHASE - 1)) continue;
        a.ph_lo = p; a.ph_hi = p + 1;
        hipLaunchKernelGGL(fwd_kernel, dim3(grid), dim3(512), LDS_BYTES, stream, a);
        if (p == MK_REP_PHASE) for (int r = 0; r < MK_REP_N; ++r) hipLaunchKernelGGL(fwd_kernel, dim3(grid), dim3(512), LDS_BYTES, stream, a);
    }
#endif
}
```

```cpp
#include <hip/hip_runtime.h>
#include <cstdio>
#include <cstdint>

#ifndef MK_STAGE
#define MK_STAGE 4
#endif
#ifndef MK_ONE_LAUNCH
#define MK_ONE_LAUNCH 1
#endif

#ifndef MK_REP_PHASE
#define MK_REP_PHASE -1
#define MK_REP_N 0
#endif
#ifndef MK_DUP
#define MK_DUP 0
#endif
#define GAS __attribute__((address_space(1)))
#define LAS __attribute__((address_space(3)))
typedef unsigned short bf16;
typedef unsigned u32x4 __attribute__((ext_vector_type(4)));
typedef unsigned u32x2 __attribute__((ext_vector_type(2)));
typedef float f32x4 __attribute__((ext_vector_type(4)));
typedef float f32x2 __attribute__((ext_vector_type(2)));
typedef float f32x16 __attribute__((ext_vector_type(16)));
typedef short bf16x8 __attribute__((ext_vector_type(8)));
typedef __bf16 bf16x2_t __attribute__((ext_vector_type(2)));

__device__ __forceinline__ unsigned cvtpk(float lo, float hi) { f32x2 v = {lo, hi}; bf16x2_t b = __builtin_convertvector(v, bf16x2_t); return __builtin_bit_cast(unsigned, b); }
typedef int v8i32 __attribute__((ext_vector_type(8)));
typedef int v4i32g __attribute__((ext_vector_type(4)));
__device__ __forceinline__ unsigned pack4_i8(float a, float b, float c, float d) {
    unsigned w = 0u; w = __builtin_amdgcn_cvt_pk_u8_f32(a + 128.f, 0, w); w = __builtin_amdgcn_cvt_pk_u8_f32(b + 128.f, 1, w); w = __builtin_amdgcn_cvt_pk_u8_f32(c + 128.f, 2, w); w = __builtin_amdgcn_cvt_pk_u8_f32(d + 128.f, 3, w);
    return w ^ 0x80808080u; }
typedef short bf16x16v __attribute__((ext_vector_type(16)));
constexpr float FP8_ACT_SCALE = 8.f, FP8_W_SCALE = 32.f, FP8_OUT_SCALE = 1.f / (8.f * 32.f), FP8_H_SCALE = 16.f, FP8_GU_SCALE = 1.f / (16.f * 32.f);
__device__ __forceinline__ unsigned pack4_fp8(float a, float b, float c, float d) {
    a = __builtin_amdgcn_fmed3f(a, -448.f, 448.f); b = __builtin_amdgcn_fmed3f(b, -448.f, 448.f); c = __builtin_amdgcn_fmed3f(c, -448.f, 448.f); d = __builtin_amdgcn_fmed3f(d, -448.f, 448.f);
    int w = 0; w = __builtin_amdgcn_cvt_pk_fp8_f32(a, b, w, false); w = __builtin_amdgcn_cvt_pk_fp8_f32(c, d, w, true); return (unsigned)w; }
__device__ __forceinline__ float bf2f(unsigned short b) { return __uint_as_float((unsigned)b << 16); }
__device__ __forceinline__ float bflo(unsigned w) { return __uint_as_float(w << 16); }
__device__ __forceinline__ float bfhi(unsigned w) { return __uint_as_float(w & 0xffff0000u); }

constexpr int BATCH = 16, SEQ = 2048, T = BATCH * SEQ, D = 1024;
constexpr int NQ = 2304;
constexpr int FF = 2816, FFE = 1408, NE = 8;
constexpr int FFEP = 1536;
constexpr int E_IN = 2312, O_IN = 2120;
constexpr float C2 = 0.125f * 1.4426950408889634f;
constexpr float NORM_EPS = 1e-6f;
constexpr int YROWS = 2 * T + NE * 256;

constexpr size_t MiB = 1u << 20;
constexpr size_t WS_CTL = 0, CTL_ZERO_BYTES = 1 * MiB;
constexpr size_t WS_MOD = 1 * MiB;
constexpr size_t WS_ROPE = 2 * MiB;
constexpr size_t WS_LOGF = 10 * MiB;
constexpr size_t WS_RSS = WS_LOGF;
constexpr size_t WS_KAUG = 11 * MiB;
constexpr size_t WS_IW = 15 * MiB;
constexpr size_t WS_TOK = 16 * MiB;
constexpr size_t WS_RS = 16 * MiB + 512 * 1024;
constexpr size_t WS_CS = WS_RS + 128 * 1024;
constexpr int CS_WIN0 = 0, CS_WGU0 = 2304, CS_WIN1 = CS_WGU0 + 2 * 2816, CS_WGU1 = CS_WIN1 + 2304, CS_END = CS_WGU1 + 8 * 2 * 1408;

static_assert(CS_END == 32768, "column scale table");
constexpr size_t WS_LIST = 17 * MiB;
constexpr size_t WS_MASK = 18 * MiB;
constexpr size_t WS_WIN0 = 26 * MiB, WS_WOUT0 = WS_WIN0 + (size_t)NQ * D * 2, WS_WGU0 = WS_WOUT0 + (size_t)D * D * 2, WS_WDN0 = WS_WGU0 + (size_t)2 * FF * D * 2;
constexpr size_t WS_WIN1 = WS_WDN0 + (size_t)D * FF * 2, WS_WOUT1 = WS_WIN1 + (size_t)NQ * D * 2, WS_WGU1 = WS_WOUT1 + (size_t)D * D * 2, WS_WDN1 = WS_WGU1 + (size_t)NE * 2 * FFE * D * 2;
constexpr size_t WS_WEND = WS_WDN1 + (size_t)NE * D * FFE * 2;
constexpr size_t WS_XR = 122 * MiB;
constexpr size_t WS_H = 186 * MiB;
constexpr size_t WS_Y = WS_H, WS_MIX = WS_H;
constexpr size_t WS_QKV = 250 * MiB;
constexpr size_t WS_VT = 394 * MiB;
constexpr size_t WS_VT_SWA = WS_VT + 32 * MiB;
constexpr size_t WS_ACT0 = WS_QKV;
constexpr size_t WS_ACT1 = 318 * MiB;
constexpr size_t WS_END = 500 * MiB;
static_assert(WS_WEND <= WS_XR && WS_XR + (size_t)T * D * 2 <= WS_H && WS_Y + (size_t)YROWS * D * 2 <= WS_ACT1 && WS_H + (size_t)T * D * 2 <= WS_QKV && WS_QKV + (size_t)T * NQ * 2 <= WS_VT && WS_VT_SWA + (size_t)16 * 128 * SEQ * 2 <= WS_END
              && WS_ACT0 + (size_t)T * FF * 2 <= WS_END && WS_ACT1 + (size_t)YROWS * FFE * 2 <= WS_END, "d_ws map");
constexpr int CW_TMO = 0;
constexpr int CW_BAR = 4096;
constexpr int CW_CNT = 16384;

constexpr int VT_STAGE_OFF = 131072, VT_STAGE_WAVE = 2560;
constexpr int SCR_BYTES = 151552;
constexpr int MISC_OFF = SCR_BYTES;
constexpr int GS_OFF = SCR_BYTES + 1024;
constexpr int LDS_BYTES = SCR_BYTES + 1024 + 4096;

namespace pg8 {
#define PG8_LAS __attribute__((address_space(3)))
constexpr int BM = 256, BK = 64, HALF = 128, HTB = HALF * BK * 2, NXCD = 8, WGM = 8;
__host__ __device__ __forceinline__ int lds_byte(int r, int c) { const int st = (r >> 4) * 2 + (c >> 5), rr = r & 15, cc = c & 31, ob = rr * 64 + cc * 2; return st * 1024 + (ob ^ (((ob >> 9) & 1) << 5)); }
__host__ __device__ __forceinline__ void stage_rc(int b, int& R, int& C) { const int st = b / 1024, sb = b % 1024, swz = sb ^ (((sb >> 9) & 1) << 5); R = (st >> 1) * 16 + swz / 64; C = (st & 1) * 32 + (swz % 64) / 2; }
__host__ __device__ __forceinline__ int perm32(int rho) { const int n = rho >> 4, i = rho & 15; return 8 * (i >> 2) + 4 * n + (i & 3); }
struct Unit { int pm, pn, e; };

struct StaticOrder {
    int nM, nN, nwg, G, c; const char* A; const char* B; size_t tA, tB; const float* cs;
    __device__ __forceinline__ void init(int M, int N, int K, int G_, int c_, const void* A_, const void* B_, const float* cs_ = nullptr) { nM = M / BM; nN = N / BM; nwg = nM * nN; G = G_; c = c_; A = (const char*)A_; B = (const char*)B_; tA = (size_t)BM * K * 2; tB = tA; cs = cs_; }
    __device__ __forceinline__ const float* cs_ptr(const Unit&) const { return cs; }
    __device__ __forceinline__ bool next(int i, Unit& u) const {
        const long L = (long)i * G + c; if (L >= nwg) return false;
        int wgid = (int)L; { const int q = nwg / NXCD, r = nwg % NXCD, xcd = wgid % NXCD, off = wgid / NXCD; wgid = (xcd < r ? xcd * (q + 1) : r * (q + 1) + (xcd - r) * q) + off; }
        const int nig = WGM * nN, gid = wgid / nig, fm = gid * WGM, gsz = (nM - fm) < WGM ? (nM - fm) : WGM;
        u.pm = fm + ((wgid % nig) % gsz); u.pn = (wgid % nig) / gsz; u.e = 0; return true;
    }
    __device__ __forceinline__ const char* a_base(const Unit& u) const { return A + (size_t)u.pm * tA; }
    __device__ __forceinline__ const char* b_base(const Unit& u) const { return B + (size_t)u.pn * tB; }
    __device__ __forceinline__ int arow(const Unit&, int) const { return 0; }
    __device__ __forceinline__ const float* rs_src(const Unit& u, const float* rs) const { return rs + (size_t)u.pm * BM; }
    __device__ __forceinline__ int rows_valid(const Unit&) const { return BM; }
};

struct MoeOrder {
    int nN, G, c; int P[9]; int cnt[8];
    const char* A; const char* B; size_t tA, tB, bstride; const int* list; bool gather; const float* cs; int cs_estride;
    __device__ __forceinline__ void init(const unsigned* gcnt, int N, int K, int G_, int c_, const void* A_, const void* B_, size_t bstride_, const int* list_, bool gather_, const float* cs_ = nullptr, int cs_estride_ = 0) {
        nN = N / BM; G = G_; c = c_; A = (const char*)A_; B = (const char*)B_; tA = (size_t)BM * K * 2; tB = tA; bstride = bstride_; list = list_; gather = gather_; cs = cs_; cs_estride = cs_estride_;
        P[0] = 0;
#pragma unroll
        for (int e = 0; e < 8; ++e) { int ce = (int)gcnt[64 * e]; ce = ce < 0 ? 0 : (ce > T ? T : ce); cnt[e] = ce; P[e + 1] = P[e] + (ce + 255) / 256; }
    }
    __device__ __forceinline__ bool next(int i, Unit& u) const {
        const long L = (long)i * G + c; if (L >= (long)P[8] * nN) return false;
        const int g = (int)(L / nN); u.pm = g; u.pn = (int)(L - (long)g * nN); int e = 0;
#pragma unroll
        for (int j = 1; j < 8; ++j) if (g >= P[j]) e = j;
        u.e = e; return true;
    }
    __device__ __forceinline__ const char* a_base(const Unit& u) const { return gather ? A : A + (size_t)u.pm * tA; }
    __device__ __forceinline__ const char* b_base(const Unit& u) const { return B + (size_t)u.e * bstride + (size_t)u.pn * tB; }
    __device__ __forceinline__ const float* cs_ptr(const Unit& u) const { return cs + (size_t)u.e * cs_estride; }
    __device__ __forceinline__ int arow(const Unit& u, int r) const {
        int Pe = 0, ce = 0;
#pragma unroll
        for (int j = 0; j < 8; ++j) if (u.e == j) { Pe = P[j]; ce = cnt[j]; }
        const int slot = (u.pm - Pe) * 256 + r;
        return slot < ce ? list[(size_t)u.e * T + slot] : 0;
    }
    __device__ __forceinline__ const float* rs_src(const Unit& u, const float* rs) const { int Pe = 0;
#pragma unroll
        for (int j = 0; j < 8; ++j) if (u.e == j) Pe = P[j];
        return rs + (size_t)u.e * T + (size_t)(u.pm - Pe) * BM; }
    __device__ __forceinline__ int rows_valid(const Unit& u) const { int Pe = 0, ce = 0;
#pragma unroll
        for (int j = 0; j < 8; ++j) if (u.e == j) { Pe = P[j]; ce = cnt[j]; }
        const int v = ce - (u.pm - Pe) * BM; return v < BM ? v : BM; }
};

typedef int v4i32 __attribute__((ext_vector_type(4)));
template <int OPK> struct AccSel { typedef f32x4 T; };
template <> struct AccSel<2> { typedef v4i32g T; };
template <int OPK  > struct Frag;
template <> struct Frag<0> { bf16x8 k0, k1;
    __device__ __forceinline__ void load(const PG8_LAS unsigned char* p) { k0 = *(const PG8_LAS bf16x8*)p; k1 = *(const PG8_LAS bf16x8*)(p + 1024); }
    static __device__ __forceinline__ f32x4 mma(const Frag& b, const Frag& a, f32x4 c) { c = __builtin_amdgcn_mfma_f32_16x16x32_bf16(b.k0, a.k0, c, 0, 0, 0); return __builtin_amdgcn_mfma_f32_16x16x32_bf16(b.k1, a.k1, c, 0, 0, 0); } };
template <> struct Frag<2> { v4i32g k0, k1;
    __device__ __forceinline__ void load(const PG8_LAS unsigned char* p) { k0 = *(const PG8_LAS v4i32g*)p; k1 = *(const PG8_LAS v4i32g*)(p + 1024); }
    static __device__ __forceinline__ v4i32g mma(const Frag& b, const Frag& a, v4i32g c) { c = __builtin_amdgcn_mfma_i32_16x16x64_i8(b.k0, a.k0, c, 0, 0, 0); return __builtin_amdgcn_mfma_i32_16x16x64_i8(b.k1, a.k1, c, 0, 0, 0); } };
template <> struct Frag<1> { v8i32 v;
    __device__ __forceinline__ void load(const PG8_LAS unsigned char* p) { const v4i32 lo = *(const PG8_LAS v4i32*)p, hi = *(const PG8_LAS v4i32*)(p + 1024); v = __builtin_shufflevector(lo, hi, 0, 1, 2, 3, 4, 5, 6, 7); }
    static __device__ __forceinline__ f32x4 mma(const Frag& b, const Frag& a, f32x4 c) {
        const int one = 0x7f7f7f7f; asm volatile("v_mfma_scale_f32_16x16x128_f8f6f4 %0, %1, %2, %0, %3, %3 op_sel_hi:[0,0,0]" : "+v"(c) : "v"(b.v), "v"(a.v), "v"(one)); return c; } };
template <class Epi, class Sched, bool ALIGN_EPI, bool GATHER, int OPK = 0>
__device__ __forceinline__ void gemm_phase(PG8_LAS unsigned char* lds, const int K, const Sched& S, const Epi& E, const int wave, const float* rs = nullptr) {
    int lane; asm volatile("v_mbcnt_lo_u32_b32 %0, -1, 0\n\tv_mbcnt_hi_u32_b32 %0, -1, %0" : "=v"(lane));
    const int wid = __builtin_amdgcn_readfirstlane(wave), tid = wid * 64 + lane, wr = wid >> 2, wc = wid & 3, fr = lane & 15, fq = lane >> 4;
    const int nt = K / BK;
    int Rr[2], Cc[2]; unsigned voffB[2];
#pragma unroll
    for (int i = 0; i < 2; ++i) { int R, C; stage_rc(tid * 16 + i * 8192, R, C); Rr[i] = R; Cc[i] = C; const int Rb = Epi::PERM ? ((R & ~31) + perm32(R & 31)) : R; voffB[i] = (unsigned)(Rb * K + C) * 2u; }
    const size_t kstep = (size_t)(BK * 2);
    const size_t hstep = (size_t)HALF * K * 2;
    const unsigned ldsw = (unsigned)wid * 1024u;
    const int aoff = lds_byte(wr * 64 + fr, fq * 8), boff = lds_byte(wc * 32 + fr, fq * 8);
#define PG8_SA(b, h) (((b) * 2 + (h)) * HTB)
#define PG8_SB(b, h) ((4 + (b) * 2 + (h)) * HTB)
#define PG8_STAGE(bufoff, gbase, voff) do { _Pragma("unroll") for (int _i = 0; _i < 2; ++_i) \
        __builtin_amdgcn_global_load_lds((const unsigned*)((const char*)(gbase) + (voff)[_i]), (PG8_LAS unsigned*)(lds + (bufoff) + ldsw + _i * 8192), 16, 0, 0); } while (0)
#define PG8_LDA(dst, b, h) do { _Pragma("unroll") for (int m = 0; m < 4; ++m) dst[m].load(lds + PG8_SA(b, h) + aoff + m * 2048); } while (0)
#define PG8_LDB(dst, b, h) do { _Pragma("unroll") for (int n = 0; n < 2; ++n) dst[n].load(lds + PG8_SB(b, h) + boff + n * 2048); } while (0)
#define PG8_MMA(ai, bj, At, Bt) do { __builtin_amdgcn_s_setprio(1); _Pragma("unroll") for (int m = 0; m < 4; ++m) _Pragma("unroll") for (int n = 0; n < 2; ++n) \
        acc[ai][bj][m][n] = Frag<OPK>::mma(Bt[n], At[m], acc[ai][bj][m][n]); __builtin_amdgcn_s_setprio(0); } while (0)
#define PG8_WAIT_V(n) asm volatile("s_waitcnt vmcnt(" #n ")" ::: "memory")
#define PG8_WAIT_L(n) asm volatile("s_waitcnt lgkmcnt(" #n ")" ::: "memory")
#define PG8_BAR __builtin_amdgcn_s_barrier()
#define PG8_SCHED __builtin_amdgcn_sched_barrier(0)
#define PG8_VA(dst, u) do { _Pragma("unroll") for (int _h = 0; _h < 2; ++_h) _Pragma("unroll") for (int _i = 0; _i < 2; ++_i) \
        dst[_h][_i] = GATHER ? (unsigned)S.arow(u, _h * HALF + Rr[_i]) * (unsigned)(K * 2) + (unsigned)Cc[_i] * 2u : (unsigned)((_h * HALF + Rr[_i]) * K + Cc[_i]) * 2u; } while (0)
    Unit cur, nxt; int ui = 0;
    if (!S.next(0, cur)) return;
    typedef typename AccSel<OPK>::T AccT;
    AccT acc[2][2][4][2];
#pragma unroll
    for (int a = 0; a < 2; ++a)
#pragma unroll
        for (int b = 0; b < 2; ++b)
#pragma unroll
            for (int m = 0; m < 4; ++m)
#pragma unroll
                for (int n = 0; n < 2; ++n) acc[a][b][m][n] = AccT{};
    Frag<OPK> At[4], B0[2], B1[2];
    unsigned vA[2][2], vAn[2][2];
    PG8_VA(vA, cur);
#pragma unroll
    for (int h = 0; h < 2; ++h)
#pragma unroll
        for (int i = 0; i < 2; ++i) vAn[h][i] = vA[h][i];
    const char* cA = S.a_base(cur); const char* cB = S.b_base(cur);
    PG8_STAGE(PG8_SB(0, 0), cB, voffB); PG8_STAGE(PG8_SB(0, 1), cB + hstep, voffB); PG8_STAGE(PG8_SA(0, 0), cA, vA[0]); PG8_STAGE(PG8_SA(0, 1), cA, vA[1]);
    if (wr == 1) PG8_BAR;
    PG8_WAIT_V(2); PG8_BAR;
    PG8_STAGE(PG8_SB(1, 0), cB + kstep, voffB); PG8_STAGE(PG8_SA(1, 0), cA + kstep, vA[0]); PG8_STAGE(PG8_SB(1, 1), cB + hstep + kstep, voffB);
    PG8_WAIT_V(6); PG8_BAR;
    for (;;) {
        const bool has_next = S.next(ui + 1, nxt);
        const char* nA = has_next ? S.a_base(nxt) : cA; const char* nB = has_next ? S.b_base(nxt) : cB;
        if constexpr (GATHER) { if (has_next) { PG8_VA(vAn, nxt); } }
        if constexpr (OPK == 2) {
            int ln; asm volatile("v_mbcnt_lo_u32_b32 %0, -1, 0\n\tv_mbcnt_hi_u32_b32 %0, -1, %0" : "=v"(ln));
            const float* sp = (wid < 4 ? S.rs_src(cur, rs) + 64 * wid : S.cs_ptr(cur) + cur.pn * BM + 64 * (wid - 4)) + ln;
            __builtin_amdgcn_global_load_lds((const unsigned*)sp, (PG8_LAS unsigned*)(lds + GS_OFF + (ui & 1) * 2048 + wid * 256), 4, 0, 0); }
        for (int t = 0; t < nt; t += 2) {
            const bool last = (t == nt - 2);
            const char* a1 = cA + (size_t)(t + 1) * kstep;
            const char* a2 = last ? nA : cA + (size_t)(t + 2) * kstep; const char* b2 = last ? nB : cB + (size_t)(t + 2) * kstep;
            const char* a3 = a2 + kstep; const char* b3 = b2 + kstep;
            unsigned v2[2][2];
#pragma unroll
            for (int h = 0; h < 2; ++h)
#pragma unroll
                for (int i = 0; i < 2; ++i) v2[h][i] = (GATHER && last) ? vAn[h][i] : vA[h][i];
            PG8_LDB(B0, 0, 0); PG8_LDB(B1, 0, 1); PG8_SCHED; PG8_LDA(At, 0, 0); PG8_STAGE(PG8_SA(1, 1), a1, vA[1]);
            PG8_WAIT_V(8); PG8_WAIT_L(0); PG8_BAR; PG8_MMA(0, 0, At, B0); PG8_MMA(0, 1, At, B1); PG8_BAR; PG8_SCHED;
            PG8_LDA(At, 0, 1); PG8_STAGE(PG8_SB(0, 0), b2, voffB); PG8_STAGE(PG8_SB(0, 1), b2 + hstep, voffB); PG8_STAGE(PG8_SA(0, 0), a2, v2[0]);
            PG8_WAIT_V(8); PG8_WAIT_L(0); PG8_BAR; PG8_MMA(1, 0, At, B0); PG8_MMA(1, 1, At, B1); PG8_BAR; PG8_SCHED;
            PG8_LDB(B0, 1, 0); PG8_LDB(B1, 1, 1); PG8_SCHED; PG8_LDA(At, 1, 0); PG8_STAGE(PG8_SA(0, 1), a2, v2[1]);
            PG8_WAIT_V(8); PG8_WAIT_L(0); PG8_BAR; PG8_MMA(0, 0, At, B0); PG8_MMA(0, 1, At, B1); PG8_BAR; PG8_SCHED;
            PG8_LDA(At, 1, 1); PG8_STAGE(PG8_SB(1, 0), b3, voffB); PG8_STAGE(PG8_SB(1, 1), b3 + hstep, voffB); PG8_STAGE(PG8_SA(1, 0), a3, v2[0]);
            PG8_WAIT_V(8); PG8_WAIT_L(0); PG8_BAR; PG8_MMA(1, 0, At, B0); PG8_MMA(1, 1, At, B1); PG8_BAR; PG8_SCHED;
        }
        if constexpr (ALIGN_EPI) { if (wr == 0) PG8_BAR; }
        if constexpr (OPK == 2) {
            const PG8_LAS float* gs = (const PG8_LAS float*)(lds + GS_OFF + (ui & 1) * 2048);
            const PG8_LAS float* cs = gs + 256 + wc * 32 + (Epi::PERM ? 8 * fq : 4 * fq);
            f32x4 csv[2][2]; float rsv[2][4];
#pragma unroll
            for (int bj = 0; bj < 2; ++bj)
#pragma unroll
                for (int n = 0; n < 2; ++n) csv[bj][n] = *(const PG8_LAS f32x4*)(cs + bj * HALF + (Epi::PERM ? 4 * n : 16 * n));
            const int nvalid = S.rows_valid(cur);
#pragma unroll
            for (int ai = 0; ai < 2; ++ai)
#pragma unroll
                for (int m = 0; m < 4; ++m) { const int lr = ai * HALF + wr * 64 + m * 16 + fr; const float v = gs[lr]; rsv[ai][m] = (GATHER && lr >= nvalid) ? 1.f : v; }
            if constexpr (Epi::I8FUSED) E.i8(acc, csv, rsv, cur, wr, wc, fr, fq);
            else {
            f32x4 accf[2][2][4][2];
#pragma unroll
            for (int ai = 0; ai < 2; ++ai)
#pragma unroll
                for (int bj = 0; bj < 2; ++bj)
#pragma unroll
                    for (int m = 0; m < 4; ++m)
#pragma unroll
                        for (int n = 0; n < 2; ++n) { const v4i32g a = acc[ai][bj][m][n]; accf[ai][bj][m][n] = (f32x4){(float)a[0], (float)a[1], (float)a[2], (float)a[3]} * csv[bj][n] * rsv[ai][m]; }
            E(accf, cur, wr, wc, fr, fq); }
        } else E(acc, cur, wr, wc, fr, fq);
        if (!has_next) break;
#pragma unroll
        for (int a = 0; a < 2; ++a)
#pragma unroll
            for (int b = 0; b < 2; ++b)
#pragma unroll
                for (int m = 0; m < 4; ++m)
#pragma unroll
                    for (int n = 0; n < 2; ++n) acc[a][b][m][n] = AccT{};
        cur = nxt; cA = nA; cB = nB; ++ui;
#pragma unroll
        for (int h = 0; h < 2; ++h)
#pragma unroll
            for (int i = 0; i < 2; ++i) vA[h][i] = vAn[h][i];
        if constexpr (ALIGN_EPI) { if (wr == 1) PG8_BAR; }
    }
    PG8_WAIT_V(0);
    if constexpr (!ALIGN_EPI) { if (wr == 0) PG8_BAR; }
    PG8_BAR;
#undef PG8_SA
#undef PG8_SB
#undef PG8_STAGE
#undef PG8_LDA
#undef PG8_LDB
#undef PG8_MMA
#undef PG8_WAIT_V
#undef PG8_WAIT_L
#undef PG8_BAR
#undef PG8_SCHED
#undef PG8_VA
}

template <int L> struct EpiQKV {
    static constexpr bool PERM = true; static constexpr bool I8FUSED = false;
    bf16* QKV; bf16* VT; bf16* VT2; const float* cs; PG8_LAS unsigned char* stg;
    __device__ __forceinline__ void operator()(const f32x4 (&acc)[2][2][4][2], const Unit& u, int wr, int wc, int fr, int fq) const {
        const int row0 = u.pm * BM + wr * 64 + fr, pn = u.pn;
        int kind = 0  , dst = 0; float sc = 1.f; bf16* vt = VT; int vnc = 0, vc0 = 0, vcs = 0;
        if (L == 0) {
            if (pn < 4) { kind = 0; dst = 256 * pn + wc * 32; sc = pn < 2 ? C2 : 1.f; }
            else if (pn < 6) { kind = 2; vt = VT; vnc = 512; vc0 = 256 * (pn - 4) + 32 * wc; vcs = 128; }
            else if (pn < 8) { kind = 1; dst = 1536 + (4 * (pn - 6) + wc) * 64; sc = C2; }
            else { if (wc < 2) { kind = 1; dst = 2048 + wc * 64; sc = 1.f; } else { kind = 2; vt = VT2; vnc = 128; vc0 = (wc - 2) * 32; vcs = 64; } }
        } else {
            if (pn < 4) { kind = 1; dst = (4 * pn + wc) * 64; sc = C2; }
            else if (pn == 4) { kind = 1; dst = 1024 + wc * 64; sc = 1.f; }
            else if (pn == 5) { kind = 2; vt = VT; vnc = 256; vc0 = 32 * wc; vcs = 128; }
            else if (pn < 8) { kind = 1; dst = 1536 + (4 * (pn - 6) + wc) * 64; sc = 1.f; }
            else { if (wc == 0) { kind = 1; dst = 2048; sc = 1.f; } else kind = 3; }
        }
        if (kind == 0) {
#pragma unroll
            for (int ai = 0; ai < 2; ++ai)
#pragma unroll
                for (int m = 0; m < 4; ++m) { bf16* rowp = QKV + (size_t)(row0 + ai * HALF + m * 16) * NQ + dst + 8 * fq;
#pragma unroll
                    for (int bj = 0; bj < 2; ++bj) { const f32x4 v0 = acc[ai][bj][m][0] * sc, v1 = acc[ai][bj][m][1] * sc;
                        u32x4 w; w.x = cvtpk(v0[0], v0[1]); w.y = cvtpk(v0[2], v0[3]); w.z = cvtpk(v1[0], v1[1]); w.w = cvtpk(v1[2], v1[3]);
                        *(u32x4*)(rowp + bj * HALF) = w; } }
        } else if (kind == 1) {
#pragma unroll
            for (int ai = 0; ai < 2; ++ai)
#pragma unroll
                for (int m = 0; m < 4; ++m) { const int r = row0 + ai * HALF + m * 16; const f32x4* cp = (const f32x4*)(cs + (size_t)r * 64 + 16 * fq);
                    const f32x4 t0 = cp[0], t1 = cp[1], t2 = cp[2], t3 = cp[3];
                    const f32x4 x1a = acc[ai][0][m][0], x1b = acc[ai][0][m][1], x2a = acc[ai][1][m][0], x2b = acc[ai][1][m][1];
                    float o1[8], o2[8];
                    o1[0] = x1a[0] * t0[0] - x2a[0] * t0[1]; o2[0] = x2a[0] * t0[0] + x1a[0] * t0[1];
                    o1[1] = x1a[1] * t0[2] - x2a[1] * t0[3]; o2[1] = x2a[1] * t0[2] + x1a[1] * t0[3];
                    o1[2] = x1a[2] * t1[0] - x2a[2] * t1[1]; o2[2] = x2a[2] * t1[0] + x1a[2] * t1[1];
                    o1[3] = x1a[3] * t1[2] - x2a[3] * t1[3]; o2[3] = x2a[3] * t1[2] + x1a[3] * t1[3];
                    o1[4] = x1b[0] * t2[0] - x2b[0] * t2[1]; o2[4] = x2b[0] * t2[0] + x1b[0] * t2[1];
                    o1[5] = x1b[1] * t2[2] - x2b[1] * t2[3]; o2[5] = x2b[1] * t2[2] + x1b[1] * t2[3];
                    o1[6] = x1b[2] * t3[0] - x2b[2] * t3[1]; o2[6] = x2b[2] * t3[0] + x1b[2] * t3[1];
                    o1[7] = x1b[3] * t3[2] - x2b[3] * t3[3]; o2[7] = x2b[3] * t3[2] + x1b[3] * t3[3];
                    bf16* rowp = QKV + (size_t)r * NQ + dst + 8 * fq;
                    u32x4 w; w.x = cvtpk(o1[0] * sc, o1[1] * sc); w.y = cvtpk(o1[2] * sc, o1[3] * sc); w.z = cvtpk(o1[4] * sc, o1[5] * sc); w.w = cvtpk(o1[6] * sc, o1[7] * sc);
                    *(u32x4*)(rowp) = w;
                    w.x = cvtpk(o2[0] * sc, o2[1] * sc); w.y = cvtpk(o2[2] * sc, o2[3] * sc); w.z = cvtpk(o2[4] * sc, o2[5] * sc); w.w = cvtpk(o2[6] * sc, o2[7] * sc);
                    *(u32x4*)(rowp + 32) = w; }
        } else if (kind == 2) {
            const int b = (u.pm * BM) / SEQ, s_tile = (u.pm * BM) % SEQ, lane = fq * 16 + fr;
            PG8_LAS unsigned char* sw = stg + (wr * 4 + wc) * VT_STAGE_WAVE;
#pragma unroll
            for (int ai = 0; ai < 2; ++ai)
#pragma unroll
                for (int bj = 0; bj < 2; ++bj)
#pragma unroll
                    for (int mp = 0; mp < 2; ++mp) {
#pragma unroll
                        for (int mm = 0; mm < 2; ++mm)
#pragma unroll
                            for (int n = 0; n < 2; ++n) { const f32x4 v = acc[ai][bj][2 * mp + mm][n]; const unsigned w0 = cvtpk(v[0], v[1]), w1 = cvtpk(v[2], v[3]);
                                PG8_LAS unsigned char* wp = sw + (8 * fq + 4 * n) * 80 + (16 * mm + fr) * 2;
                                *(PG8_LAS unsigned short*)(wp) = (unsigned short)w0; *(PG8_LAS unsigned short*)(wp + 80) = (unsigned short)(w0 >> 16);
                                *(PG8_LAS unsigned short*)(wp + 160) = (unsigned short)w1; *(PG8_LAS unsigned short*)(wp + 240) = (unsigned short)(w1 >> 16); }
#pragma unroll
                        for (int j = 0; j < 2; ++j) { const int colr = (lane >> 2) + 16 * j, seg = lane & 3;
                            const u32x4 v = *(const PG8_LAS u32x4*)(sw + colr * 80 + seg * 16);
                            *(u32x4*)(vt + ((size_t)b * vnc + vc0 + bj * vcs + colr) * SEQ + s_tile + ai * HALF + wr * 64 + mp * 32 + seg * 8) = v; }
                    }
        }
    }
};
template <bool FIRST> struct EpiResid {
    static constexpr bool PERM = true; static constexpr bool I8FUSED = false;
    const float* xin; bf16* XR; const float* gate; float oscale;
    __device__ __forceinline__ void operator()(const f32x4 (&acc)[2][2][4][2], const Unit& u, int wr, int wc, int fr, int fq) const {
        const int row0 = u.pm * BM + wr * 64 + fr, col0 = u.pn * BM + wc * 32 + 8 * fq; const int b = (u.pm * BM) / SEQ;
        f32x4 gv[2][2];
#pragma unroll
        for (int bj = 0; bj < 2; ++bj)
#pragma unroll
            for (int n = 0; n < 2; ++n) gv[bj][n] = *(const f32x4*)(gate + (size_t)b * 6144 + col0 + bj * HALF + 4 * n) * oscale;
#pragma unroll
        for (int ai = 0; ai < 2; ++ai)
#pragma unroll
            for (int m = 0; m < 4; ++m) { const size_t ro = (size_t)(row0 + ai * HALF + m * 16) * D + col0;
#pragma unroll
                for (int bj = 0; bj < 2; ++bj) { f32x4 b0, b1;
                    if (FIRST) { b0 = *(const f32x4*)(xin + ro + bj * HALF); b1 = *(const f32x4*)(xin + ro + bj * HALF + 4); }
                    else { const u32x4 w = *(const u32x4*)(XR + ro + bj * HALF); b0 = (f32x4){bflo(w.x), bfhi(w.x), bflo(w.y), bfhi(w.y)}; b1 = (f32x4){bflo(w.z), bfhi(w.z), bflo(w.w), bfhi(w.w)}; }
                    const f32x4 v0 = b0 + gv[bj][0] * acc[ai][bj][m][0], v1 = b1 + gv[bj][1] * acc[ai][bj][m][1];
                    u32x4 o; o.x = cvtpk(v0[0], v0[1]); o.y = cvtpk(v0[2], v0[3]); o.z = cvtpk(v1[0], v1[1]); o.w = cvtpk(v1[2], v1[3]);
                    *(u32x4*)(XR + ro + bj * HALF) = o; } }
    }
};
template <bool FP8OUT> struct EpiSwiGLU {
    static constexpr bool PERM = true; static constexpr bool I8FUSED = FP8OUT;
    __device__ __forceinline__ void i8(const v4i32g (&acc)[2][2][4][2], const f32x4 (&csv)[2][2], const float (&rsv)[2][4], const Unit& u, int wr, int wc, int fr, int fq) const {
        const int row0 = u.pm * BM + wr * 64 + fr, col0 = u.pn * HALF + wc * 32 + 8 * fq;
#pragma unroll
        for (int ai = 0; ai < 2; ++ai)
#pragma unroll
            for (int m = 0; m < 4; ++m) { float v[8]; const float rs = rsv[ai][m], rsl = rs * -1.4426950408889634f, rs2 = rs * rs * FP8_ACT_SCALE;
#pragma unroll
                for (int n = 0; n < 2; ++n)
#pragma unroll
                    for (int i = 0; i < 4; ++i) { const float G = (float)acc[ai][0][m][n][i] * csv[0][n][i], U = (float)acc[ai][1][m][n][i] * csv[1][n][i];
                        v[4 * n + i] = (G * U) * (rs2 * __builtin_amdgcn_rcpf(1.f + __builtin_amdgcn_exp2f(G * rsl))); }
                *(u32x2*)((unsigned char*)O + (size_t)(row0 + ai * HALF + m * 16) * ldc + col0) = (u32x2){pack4_fp8(v[0], v[1], v[2], v[3]), pack4_fp8(v[4], v[5], v[6], v[7])}; }
    }
    void* O; int ldc; float iscale;
    __device__ __forceinline__ void operator()(const f32x4 (&acc)[2][2][4][2], const Unit& u, int wr, int wc, int fr, int fq) const {
        const int row0 = u.pm * BM + wr * 64 + fr, col0 = u.pn * HALF + wc * 32 + 8 * fq;
#pragma unroll
        for (int ai = 0; ai < 2; ++ai)
#pragma unroll
            for (int m = 0; m < 4; ++m) { float v[8];
#pragma unroll
                for (int n = 0; n < 2; ++n)
#pragma unroll
                    for (int i = 0; i < 4; ++i) { const float g = acc[ai][0][m][n][i] * iscale, up = acc[ai][1][m][n][i] * iscale; v[4 * n + i] = g * __builtin_amdgcn_rcpf(1.f + __expf(-g)) * up; }
                if (FP8OUT) { const u32x2 w = (u32x2){pack4_fp8(v[0] * FP8_ACT_SCALE, v[1] * FP8_ACT_SCALE, v[2] * FP8_ACT_SCALE, v[3] * FP8_ACT_SCALE), pack4_fp8(v[4] * FP8_ACT_SCALE, v[5] * FP8_ACT_SCALE, v[6] * FP8_ACT_SCALE, v[7] * FP8_ACT_SCALE)};
                    *(u32x2*)((unsigned char*)O + (size_t)(row0 + ai * HALF + m * 16) * ldc + col0) = w; }
                else { u32x4 w; w.x = cvtpk(v[0], v[1]); w.y = cvtpk(v[2], v[3]); w.z = cvtpk(v[4], v[5]); w.w = cvtpk(v[6], v[7]);
                    *(u32x4*)((bf16*)O + (size_t)(row0 + ai * HALF + m * 16) * ldc + col0) = w; } }
    }
};
struct EpiBf16 {
    static constexpr bool PERM = true; static constexpr bool I8FUSED = false;
    bf16* O; int ldc; float oscale;
    __device__ __forceinline__ void operator()(const f32x4 (&acc)[2][2][4][2], const Unit& u, int wr, int wc, int fr, int fq) const {
        const int row0 = u.pm * BM + wr * 64 + fr, col0 = u.pn * BM + wc * 32 + 8 * fq;
#pragma unroll
        for (int ai = 0; ai < 2; ++ai)
#pragma unroll
            for (int m = 0; m < 4; ++m) { bf16* rowp = O + (size_t)(row0 + ai * HALF + m * 16) * ldc + col0;
#pragma unroll
                for (int bj = 0; bj < 2; ++bj) { const f32x4 v0 = acc[ai][bj][m][0] * oscale, v1 = acc[ai][bj][m][1] * oscale;
                    u32x4 w; w.x = cvtpk(v0[0], v0[1]); w.y = cvtpk(v0[2], v0[3]); w.z = cvtpk(v1[0], v1[1]); w.w = cvtpk(v1[2], v1[3]);
                    *(u32x4*)(rowp + bj * HALF) = w; } }
    }
};
}

#define XB_TMO      128
#define XB_XCNT(j)  (256  + 64 * (j))
#define XB_XSUB(j)  (1280 + 64 * (j))
#define XB_XGEN(j)  (2304 + 64 * (j))
#define XB_TOP      3328
#define XB_TOPGEN   3392
#define XCD_BAR_WORDS 3456
#define XB_SPIN_CAP (1u << 18)
__device__ __forceinline__ unsigned xb_ld(unsigned* p)              { return __hip_atomic_load(p, __ATOMIC_RELAXED, __HIP_MEMORY_SCOPE_AGENT); }
__device__ __forceinline__ unsigned xb_add(unsigned* p, unsigned v) { return __hip_atomic_fetch_add(p, v, __ATOMIC_RELAXED, __HIP_MEMORY_SCOPE_AGENT); }
__device__ __forceinline__ unsigned xb_xcc_id() { return (unsigned)__builtin_amdgcn_s_getreg((3 << 11) | 20) & 0xFu; }
#define XB_SPIN(cond, bar) do { unsigned _sp = 0; while (cond) { __builtin_amdgcn_s_sleep(1); \
    if ((++_sp & 255u) == 0u) { if (xb_ld(&(bar)[XB_TMO])) break; if (_sp > XB_SPIN_CAP) { atomicAdd(&(bar)[XB_TMO], 1u); break; } } } } while (0)
struct XcdBarrier { unsigned* bar; unsigned x; volatile LAS unsigned* st; };
__device__ __forceinline__ XcdBarrier xcd_barrier_post(unsigned* bar, volatile LAS unsigned* st) {
    XcdBarrier b; b.bar = bar; b.x = xb_xcc_id(); b.st = st;
    if (threadIdx.x == 0) (void)xb_add(&bar[XB_XCNT(b.x)], 1u);
    return b;
}
__device__ __forceinline__ void xcd_barrier_complete(unsigned* bar, unsigned x, unsigned& nloc, unsigned& nx) {
    const unsigned G = gridDim.x * gridDim.y * gridDim.z;
    unsigned sum, cnt, mine, sp = 0u;
    for (;;) {
        sum = 0u; cnt = 0u; mine = 0u;
#pragma unroll
        for (unsigned j = 0; j < 16; ++j) { const unsigned c = xb_ld(&bar[XB_XCNT(j)]); sum += c; cnt += (c > 0u) ? 1u : 0u; mine = (j == x) ? c : mine; }
        if (sum == G) break;
        __builtin_amdgcn_s_sleep(1);
        if ((++sp & 255u) == 0u) { if (xb_ld(&bar[XB_TMO])) break; if (sp > XB_SPIN_CAP) { atomicAdd(&bar[XB_TMO], 1u); break; } }
    }
    nloc = mine > 0u ? mine : 1u; nx = cnt > 0u ? cnt : 1u;
}
__device__ __forceinline__ void xcd_barrier(const XcdBarrier& b) {
    asm volatile("s_waitcnt vmcnt(0)" ::: "memory");
    __syncthreads();
    if (threadIdx.x == 0) {
        unsigned* bar = b.bar;
        __builtin_amdgcn_s_waitcnt(0);
        unsigned nloc = b.st[0], nx = b.st[1];
        if (nloc == 0u) { xcd_barrier_complete(bar, b.x, nloc, nx); b.st[0] = nloc; b.st[1] = nx; }
        const unsigned old = xb_add(&bar[XB_XSUB(b.x)], 1u);
        const unsigned gen = old / nloc;
        if (old + 1u == (gen + 1u) * nloc) {
            __builtin_amdgcn_fence(__ATOMIC_RELEASE, "agent");
            asm volatile("s_waitcnt vmcnt(0)" ::: "memory");
            const unsigned og = xb_add(&bar[XB_TOP], 1u);
            const unsigned tg = og / nx;
            if (og + 1u == (tg + 1u) * nx) xb_add(&bar[XB_TOPGEN], 1u);
            else XB_SPIN(xb_ld(&bar[XB_TOPGEN]) == tg, bar);
            __builtin_amdgcn_fence(__ATOMIC_ACQUIRE, "agent");
            xb_add(&bar[XB_XGEN(b.x)], 1u);
            asm volatile("s_waitcnt vmcnt(0)" ::: "memory");
        } else {
            XB_SPIN(xb_ld(&bar[XB_XGEN(b.x)]) == gen, bar);
            __builtin_amdgcn_fence(__ATOMIC_ACQUIRE, "agent");
            asm volatile("s_waitcnt vmcnt(0)" ::: "memory");
        }
    }
    __syncthreads();
}

#define DPP_MOV(v, CTRL) __int_as_float(__builtin_amdgcn_update_dpp(0, __float_as_int(v), (CTRL), 0xf, 0xf, true))
__device__ __forceinline__ float wave_sum(float v) {
    v += DPP_MOV(v, 0xB1); v += DPP_MOV(v, 0x4E); v += DPP_MOV(v, 0x141); v += DPP_MOV(v, 0x140);
    v += __shfl_xor(v, 16);
    auto rr = __builtin_amdgcn_permlane32_swap(__float_as_uint(v), __float_as_uint(v), false, false); return __uint_as_float(rr[0]) + __uint_as_float(rr[1]);
}
__device__ __forceinline__ float wave_max(float v) {
    v = fmaxf(v, DPP_MOV(v, 0xB1)); v = fmaxf(v, DPP_MOV(v, 0x4E)); v = fmaxf(v, DPP_MOV(v, 0x141)); v = fmaxf(v, DPP_MOV(v, 0x140));
    v = fmaxf(v, __shfl_xor(v, 16));
    auto rr = __builtin_amdgcn_permlane32_swap(__float_as_uint(v), __float_as_uint(v), false, false); return fmaxf(__uint_as_float(rr[0]), __uint_as_float(rr[1]));
}
__device__ __forceinline__ float swap_max(float v) { auto rr = __builtin_amdgcn_permlane32_swap(__float_as_uint(v), __float_as_uint(v), false, false); return fmaxf(__uint_as_float(rr[0]), __uint_as_float(rr[1])); }
__device__ __forceinline__ float swap_sum(float v) { auto rr = __builtin_amdgcn_permlane32_swap(__float_as_uint(v), __float_as_uint(v), false, false); return __uint_as_float(rr[0]) + __uint_as_float(rr[1]); }

__device__ __forceinline__ void sincos_d(double a, float& sn, float& cn) {
    const double k = __builtin_rint(a * 0.63661977236758134308);
    double r = __builtin_fma(-k, 1.57079632673412561417e+00, a);
    r = __builtin_fma(-k, 6.07710050650619224932e-11, r);
    r = __builtin_fma(-k, 2.02226624879595063154e-21, r);
    const double z = r * r;
    const double sp = r + r * z * (-1.66666666666666324348e-01 + z * (8.33333333332248946124e-03 + z * (-1.98412698298579493134e-04 + z * (2.75573137070700676789e-06 + z * (-2.50507602534068634195e-08 + z * 1.58969099521155010221e-10)))));
    const double cp = 1.0 - 0.5 * z + z * z * (4.16666666666666019037e-02 + z * (-1.38888888888741095749e-03 + z * (2.48015872894767294178e-05 + z * (-2.75573143513906633035e-07 + z * (2.08757232129817482790e-09 + z * -1.13596475577881948265e-11)))));
    const int q = ((int)k) & 3;
    const double s = (q == 0) ? sp : (q == 1) ? cp : (q == 2) ? -sp : -cp;
    const double c = (q == 0) ? cp : (q == 1) ? -sp : (q == 2) ? -cp : sp;
    sn = (float)s; cn = (float)c;
}

struct Args { const void* in[26]; float* out; unsigned char* ws; int ph_lo, ph_hi; };
struct Frame {
    LAS unsigned char* lds; unsigned* ctl; unsigned char* ws;
    int tid, lane, wave, G, blk;
};

__device__ __forceinline__ void conv_item(const float* W, int ld, int col0, bf16* WT, int K, int dstrow0, int k0, LAS float* scr, int lane) {
    if (col0 >= 0) {
#pragma unroll 8
        for (int i = 0; i < 32; ++i) { const int kk = 2 * i + (lane >> 5); scr[kk * 33 + (lane & 31)] = W[(size_t)(k0 + kk) * ld + col0 + (lane & 31)]; }
    } else {
#pragma unroll 8
        for (int i = 0; i < 32; ++i) { const int kk = 2 * i + (lane >> 5); scr[kk * 33 + (lane & 31)] = 0.f; }
    }
    asm volatile("s_waitcnt lgkmcnt(0)" ::: "memory");
    const int c = lane & 7;
#pragma unroll
    for (int j = 0; j < 4; ++j) { const int n = (lane >> 3) + 8 * j; const LAS float* s = scr + (8 * c) * 33 + n;
        u32x4 o; o.x = cvtpk(s[0 * 33], s[1 * 33]); o.y = cvtpk(s[2 * 33], s[3 * 33]); o.z = cvtpk(s[4 * 33], s[5 * 33]); o.w = cvtpk(s[6 * 33], s[7 * 33]);
        *(u32x4*)(WT + (size_t)(dstrow0 + n) * K + k0 + 8 * c) = o; }
    asm volatile("s_waitcnt lgkmcnt(0)" ::: "memory");
}
__device__ __forceinline__ void conv_item_fp8(const float* W, int ld, int col0, unsigned char* WT, int Kp, int dstrow0, int k0, LAS float* scr, int lane) {
#pragma unroll 8
    for (int i = 0; i < 32; ++i) { const int kk = 2 * i + (lane >> 5); scr[kk * 33 + (lane & 31)] = W[(size_t)(k0 + kk) * ld + col0 + (lane & 31)] * FP8_W_SCALE; }
    asm volatile("s_waitcnt lgkmcnt(0)" ::: "memory");
    const int c = lane & 7;
#pragma unroll
    for (int j = 0; j < 4; ++j) { const int n = (lane >> 3) + 8 * j; const LAS float* sp = scr + (8 * c) * 33 + n;
        const u32x2 o = (u32x2){pack4_fp8(sp[0 * 33], sp[1 * 33], sp[2 * 33], sp[3 * 33]), pack4_fp8(sp[4 * 33], sp[5 * 33], sp[6 * 33], sp[7 * 33])};
        *(u32x2*)(WT + (size_t)(dstrow0 + n) * Kp + k0 + 8 * c) = o; }
    asm volatile("s_waitcnt lgkmcnt(0)" ::: "memory");
}
__device__ __forceinline__ int map_win0(int n0) {
    const int pn = n0 >> 8, bj = (n0 >> 7) & 1, x = n0 & 127;
    if (pn < 6) return n0;
    if (pn < 8) return 1544 + (4 * (pn - 6) + (x >> 5)) * 64 + 32 * bj;
    return x < 64 ? 2056 + (x >> 5) * 64 + 32 * bj : 2184 + 64 * bj + (x - 64);
}
__device__ __forceinline__ int map_win1(int n0) {
    const int pn = n0 >> 8, bj = (n0 >> 7) & 1, x = n0 & 127;
    if (pn < 4) return (4 * pn + (x >> 5)) * 64 + 32 * bj;
    if (pn == 4) return 1024 + (x >> 5) * 64 + 32 * bj;
    if (pn == 5) return 1280 + 128 * bj + x;
    if (pn < 8) return 1536 + (4 * (pn - 6) + (x >> 5)) * 64 + 32 * bj;
    return x == 0 ? 2048 + 32 * bj : -1;
}

__device__ __forceinline__ void p0_prologue(Frame& F, const Args& a) {
    const float* c_in = (const float*)a.in[1]; const int* pos = (const int*)a.in[2];
    float* mod = (float*)(F.ws + WS_MOD);
    {
        LAS float* sl = (LAS float*)F.lds; LAS float* red = (LAS float*)(F.lds + 65536);
        bool have = false;
        for (int job = F.blk; job < 192; job += F.G) {
            if (!have) { for (int i = F.tid; i < 16 * 1024; i += 512) { const float c = c_in[i]; sl[i] = c / (1.f + __expf(-c)); } __syncthreads(); have = true; }
            const int l = job / 96, n0 = (job % 96) * 64;
            const float* W = (const float*)a.in[l == 0 ? 3 : 14] + n0 + F.lane; const float* bias = (const float*)a.in[l == 0 ? 4 : 15];
            float acc[16];
#pragma unroll
            for (int b = 0; b < 16; ++b) acc[b] = 0.f;
            const int kb = F.wave * 128;
#pragma unroll 4
            for (int k = 0; k < 128; ++k) { const float wv = W[(size_t)(kb + k) * 6144];
#pragma unroll
                for (int b = 0; b < 16; ++b) acc[b] += sl[b * 1024 + kb + k] * wv; }
#pragma unroll
            for (int b = 0; b < 16; ++b) red[(F.wave * 16 + b) * 64 + F.lane] = acc[b];
            __syncthreads();
            for (int i = F.tid; i < 16 * 64; i += 512) { const int b = i >> 6, ln = i & 63; float s = bias[n0 + ln];
#pragma unroll
                for (int w = 0; w < 8; ++w) s += red[(w * 16 + b) * 64 + ln];
                mod[((size_t)l * 16 + b) * 6144 + n0 + ln] = s; }
            __syncthreads();
        }
        __syncthreads();
    }
    {
        float* cs = (float*)(F.ws + WS_ROPE);
        for (int i = F.blk * 512 + F.tid; i < T * 32; i += F.G * 512) { const int t = i >> 5, f = i & 31;
            const float inv = exp2f(-(float)f * (13.287712379549449f / 32.f));
            const float ang = (float)pos[t] * inv; float sn, cn; sincos_d((double)ang, sn, cn);
            *(f32x2*)(cs + (size_t)i * 2) = (f32x2){cn, sn}; }
    }
    {
        LAS float* scr = (LAS float*)(F.lds + F.wave * 16384);
        const int gw = F.blk * 8 + F.wave, NGW = F.G * 8;
        constexpr int I1 = 16 * (NQ / 32), I2 = 16 * 32, I3 = 16 * (2 * FF / 32), I4 = (FF / 64) * 32, I7 = 16 * (2 * FFE / 32), I8 = (FFE / 64) * 32;
        constexpr int NITEMS = 2 * I2 + I4 + NE * I8;
        for (int it = gw; it < NITEMS; it += NGW) {
            int r = it;
            if (r < I2) { const int nb = r % 32, kb = r / 32; conv_item((const float*)a.in[10], D, 32 * nb, (bf16*)(F.ws + WS_WOUT0), D, 32 * nb, 64 * kb, scr, F.lane); continue; } r -= I2;
            if (r < I4) { const int nb = r % 32, kb = r / 32; conv_item_fp8((const float*)a.in[13], D, 32 * nb, F.ws + WS_WDN0, FF, 32 * nb, 64 * kb, scr, F.lane); continue; } r -= I4;
            if (r < I2) { const int nb = r % 32, kb = r / 32; conv_item((const float*)a.in[19], D, 32 * nb, (bf16*)(F.ws + WS_WOUT1), D, 32 * nb, 64 * kb, scr, F.lane); continue; } r -= I2;
            { const int e = r / I8; r -= e * I8; const int nb = r % 32, kb = r / 32;
                conv_item_fp8((const float*)a.in[24] + (size_t)e * FFE * D, D, 32 * nb, F.ws + WS_WDN1 + (size_t)e * D * FFEP, FFEP, 32 * nb, 64 * kb, scr, F.lane); }
        }
    }
}

struct QItem { const float* W; unsigned char* WT; int ld, col0, drow, k0, cs; };
__device__ __forceinline__ QItem q_item(int it, const Args& a, unsigned char* ws) {
    QItem q; const int kb = it & 15; int nb = it >> 4; q.k0 = 64 * kb; q.cs = 32 * nb;
    if (nb < 72) { q.W = (const float*)a.in[7]; q.ld = E_IN; q.col0 = map_win0(32 * nb); q.WT = ws + WS_WIN0; q.drow = 32 * nb; return q; } nb -= 72;
    if (nb < 176) { const int n0 = 32 * nb, pn = n0 >> 8, bj = (n0 >> 7) & 1, x = n0 & 127; q.W = (const float*)a.in[bj ? 12 : 11]; q.ld = FF; q.col0 = 128 * pn + x; q.WT = ws + WS_WGU0; q.drow = n0; return q; } nb -= 176;
    if (nb < 72) { q.W = (const float*)a.in[18]; q.ld = O_IN; q.col0 = map_win1(32 * nb); q.WT = ws + WS_WIN1; q.drow = 32 * nb; return q; } nb -= 72;
    { const int e = nb / 88; nb -= e * 88; const int n0 = 32 * nb, pn = n0 >> 8, bj = (n0 >> 7) & 1, x = n0 & 127;
      q.W = (const float*)a.in[bj ? 23 : 22] + (size_t)e * D * FFE; q.ld = FFE; q.col0 = 128 * pn + x; q.WT = ws + WS_WGU1 + (size_t)e * 2 * FFE * D; q.drow = n0; return q; }
}
__device__ __forceinline__ void q_strips(Frame& F, const Args& a) {
    LAS float* scr = (LAS float*)(F.lds + F.wave * 16384);
    LAS float* cmx = (LAS float*)(F.lds + VT_STAGE_OFF);
    float* cst = (float*)(F.ws + WS_CS);
    for (int st = F.blk; st < CS_END / 32; st += F.G) {
        const QItem q = q_item(st * 16, a, F.ws);
        float r[2][32]; float am = 0.f;
#pragma unroll
        for (int j = 0; j < 2; ++j) {
            if (q.col0 >= 0) { const float* wp = q.W + (size_t)(64 * (2 * F.wave + j) + (F.lane >> 5)) * q.ld + q.col0 + (F.lane & 31);
#pragma unroll
                for (int i = 0; i < 32; ++i) r[j][i] = wp[(size_t)(2 * i) * q.ld]; }
            else {
#pragma unroll
                for (int i = 0; i < 32; ++i) r[j][i] = 0.f; } }
#pragma unroll
        for (int j = 0; j < 2; ++j)
#pragma unroll
            for (int i = 0; i < 32; ++i) am = fmaxf(am, fabsf(r[j][i]));
        am = fmaxf(am, __shfl_xor(am, 32));
        if (F.lane < 32) cmx[F.wave * 32 + F.lane] = am;
        __syncthreads();
        am = cmx[F.lane & 31];
#pragma unroll
        for (int w = 1; w < 8; ++w) am = fmaxf(am, cmx[w * 32 + (F.lane & 31)]);
        const float inv = am > 0.f ? 127.f / am : 0.f;
        if (F.wave == 0 && F.lane < 32) cst[q.cs + F.lane] = am > 0.f ? am * (1.f / 127.f) : 1.f;
#pragma unroll
        for (int j = 0; j < 2; ++j) { const int k0 = 64 * (2 * F.wave + j);
#pragma unroll
            for (int i = 0; i < 32; ++i) scr[(2 * i + (F.lane >> 5)) * 33 + (F.lane & 31)] = rintf(r[j][i] * inv);
            asm volatile("s_waitcnt lgkmcnt(0)" ::: "memory");
            const int c = F.lane & 7;
#pragma unroll
            for (int jj = 0; jj < 4; ++jj) { const int n = (F.lane >> 3) + 8 * jj; const LAS float* sp = scr + (8 * c) * 33 + n;
                *(u32x2*)(q.WT + (size_t)(q.drow + n) * D + k0 + 8 * c) = (u32x2){pack4_i8(sp[0 * 33], sp[1 * 33], sp[2 * 33], sp[3 * 33]), pack4_i8(sp[4 * 33], sp[5 * 33], sp[6 * 33], sp[7 * 33])}; }
            asm volatile("s_waitcnt lgkmcnt(0)" ::: "memory"); }
        __syncthreads();
    }
}
__device__ __forceinline__ void zero_kpad(Frame& F, unsigned char* base, int rows) {
    constexpr int CH = (FFEP - FFE) / 16;
    for (int i = F.blk * 512 + F.tid; i < rows * CH; i += F.G * 512) { const int row = i / CH, ch = i % CH; *(u32x4*)(base + (size_t)row * FFEP + FFE + 16 * ch) = (u32x4){0u, 0u, 0u, 0u}; }
}
template <int SIDE  , bool SRC_BF16, int HOUT = 0  >
__device__ __forceinline__ void norm_phase(Frame& F, const void* src, const float* gamma, const float* modl, int sh_off, int sc_off, bf16* H,
                                           const float* Wside, int ldw, int wcol0, const float* bside, float* side_out) {
    const int rpb = T / F.G, row_lo = F.blk * rpb;
    LAS int* lcnt = (LAS int*)F.lds;
    LAS int* rinfo = (LAS int*)(F.lds + 256);
    if (SIDE == 3) { if (F.tid < 16) lcnt[F.tid] = 0; __syncthreads(); }
    float wreg[4][4][8];
    if (SIDE != 0) {
#pragma unroll
        for (int jj = 0; jj < 4; ++jj)
#pragma unroll
            for (int i = 0; i < 4; ++i) { const int k = 4 * F.lane + 256 * jj + i; const f32x4 w0 = *(const f32x4*)(Wside + (size_t)k * ldw + wcol0), w1 = *(const f32x4*)(Wside + (size_t)k * ldw + wcol0 + 4);
                wreg[jj][i][0] = w0[0]; wreg[jj][i][1] = w0[1]; wreg[jj][i][2] = w0[2]; wreg[jj][i][3] = w0[3]; wreg[jj][i][4] = w1[0]; wreg[jj][i][5] = w1[1]; wreg[jj][i][6] = w1[2]; wreg[jj][i][7] = w1[3]; }
    }
    f32x4 gm[4], av[4], shv[4];
#pragma unroll
    for (int jj = 0; jj < 4; ++jj) gm[jj] = *(const f32x4*)(gamma + 4 * F.lane + 256 * jj);
    int curb = -1;
    for (int lr = F.wave; lr < rpb; lr += 8) {
        const int row = row_lo + lr, b = row / SEQ;
        if (b != curb) { curb = b;
#pragma unroll
            for (int jj = 0; jj < 4; ++jj) { const f32x4 scv = *(const f32x4*)(modl + (size_t)b * 6144 + sc_off + 4 * F.lane + 256 * jj); shv[jj] = *(const f32x4*)(modl + (size_t)b * 6144 + sh_off + 4 * F.lane + 256 * jj); av[jj] = gm[jj] * (scv + 1.f); } }
        f32x4 v[4]; float ss = 0.f, rowscale = 1.f;
#pragma unroll
        for (int jj = 0; jj < 4; ++jj) {
            if (SRC_BF16) { const u32x2 w = ((const u32x2*)((const bf16*)src + (size_t)row * D) + F.lane)[64 * jj]; v[jj] = (f32x4){bflo(w.x), bfhi(w.x), bflo(w.y), bfhi(w.y)}; }
            else v[jj] = ((const f32x4*)((const float*)src + (size_t)row * D) + F.lane)[64 * jj];
            ss += (v[jj][0] * v[jj][0] + v[jj][1] * v[jj][1]) + (v[jj][2] * v[jj][2] + v[jj][3] * v[jj][3]); }
        const float rstd = rsqrtf(wave_sum(ss) * (1.f / D) + NORM_EPS);
        u32x2* o8 = (u32x2*)(H + (size_t)row * D) + F.lane;
#pragma unroll
        for (int jj = 0; jj < 4; ++jj) { v[jj] = v[jj] * rstd * av[jj] + shv[jj];
            if (HOUT == 1) ((unsigned*)((unsigned char*)H + (size_t)row * D) + F.lane)[64 * jj] = pack4_fp8(v[jj][0] * FP8_H_SCALE, v[jj][1] * FP8_H_SCALE, v[jj][2] * FP8_H_SCALE, v[jj][3] * FP8_H_SCALE);
            else if (HOUT == 0) o8[64 * jj] = (u32x2){cvtpk(v[jj][0], v[jj][1]), cvtpk(v[jj][2], v[jj][3])}; }
        if (HOUT == 2) {
            float am = 0.f;
#pragma unroll
            for (int jj = 0; jj < 4; ++jj) am = fmaxf(fmaxf(am, fmaxf(fabsf(v[jj][0]), fabsf(v[jj][1]))), fmaxf(fabsf(v[jj][2]), fabsf(v[jj][3])));
            am = wave_max(am);
            const float inv = am > 0.f ? 127.f / am : 0.f;
#pragma unroll
            for (int jj = 0; jj < 4; ++jj) ((unsigned*)((unsigned char*)H + (size_t)row * D) + F.lane)[64 * jj] = pack4_i8(rintf(v[jj][0] * inv), rintf(v[jj][1] * inv), rintf(v[jj][2] * inv), rintf(v[jj][3] * inv));
            rowscale = am > 0.f ? am * (1.f / 127.f) : 1.f;
            if (F.lane == 0) ((float*)(F.ws + WS_RS))[row] = rowscale;
        }
        if (SIDE != 0) {
            float s[8];
#pragma unroll
            for (int j = 0; j < 8; ++j) { float t = 0.f;
#pragma unroll
                for (int jj = 0; jj < 4; ++jj)
#pragma unroll
                    for (int i = 0; i < 4; ++i) t += v[jj][i] * wreg[jj][i][j];
                s[j] = wave_sum(t); }
            if (SIDE == 1 || SIDE == 2) {
                float mine = 0.f;
#pragma unroll
                for (int j = 0; j < 8; ++j) if (F.lane == j) mine = s[j];
                if (F.lane < 8) {
                    if (SIDE == 1) { const float z = mine + bside[F.lane]; mine = z < 0.f ? z - log1pf(__expf(z)) : -log1pf(__expf(-z)); }
                    else mine *= 0.04419417382415922f;
                    side_out[(size_t)row * 8 + F.lane] = mine; }
            } else {
                float l1 = -INFINITY, l2 = -INFINITY; int e1 = 0, e2 = 0;
#pragma unroll
                for (int j = 0; j < 8; ++j) { const float lg = s[j] + bside[j]; if (lg > l1) { l2 = l1; e2 = e1; l1 = lg; e1 = j; } else if (lg > l2) { l2 = lg; e2 = j; } }
                const float g1 = 1.f / (1.f + __expf(l2 - l1));
                if (F.lane == 0) { const int sl1 = atomicAdd((int*)&lcnt[e1], 1), sl2 = atomicAdd((int*)&lcnt[e2], 1);
                    LAS int* ri = rinfo + lr * 8; ri[0] = e1; ri[1] = e2; ri[2] = sl1; ri[3] = sl2; ri[4] = (int)__float_as_uint(g1); ri[5] = (int)__float_as_uint(rowscale); }
            }
        }
    }
    if (SIDE == 3) {
        __syncthreads();
        if (F.tid < 8) lcnt[8 + F.tid] = (int)__hip_atomic_fetch_add(F.ctl + CW_CNT + 64 * F.tid, (unsigned)lcnt[F.tid], __ATOMIC_RELAXED, __HIP_MEMORY_SCOPE_AGENT);
        __syncthreads();
        int* list = (int*)(F.ws + WS_LIST); u32x4* tok = (u32x4*)(F.ws + WS_TOK);
        for (int lr = F.tid; lr < rpb; lr += 512) { const LAS int* ri = rinfo + lr * 8; const int e1 = ri[0], e2 = ri[1]; const int s1 = lcnt[8 + e1] + ri[2], s2 = lcnt[8 + e2] + ri[3]; const int row = row_lo + lr;
            list[(size_t)e1 * T + s1] = row; list[(size_t)e2 * T + s2] = row;
            { float* rss = (float*)(F.ws + WS_RSS); const float sc = __uint_as_float((unsigned)ri[5]); rss[(size_t)e1 * T + s1] = sc; rss[(size_t)e2 * T + s2] = sc; }
            tok[row] = (u32x4){(unsigned)(e1 | (e2 << 8)), (unsigned)s1, (unsigned)s2, (unsigned)ri[4]}; }
        __syncthreads();
    }
}

__device__ __forceinline__ void cumsum_kaug(Frame& F) {
    const int gw = F.blk * 8 + F.wave;
    if (gw >= BATCH * 8) return;
    const int b = gw >> 3, h = gw & 7;
    const float* lf = (const float*)(F.ws + WS_LOGF) + (size_t)b * SEQ * 8 + h;
    float v[32]; float run = 0.f;
#pragma unroll
    for (int i = 0; i < 32; ++i) { run += lf[(size_t)(32 * F.lane + i) * 8]; v[i] = run; }
    float incl = run;
#pragma unroll
    for (int o = 1; o < 64; o <<= 1) { const float t = __shfl_up(incl, o); if (F.lane >= o) incl += t; }
    const float excl = incl - run;
    u32x4* ka = (u32x4*)(F.ws + WS_KAUG) + (size_t)gw * SEQ + 32 * F.lane;
#pragma unroll
    for (int i = 0; i < 32; ++i) { const float bias = -(excl + v[i]) * 1.4426950408889634f;
        const unsigned h1 = cvtpk(bias, 0.f) & 0xffffu; const float r1 = bias - bflo(h1);
        const unsigned h2 = cvtpk(r1, 0.f) & 0xffffu; const float r2 = r1 - bflo(h2);
        const unsigned h3 = cvtpk(r2, 0.f) & 0xffffu;
        ka[i] = (u32x4){h1 | (h2 << 16), h3, 0u, 0u}; }
}

constexpr int ATT_BUF = 17408;
template <int MODE  >
__device__ __forceinline__ void attn_unit(LAS unsigned char* lds, const int wave, const int lane,
                                          const bf16* __restrict__ Kg, const bf16* __restrict__ VTg, const u32x4* __restrict__ kaug_g,
                                          const bf16* __restrict__ Qp, bf16* __restrict__ Op, const int q0, const int tw_lo, const int tw_hi, const int T_lo, const int T_hi,
                                          const float sinkl2, const unsigned long long* __restrict__ mb) {
    const int r32 = lane & 31, hi = lane >> 5;
    bf16x8 qf[4];
#pragma unroll
    for (int d0 = 0; d0 < 4; ++d0) qf[d0] = *(const bf16x8*)(Qp + (size_t)r32 * NQ + d0 * 16 + hi * 8);
    const int kr = (r32 & ~12) | ((r32 & 4) << 1) | ((r32 & 8) >> 1);
    const int ksw = (kr >> 1) & 7, vsw = (r32 >> 1) & 7;
    int koff[4], voff[2][2];
#pragma unroll
    for (int d0 = 0; d0 < 4; ++d0) koff[d0] = kr * 128 + (((2 * d0 + hi) ^ ksw) << 4);
#pragma unroll
    for (int hf = 0; hf < 2; ++hf)
#pragma unroll
        for (int s = 0; s < 2; ++s) voff[hf][s] = 8192 + r32 * 128 + (((4 * hf + 2 * s + hi) ^ vsw) << 4);
    const int kaoff = 16384 + kr * 16;
    const int drow = 8 * wave + (lane >> 3), dc = (lane & 7) ^ ((drow >> 1) & 7);
    const bf16* ksrc = Kg + (size_t)drow * NQ + dc * 8;
    const bf16* vsrc = VTg + (size_t)drow * SEQ + dc * 8;
#define ATT_DMA(t, b) do { \
        __builtin_amdgcn_global_load_lds((const unsigned*)(ksrc + (size_t)(t) * 64 * NQ), (LAS unsigned*)(lds + (b) * ATT_BUF + wave * 1024), 16, 0, 0); \
        __builtin_amdgcn_global_load_lds((const unsigned*)(vsrc + (t) * 64), (LAS unsigned*)(lds + (b) * ATT_BUF + 8192 + wave * 1024), 16, 0, 0); \
        if (MODE == 0) { if (wave == 0) __builtin_amdgcn_global_load_lds((const unsigned*)(kaug_g + (t) * 64 + lane), (LAS unsigned*)(lds + (b) * ATT_BUF + 16384), 16, 0, 0); } } while (0)
    bf16x8 qaug = (bf16x8){0, 0, 0, 0, 0, 0, 0, 0};
    if (MODE == 0 && hi == 0) { qaug[0] = (short)0x3F80; qaug[1] = (short)0x3F80; qaug[2] = (short)0x3F80; }
    f32x16 o0, o1;
#pragma unroll
    for (int r = 0; r < 16; ++r) { o0[r] = 0.f; o1[r] = 0.f; }
    float m = (MODE == 1) ? sinkl2 : 0.f, l = (MODE == 1 && hi == 0) ? 1.f : 0.f;
    f32x16 negm;
#pragma unroll
    for (int r = 0; r < 16; ++r) negm[r] = -m;
    const int q = q0 + r32;
    asm volatile("" ::: "memory"); __builtin_amdgcn_s_barrier(); asm volatile("" ::: "memory");
    ATT_DMA(T_lo, 0);
    unsigned long long wn = 0ull;
    if (MODE == 2) wn = mb[(size_t)r32 * 32 + T_lo];
    for (int t = T_lo; t < T_hi; ++t) {
        const int buf = (t - T_lo) & 1;
        asm volatile("s_waitcnt vmcnt(0)" ::: "memory"); __builtin_amdgcn_s_barrier(); asm volatile("" ::: "memory");
        if (t + 1 < T_hi) ATT_DMA(t + 1, buf ^ 1);
        const unsigned long long w = wn;
        if (MODE == 2) { if (t + 1 < T_hi) wn = mb[(size_t)r32 * 32 + t + 1]; }
        if (t < tw_lo || t >= tw_hi) continue;
        const int key0 = t * 64;
        const LAS unsigned char* tb = lds + buf * ATT_BUF;
        f32x16 p0, p1;
#pragma unroll
        for (int d0 = 0; d0 < 4; ++d0) { const bf16x8 k0 = *(const LAS bf16x8*)(tb + koff[d0]), k1 = *(const LAS bf16x8*)(tb + 4096 + koff[d0]);
            p0 = __builtin_amdgcn_mfma_f32_32x32x16_bf16(k0, qf[d0], d0 == 0 ? negm : p0, 0, 0, 0); p1 = __builtin_amdgcn_mfma_f32_32x32x16_bf16(k1, qf[d0], d0 == 0 ? negm : p1, 0, 0, 0); }
        if (MODE == 0) { const bf16x8 a0 = *(const LAS bf16x8*)(tb + kaoff), a1 = *(const LAS bf16x8*)(tb + kaoff + 512);
            p0 = __builtin_amdgcn_mfma_f32_32x32x16_bf16(a0, qaug, p0, 0, 0, 0); p1 = __builtin_amdgcn_mfma_f32_32x32x16_bf16(a1, qaug, p1, 0, 0, 0); }
        bf16x8 vf[2][2][2];
#pragma unroll
        for (int dt = 0; dt < 2; ++dt)
#pragma unroll
            for (int hf = 0; hf < 2; ++hf)
#pragma unroll
                for (int s = 0; s < 2; ++s) vf[dt][hf][s] = *(const LAS bf16x8*)(tb + dt * 4096 + voff[hf][s]);
        if (MODE == 0) { if (key0 + 63 > q0) {
#pragma unroll
            for (int r = 0; r < 16; ++r) { const int key = key0 + 16 * (r >> 3) + 8 * hi + (r & 7); if (key > q) p0[r] = -1e30f; if (key + 32 > q) p1[r] = -1e30f; } } }
        if (MODE == 1) {
#pragma unroll
            for (int r = 0; r < 16; ++r) { const int key = key0 + 16 * (r >> 3) + 8 * hi + (r & 7); if (key > q || key <= q - 128) p0[r] = -1e30f; if (key + 32 > q || key + 32 <= q - 128) p1[r] = -1e30f; } }
        float mx = fmaxf(fmaxf(p0[0], p1[0]), p0[1]);
#pragma unroll
        for (int r = 1; r < 16; ++r) mx = fmaxf(fmaxf(mx, p1[r]), r + 1 < 16 ? p0[r + 1] : p1[r]);
        mx = swap_max(mx);
        if (__any(mx > 8.f)) {
            const float dl = fmaxf(mx, 0.f); const float f = __builtin_amdgcn_exp2f(-dl); m += dl; l *= f;
#pragma unroll
            for (int r = 0; r < 16; ++r) { o0[r] *= f; o1[r] *= f; p0[r] -= dl; p1[r] -= dl; negm[r] = -m; }
        }
#pragma unroll
        for (int r = 0; r < 16; ++r) { p0[r] = __builtin_amdgcn_exp2f(p0[r]); p1[r] = __builtin_amdgcn_exp2f(p1[r]); }
        if (MODE == 2) {
            const unsigned wlo = (unsigned)w >> (8 * hi), whi = (unsigned)(w >> 32) >> (8 * hi);
#pragma unroll
            for (int r = 0; r < 16; ++r) { const int bit = 16 * (r >> 3) + (r & 7); int m0, m1;
                asm("v_bfe_i32 %0, %1, %2, 1" : "=v"(m0) : "v"(wlo), "n"(bit)); asm("v_bfe_i32 %0, %1, %2, 1" : "=v"(m1) : "v"(whi), "n"(bit));
                p0[r] = __uint_as_float(__float_as_uint(p0[r]) & (unsigned)m0); p1[r] = __uint_as_float(__float_as_uint(p1[r]) & (unsigned)m1); }
        }
        float ls = 0.f;
#pragma unroll
        for (int r = 0; r < 16; ++r) ls += p0[r] + p1[r];
        l += ls;
        bf16x8 pb[2][2];
#pragma unroll
        for (int s = 0; s < 2; ++s) {
            u32x4 a, b2;
            a.x = cvtpk(p0[8 * s + 0], p0[8 * s + 1]); a.y = cvtpk(p0[8 * s + 2], p0[8 * s + 3]); a.z = cvtpk(p0[8 * s + 4], p0[8 * s + 5]); a.w = cvtpk(p0[8 * s + 6], p0[8 * s + 7]);
            b2.x = cvtpk(p1[8 * s + 0], p1[8 * s + 1]); b2.y = cvtpk(p1[8 * s + 2], p1[8 * s + 3]); b2.z = cvtpk(p1[8 * s + 4], p1[8 * s + 5]); b2.w = cvtpk(p1[8 * s + 6], p1[8 * s + 7]);
            pb[0][s] = __builtin_bit_cast(bf16x8, a); pb[1][s] = __builtin_bit_cast(bf16x8, b2); }
#pragma unroll
        for (int hf = 0; hf < 2; ++hf)
#pragma unroll
            for (int s = 0; s < 2; ++s) { o0 = __builtin_amdgcn_mfma_f32_32x32x16_bf16(vf[0][hf][s], pb[hf][s], o0, 0, 0, 0); o1 = __builtin_amdgcn_mfma_f32_32x32x16_bf16(vf[1][hf][s], pb[hf][s], o1, 0, 0, 0); }
    }
#undef ATT_DMA
    l = swap_sum(l);
    const float inv = 1.f / l;
    bf16* orow = Op + (size_t)r32 * D + 4 * hi;
#pragma unroll
    for (int g = 0; g < 4; ++g) {
        *(u32x2*)(orow + 8 * g) = (u32x2){cvtpk(o0[4 * g] * inv, o0[4 * g + 1] * inv), cvtpk(o0[4 * g + 2] * inv, o0[4 * g + 3] * inv)};
        *(u32x2*)(orow + 32 + 8 * g) = (u32x2){cvtpk(o1[4 * g] * inv, o1[4 * g + 1] * inv), cvtpk(o1[4 * g + 2] * inv, o1[4 * g + 3] * inv)}; }
}

__device__ __forceinline__ void attn0_phase(Frame& F, const float* sinks) {
    const bf16* QKV = (const bf16*)(F.ws + WS_QKV); bf16* MIX = (bf16*)(F.ws + WS_MIX);
    const bf16* VTF = (const bf16*)(F.ws + WS_VT); const bf16* VTS = (const bf16*)(F.ws + WS_VT_SWA);
    const u32x4* KA = (const u32x4*)(F.ws + WS_KAUG);
    for (int it = 0;; ++it) {
        const int idx = it * F.G + F.blk; if (idx >= BATCH * 8 * 8) break;
        const int bh = idx & 127, jn = idx >> 7, itp = jn >> 1, base = 2 * (itp >> 1) + (jn & 1), qb = (itp & 1) ? 7 - base : base;
        const int b = bh >> 3, h = bh & 7, q0 = 256 * qb + 32 * F.wave;
        attn_unit<0>(F.lds, F.wave, F.lane, QKV + (size_t)(b * SEQ) * NQ + 512 + h * 64, VTF + (size_t)(b * 512 + h * 64) * SEQ, KA + (size_t)bh * SEQ,
                     QKV + (size_t)(b * SEQ + q0) * NQ + h * 64, MIX + (size_t)(b * SEQ + q0) * D + h * 64, q0, 0, (q0 + 32 + 63) / 64, 0, 4 * qb + 4, 0.f, nullptr);
    }
    for (int it = 0;; ++it) {
        const int idx = it * F.G + F.blk; if (idx >= BATCH * 2 * 32) break;
        const int b = (idx & 31) >> 1, kvh = idx & 1, qp = idx >> 5, h = kvh * 4 + (F.wave & 3), q0 = 64 * qp + 32 * (F.wave >> 2);
        const int lo = q0 - 127, tw_lo = lo > 0 ? lo / 64 : 0, Lo = 64 * qp - 127, T_lo = Lo > 0 ? Lo / 64 : 0;
        attn_unit<1>(F.lds, F.wave, F.lane, QKV + (size_t)(b * SEQ) * NQ + 2048 + kvh * 64, VTS + (size_t)(b * 128 + kvh * 64) * SEQ, nullptr,
                     QKV + (size_t)(b * SEQ + q0) * NQ + 1536 + h * 64, MIX + (size_t)(b * SEQ + q0) * D + 512 + h * 64, q0, tw_lo, (q0 + 32 + 63) / 64, T_lo, qp + 1,
                     sinks[h] * 1.4426950408889634f, nullptr);
    }
}
__device__ __forceinline__ void attn1_phase(Frame& F) {
    const bf16* QKV = (const bf16*)(F.ws + WS_QKV); bf16* MIX = (bf16*)(F.ws + WS_MIX);
    const bf16* VTD = (const bf16*)(F.ws + WS_VT); const unsigned long long* MB = (const unsigned long long*)(F.ws + WS_MASK);
    for (int it = 0;; ++it) {
        const int idx = it * F.G + F.blk; if (idx >= BATCH * 4 * 32) break;
        const int b = (idx & 63) >> 2, kvh = idx & 3, jn = idx >> 6, h3 = jn >> 2, a2 = jn & 3;
        const int qp = 4 * ((h3 & 1) ? 7 - (h3 >> 1) : (h3 >> 1)) + ((h3 & 1) ? 3 - a2 : a2);
        const int h = kvh * 4 + (F.wave & 3), q0 = 64 * qp + 32 * (F.wave >> 2);
        attn_unit<2>(F.lds, F.wave, F.lane, QKV + (size_t)(b * SEQ) * NQ + 1024 + kvh * 64, VTD + (size_t)(b * 256 + kvh * 64) * SEQ, nullptr,
                     QKV + (size_t)(b * SEQ + q0) * NQ + h * 64, MIX + (size_t)(b * SEQ + q0) * D + h * 64, q0, 0, qp + 1, 0, qp + 1, 0.f, MB + (size_t)(b * SEQ + q0) * 32);
    }
}

#define WRLANE(dst, val, LANE) asm("s_nop 1\n\tv_writelane_b32 %0, %1, %2" : "+v"(dst) : "s"(val), "n"(LANE))
template <int NR>
__device__ __forceinline__ unsigned select_query(const LAS float* srow_in, LAS unsigned* hist, const int q, const int lane_in, unsigned& Tprev) {
    unsigned myword = 0u;
    int lane = lane_in; asm volatile("" : "+v"(lane));
    const LAS float* srow = srow_in; asm volatile("" : "+v"(srow));
    unsigned ky[NR];
#pragma unroll
    for (int i = 0; i < NR; ++i) { const unsigned bits = __float_as_uint(srow[64 * i]); const unsigned key = (bits & 0x80000000u) ? ~bits : (bits | 0x80000000u); ky[i] = (lane <= q - 64 * i) ? key : 0u; }
#define SEL_COUNT(dst, thr) do { int c0_ = 0, c1_ = 0, c2_ = 0, c3_ = 0; \
        _Pragma("unroll") for (int i = 0; i < NR; i += 4) { c0_ += __popcll(__ballot(ky[i] >= (thr))); c1_ += __popcll(__ballot(ky[i + 1] >= (thr))); c2_ += __popcll(__ballot(ky[i + 2] >= (thr))); c3_ += __popcll(__ballot(ky[i + 3] >= (thr))); } \
        dst = (c0_ + c1_) + (c2_ + c3_); } while (0)
    unsigned Tk = 0u; bool exact = false; int above = 0;
    bool have = false;
    if (Tprev != 0u && (Tprev >> 23) != 0x1ffu) {
        const unsigned lo = Tprev & 0xff800000u, hi = lo + 0x00800000u; int clo, chi;
        SEL_COUNT(clo, lo); SEL_COUNT(chi, hi);
        if (clo >= 256 && chi < 256) { Tk = lo; above = chi; have = true; if (clo == 256) exact = true; }
    }
    if (!have) {
#pragma unroll 1
        for (int bit = 31; bit >= 23; --bit) { const unsigned cand = Tk | (1u << bit); int cnt; SEL_COUNT(cnt, cand);
            if (cnt >= 256) Tk = cand; else above = cnt;
            if (cnt == 256) { exact = true; break; } }
    }
    int lowbit = 22;
    if (!exact) {
        *(LAS u32x4*)(hist + 4 * lane) = (u32x4){0u, 0u, 0u, 0u};
#pragma unroll
        for (int i = 0; i < NR; ++i) { if ((ky[i] >> 23) == (Tk >> 23)) __hip_atomic_fetch_add(hist + ((ky[i] >> 15) & 255u), 1u, __ATOMIC_RELAXED, __HIP_MEMORY_SCOPE_WORKGROUP); }
        const u32x4 c = *(LAS u32x4*)(hist + 4 * lane);
        const int kk = 256 - above;
        const int s4 = (int)(c.x + c.y + c.z + c.w); int suf = s4;
#pragma unroll
        for (int o = 1; o < 64; o <<= 1) { const int t = __shfl_down(suf, o); if (lane + o < 64) suf += t; }
        const int ab3 = suf - s4, ab2 = ab3 + (int)c.w, ab1 = ab2 + (int)c.z, ab0 = ab1 + (int)c.y;
        int dmine = -1, kmine = 0, cmine = 0;
        if (ab3 < kk && kk <= ab3 + (int)c.w) { dmine = 4 * lane + 3; kmine = kk - ab3; cmine = (int)c.w; }
        else if (ab2 < kk && kk <= ab2 + (int)c.z) { dmine = 4 * lane + 2; kmine = kk - ab2; cmine = (int)c.z; }
        else if (ab1 < kk && kk <= ab1 + (int)c.y) { dmine = 4 * lane + 1; kmine = kk - ab1; cmine = (int)c.y; }
        else if (ab0 < kk && kk <= ab0 + (int)c.x) { dmine = 4 * lane; kmine = kk - ab0; cmine = (int)c.x; }
        const unsigned long long fb = __ballot(dmine >= 0);
        if (fb != 0ull) { const int src = __ffsll((long long)fb) - 1; const int dsel = __shfl(dmine, src), ksel = __shfl(kmine, src), csel = __shfl(cmine, src);
            Tk |= (unsigned)(dsel & 255) << 15; lowbit = 14; if (csel == ksel) exact = true; }
    }
    if (!exact) {
#pragma unroll 1
        for (int bit = lowbit; bit >= 0; --bit) { const unsigned cand = Tk | (1u << bit); int cnt; SEL_COUNT(cnt, cand);
            if (cnt >= 256) Tk = cand;
            if (cnt == 256) { exact = true; break; } }
    }
#undef SEL_COUNT
    asm volatile("" : "+v"(Tk));
    Tprev = Tk;
    if (exact) {
#pragma unroll
        for (int i = 0; i < NR; ++i) { const unsigned long long bs = __ballot(ky[i] >= Tk);
            WRLANE(myword, (unsigned)bs, 2 * i); WRLANE(myword, (unsigned)(bs >> 32), 2 * i + 1); }
    } else {
        int cgt = 0;
#pragma unroll
        for (int i = 0; i < NR; ++i) cgt += __popcll(__ballot(ky[i] > Tk));
        const int need = 256 - cgt; int running = 0;
        const unsigned long long ltmask = (1ull << lane) - 1ull;
#pragma unroll
        for (int i = 0; i < NR; ++i) { const bool eq = ky[i] == Tk; const unsigned long long beq = __ballot(eq);
            const int rank = running + __popcll(beq & ltmask); const bool sel = (ky[i] > Tk || (eq && rank < need)) && (lane <= q - 64 * i);
            const unsigned long long bs = __ballot(sel); running += __popcll(beq);
            WRLANE(myword, (unsigned)bs, 2 * i); WRLANE(myword, (unsigned)(bs >> 32), 2 * i + 1); }
    }
    return myword;
}
__device__ __forceinline__ void indexer_phase(Frame& F) {
    const bf16* QKV = (const bf16*)(F.ws + WS_QKV); const float* IW = (const float*)(F.ws + WS_IW); unsigned* MASK = (unsigned*)(F.ws + WS_MASK);
    LAS float* sc = (LAS float*)F.lds;
    constexpr int SP = 2052;
    const int fr = F.lane & 15, fq = F.lane >> 4;
    LAS unsigned* hist = (LAS unsigned*)(F.lds + 16 * SP * 4 + F.wave * 1024);
    unsigned Tprev = 0u;
#define IDX_DECODE(it_, valid_, rb_, q0_) do { const int idx_ = (it_) * F.G + F.blk; valid_ = idx_ < BATCH * 128; const int jn_ = (idx_ >> 4) & 127, h3_ = jn_ >> 4, a4_ = jn_ & 15; \
        q0_ = 16 * (16 * ((h3_ & 1) ? 7 - (h3_ >> 1) : (h3_ >> 1)) + ((h3_ & 1) ? 15 - a4_ : a4_)); rb_ = (size_t)(idx_ & 15) * SEQ; } while (0)
#define IDX_LOAD(rb_, q0_) do { const int nt_ = (q0_) / 16 + 1; const bf16* kb_ = QKV + ((rb_) + fr) * NQ + 2048 + fq * 8; \
        _Pragma("unroll") for (int k = 0; k < 8; ++k) { const int tl = F.wave + 8 * k < nt_ ? F.wave + 8 * k : 0; ik[k][0] = *(const bf16x8*)(kb_ + (size_t)tl * 16 * NQ); ik[k][1] = *(const bf16x8*)(kb_ + (size_t)tl * 16 * NQ + 32); } \
        iw0 = *(const f32x4*)(IW + ((rb_) + (q0_) + fr) * 8); iw1 = *(const f32x4*)(IW + ((rb_) + (q0_) + fr) * 8 + 4); \
        _Pragma("unroll") for (int h = 0; h < 8; ++h) _Pragma("unroll") for (int ks = 0; ks < 2; ++ks) iqf[h][ks] = *(const bf16x8*)(QKV + ((rb_) + (q0_) + fr) * NQ + 1536 + h * 64 + ks * 32 + fq * 8); } while (0)
#define IDX_TILE(IKF, tile_) do { f32x4 s_ = (f32x4){0.f, 0.f, 0.f, 0.f}; \
        _Pragma("unroll") for (int h = 0; h < 8; ++h) { f32x4 a_ = (f32x4){0.f, 0.f, 0.f, 0.f}; const float iwh = h < 4 ? iw0[h & 3] : iw1[h & 3]; \
            a_ = __builtin_amdgcn_mfma_f32_16x16x32_bf16((IKF)[0], iqf[h][0], a_, 0, 0, 0); a_ = __builtin_amdgcn_mfma_f32_16x16x32_bf16((IKF)[1], iqf[h][1], a_, 0, 0, 0); \
            _Pragma("unroll") for (int i = 0; i < 4; ++i) { const int ai_ = __float_as_int(a_[i]); const float r_ = __int_as_float(ai_ > 0 ? ai_ : 0);     asm("v_fmac_f32 %0, %1, %2" : "+v"(s_[i]) : "v"(iwh), "v"(r_)); } } \
        *(LAS f32x4*)(sc + fr * SP + (tile_) * 16 + 4 * fq) = s_; } while (0)
    bf16x8 iqf[8][2], ik[8][2]; f32x4 iw0, iw1;
    bool valid; size_t rb; int q0;
    IDX_DECODE(0, valid, rb, q0);
    if (valid && q0 + 16 > 256) IDX_LOAD(rb, q0);
    for (int it = 0; valid; ++it) {
        const bool light = q0 + 16 <= 256;
        const int ntile = light ? 0 : q0 / 16 + 1;
        if (ntile > 0) {
#pragma unroll
            for (int k = 0; k < 8; ++k) { if (F.wave + 8 * k < ntile) IDX_TILE(ik[k], F.wave + 8 * k); }
            if (ntile > 64) {
                const bf16* kb = QKV + (rb + fr) * NQ + 2048 + fq * 8;
#pragma unroll
                for (int k = 0; k < 8; ++k) { const int tl = F.wave + 64 + 8 * k < ntile ? F.wave + 64 + 8 * k : 0; ik[k][0] = *(const bf16x8*)(kb + (size_t)tl * 16 * NQ); ik[k][1] = *(const bf16x8*)(kb + (size_t)tl * 16 * NQ + 32); }
#pragma unroll
                for (int k = 0; k < 8; ++k) { if (F.wave + 64 + 8 * k < ntile) IDX_TILE(ik[k], F.wave + 64 + 8 * k); } }
        }
        __syncthreads();
        bool nvalid; size_t nrb; int nq0;
        IDX_DECODE(it + 1, nvalid, nrb, nq0);
        if (nvalid && nq0 + 16 > 256) IDX_LOAD(nrb, nq0);
#pragma unroll 1
        for (int k = 0; k < 2; ++k) {
            const int ql = 2 * F.wave + k, q = q0 + ql;
            unsigned myword = 0u;
            if (light) { const int n = q + 1 - 32 * F.lane; myword = n >= 32 ? 0xffffffffu : (n <= 0 ? 0u : ((1u << n) - 1u)); }
            else {
            const int nrb = (((q0 + 15) >> 6) + 8) >> 3;
            const LAS float* srow = sc + ql * SP + F.lane;
            if (nrb == 1) myword = select_query<8>(srow, hist, q, F.lane, Tprev); else if (nrb == 2) myword = select_query<16>(srow, hist, q, F.lane, Tprev);
            else if (nrb == 3) myword = select_query<24>(srow, hist, q, F.lane, Tprev); else myword = select_query<32>(srow, hist, q, F.lane, Tprev);
            }
            MASK[(rb + q) * 64 + F.lane] = myword;
        }
        __syncthreads();
        valid = nvalid; rb = nrb; q0 = nq0;
    }
#undef IDX_DECODE
#undef IDX_LOAD
#undef IDX_TILE
}

template <bool MOE, bool SRC_BF16>
__device__ __forceinline__ void final_phase(Frame& F, const void* src, float* out, const float* fnorm, const float* mod1) {
    const int gw = F.blk * 8 + F.wave, NGW = F.G * 8;
    int P[9]; P[0] = 0;
    if (MOE) {
#pragma unroll
        for (int e = 0; e < 8; ++e) { int ce = (int)F.ctl[CW_CNT + 64 * e]; ce = ce < 0 ? 0 : (ce > T ? T : ce); P[e + 1] = P[e] + (ce + 255) / 256; }
    }
    const bf16* Y = (const bf16*)(F.ws + WS_Y); const u32x4* tok = (const u32x4*)(F.ws + WS_TOK);
    f32x4 fn[4];
#pragma unroll
    for (int jj = 0; jj < 4; ++jj) fn[jj] = *(const f32x4*)(fnorm + 4 * F.lane + 256 * jj);
    for (int row = gw; row < T; row += NGW) {
        f32x4 v[4];
#pragma unroll
        for (int jj = 0; jj < 4; ++jj) {
            if (SRC_BF16) { const u32x2 w = ((const u32x2*)((const bf16*)src + (size_t)row * D) + F.lane)[64 * jj]; v[jj] = (f32x4){bflo(w.x), bfhi(w.x), bflo(w.y), bfhi(w.y)}; }
            else v[jj] = ((const f32x4*)((const float*)src + (size_t)row * D) + F.lane)[64 * jj]; }
        if (MOE) {
            const u32x4 ti = tok[row]; const int e1 = ti.x & 0xff, e2 = (ti.x >> 8) & 0xff; int p1 = 0, p2 = 0;
#pragma unroll
            for (int e = 0; e < 8; ++e) { if (e1 == e) p1 = P[e]; if (e2 == e) p2 = P[e]; }
            const size_t r1 = (size_t)p1 * 256 + ti.y, r2 = (size_t)p2 * 256 + ti.z; const float g1 = __uint_as_float(ti.w), g2 = 1.f - g1;
            const int b = row / SEQ;
            const u32x2* y1 = (const u32x2*)(Y + r1 * D) + F.lane; const u32x2* y2 = (const u32x2*)(Y + r2 * D) + F.lane;
#pragma unroll
            for (int jj = 0; jj < 4; ++jj) { const u32x2 a = y1[64 * jj], c = y2[64 * jj]; const f32x4 gf = *(const f32x4*)(mod1 + (size_t)b * 6144 + 5 * 1024 + 4 * F.lane + 256 * jj);
                v[jj][0] += gf[0] * (g1 * bflo(a.x) + g2 * bflo(c.x)); v[jj][1] += gf[1] * (g1 * bfhi(a.x) + g2 * bfhi(c.x));
                v[jj][2] += gf[2] * (g1 * bflo(a.y) + g2 * bflo(c.y)); v[jj][3] += gf[3] * (g1 * bfhi(a.y) + g2 * bfhi(c.y)); }
        }
        float ss = 0.f;
#pragma unroll
        for (int jj = 0; jj < 4; ++jj) ss += (v[jj][0] * v[jj][0] + v[jj][1] * v[jj][1]) + (v[jj][2] * v[jj][2] + v[jj][3] * v[jj][3]);
        const float rstd = rsqrtf(wave_sum(ss) * (1.f / D) + NORM_EPS);
        f32x4* orow = (f32x4*)(out + (size_t)row * D) + F.lane;
#pragma unroll
        for (int jj = 0; jj < 4; ++jj) orow[64 * jj] = v[jj] * rstd * fn[jj];
    }
}

constexpr int NPHASE = 17;
constexpr int LASTPH = (MK_STAGE == 0) ? 0 : (MK_STAGE == 1) ? 4 : (MK_STAGE == 2) ? 7 : (MK_STAGE == 3) ? 12 : 15;
__global__ void __launch_bounds__(512, 2) fwd_kernel(Args args) {
    extern __shared__ __attribute__((aligned(16))) unsigned char lds_raw[];
    Frame F;
    F.lds = (LAS unsigned char*)lds_raw; F.ws = args.ws; F.ctl = (unsigned*)(args.ws + WS_CTL);
    F.tid = threadIdx.x; F.lane = F.tid & 63; F.wave = __builtin_amdgcn_readfirstlane(F.tid >> 6); F.G = gridDim.x; F.blk = blockIdx.x;
    volatile LAS unsigned* MISC = (volatile LAS unsigned*)(F.lds + MISC_OFF);
    if (F.tid < 64) MISC[F.tid] = 0u;
    __syncthreads();
    XcdBarrier bar; bar.bar = F.ctl + CW_BAR; bar.x = 0; bar.st = MISC + 8;
    if (MK_ONE_LAUNCH) bar = xcd_barrier_post(F.ctl + CW_BAR, MISC + 8);
    const int lo = args.ph_lo, hi = args.ph_hi;
#define IN(k) (lo <= (k) && (k) < hi && ((k) <= LASTPH || (k) == NPHASE - 1))
#define SEAM(k) do { if (MK_ONE_LAUNCH && (k) + 1 < hi) xcd_barrier(bar); } while (0)
    const float* x = (const float*)args.in[0];
    float* mod0 = (float*)(F.ws + WS_MOD); float* mod1 = mod0 + 16 * 6144;
    bf16* Hb = (bf16*)(F.ws + WS_H); bf16* QKV = (bf16*)(F.ws + WS_QKV); bf16* MIX = (bf16*)(F.ws + WS_MIX); unsigned char* ACT0 = F.ws + WS_ACT0; unsigned char* ACT1 = F.ws + WS_ACT1; bf16* Yb = (bf16*)(F.ws + WS_Y); bf16* XR = (bf16*)(F.ws + WS_XR);
    const float* cs = (const float*)(F.ws + WS_ROPE);
    LAS unsigned char* ring = F.lds;

#define PHASE(k, ...) do { if (IN(k)) { { int l_; asm volatile("v_mbcnt_lo_u32_b32 %0, -1, 0\n\tv_mbcnt_hi_u32_b32 %0, -1, %0" : "=v"(l_)); F.lane = l_; F.tid = F.wave * 64 + l_; } __VA_ARGS__; if (MK_DUP & (1 << (k))) { xcd_barrier(bar); __VA_ARGS__; } } SEAM(k); } while (0)
    PHASE(0, { p0_prologue(F, args); q_strips(F, args); zero_kpad(F, F.ws + WS_WDN1, NE * D); });
    PHASE(1, { norm_phase<1, false, 2>(F, x, (const float*)args.in[5], mod0, 0, 1024, Hb, (const float*)args.in[7], E_IN, 1536, (const float*)args.in[8], (float*)(F.ws + WS_LOGF)); });
    const float* rsc = (const float*)(F.ws + WS_RS); const float* csc = (const float*)(F.ws + WS_CS);
    PHASE(2, { cumsum_kaug(F);
        pg8::StaticOrder S; S.init(T, NQ, D / 2, F.G, F.blk, Hb, F.ws + WS_WIN0, csc + CS_WIN0);
        pg8::EpiQKV<0> E{QKV, (bf16*)(F.ws + WS_VT), (bf16*)(F.ws + WS_VT_SWA), cs, F.lds + VT_STAGE_OFF};
        pg8::gemm_phase<pg8::EpiQKV<0>, pg8::StaticOrder, true, false, 2>(ring, D / 2, S, E, F.wave, rsc); });
    PHASE(3, attn0_phase(F, (const float*)args.in[9]));
    PHASE(4, { pg8::StaticOrder S; S.init(T, D, D, F.G, F.blk, MIX, F.ws + WS_WOUT0);
        pg8::EpiResid<true> E{x, XR, mod0 + 2048, 1.f};
        pg8::gemm_phase<pg8::EpiResid<true>, pg8::StaticOrder, true, false>(ring, D, S, E, F.wave); });
    PHASE(5, norm_phase<0, true, 2>(F, XR, (const float*)args.in[6], mod0, 3072, 4096, Hb, nullptr, 0, 0, nullptr, nullptr));
    PHASE(6, { pg8::StaticOrder S; S.init(T, 2 * FF, D / 2, F.G, F.blk, Hb, F.ws + WS_WGU0, csc + CS_WGU0);
        pg8::EpiSwiGLU<true> E{ACT0, FF, 1.f};
        pg8::gemm_phase<pg8::EpiSwiGLU<true>, pg8::StaticOrder, true, false, 2>(ring, D / 2, S, E, F.wave, rsc); });
    PHASE(7, { pg8::StaticOrder S; S.init(T, D, FF / 2, F.G, F.blk, ACT0, F.ws + WS_WDN0);
        pg8::EpiResid<false> E{nullptr, XR, mod0 + 5120, FP8_OUT_SCALE};
        pg8::gemm_phase<pg8::EpiResid<false>, pg8::StaticOrder, true, false, 1>(ring, FF / 2, S, E, F.wave); });
    PHASE(8, norm_phase<2, true, 2>(F, XR, (const float*)args.in[16], mod1, 0, 1024, Hb, (const float*)args.in[18], O_IN, 2112, nullptr, (float*)(F.ws + WS_IW)));
    PHASE(9, { pg8::StaticOrder S; S.init(T, NQ, D / 2, F.G, F.blk, Hb, F.ws + WS_WIN1, csc + CS_WIN1);
        pg8::EpiQKV<1> E{QKV, (bf16*)(F.ws + WS_VT), nullptr, cs, F.lds + VT_STAGE_OFF};
        pg8::gemm_phase<pg8::EpiQKV<1>, pg8::StaticOrder, true, false, 2>(ring, D / 2, S, E, F.wave, rsc); });
    PHASE(10, indexer_phase(F));
    PHASE(11, attn1_phase(F));
    PHASE(12, { pg8::StaticOrder S; S.init(T, D, D, F.G, F.blk, MIX, F.ws + WS_WOUT1);
        pg8::EpiResid<false> E{nullptr, XR, mod1 + 2048, 1.f};
        pg8::gemm_phase<pg8::EpiResid<false>, pg8::StaticOrder, true, false>(ring, D, S, E, F.wave); });
    PHASE(13, { zero_kpad(F, F.ws + WS_ACT1, YROWS); norm_phase<3, true, 2>(F, XR, (const float*)args.in[17], mod1, 3072, 4096, Hb, (const float*)args.in[20], 8, 0, (const float*)args.in[21], nullptr); });
    PHASE(14, { pg8::MoeOrder S; S.init(F.ctl + CW_CNT, 2 * FFE, D / 2, F.G, F.blk, Hb, F.ws + WS_WGU1, (size_t)2 * FFE * D, (const int*)(F.ws + WS_LIST), true, csc + CS_WGU1, 2 * FFE);
        pg8::EpiSwiGLU<true> E{ACT1, FFEP, 1.f};
        pg8::gemm_phase<pg8::EpiSwiGLU<true>, pg8::MoeOrder, true, true, 2>(ring, D / 2, S, E, F.wave, (const float*)(F.ws + WS_RSS)); });
    PHASE(15, { pg8::MoeOrder S; S.init(F.ctl + CW_CNT, D, FFEP / 2, F.G, F.blk, ACT1, F.ws + WS_WDN1, (size_t)D * FFEP, nullptr, false);
        pg8::EpiBf16 E{Yb, D, FP8_OUT_SCALE};
        pg8::gemm_phase<pg8::EpiBf16, pg8::MoeOrder, true, false, 1>(ring, FFEP / 2, S, E, F.wave); });
    if (IN(16)) {
        if (MK_STAGE == 0) final_phase<false, false>(F, x, args.out, (const float*)args.in[25], mod1);
        else if (MK_STAGE < 4) final_phase<false, true>(F, XR, args.out, (const float*)args.in[25], mod1);
        else final_phase<true, true>(F, XR, args.out, (const float*)args.in[25], mod1);
    }
#undef IN
#undef SEAM
#undef PHASE
}

extern "C" void kernel_launch(void* const* d_in, const int* in_sizes, int n_in, void* d_out, int out_size, void* d_ws, size_t ws_size, hipStream_t stream) {
    static int grid = 0;
    if (grid == 0) {
        if (n_in != 26 || out_size != T * D || ws_size < WS_END) { fprintf(stderr, "kernel_launch: unexpected shapes (n_in %d out %d ws %zu)\n", n_in, out_size, ws_size); grid = -1; return; }
        int dev = 0, cus = 0;
        if (hipGetDevice(&dev) != hipSuccess || hipDeviceGetAttribute(&cus, hipDeviceAttributeMultiprocessorCount, dev) != hipSuccess) { grid = -1; return; }
        if (hipFuncSetAttribute((const void*)fwd_kernel, hipFuncAttributeMaxDynamicSharedMemorySize, LDS_BYTES) != hipSuccess) { fprintf(stderr, "kernel_launch: hipFuncSetAttribute failed\n"); grid = -1; return; }
        int per_cu = 0;
        if (hipOccupancyMaxActiveBlocksPerMultiprocessor(&per_cu, (const void*)fwd_kernel, 512, LDS_BYTES) != hipSuccess || per_cu < 1) fprintf(stderr, "kernel_launch: occupancy query reports %d\n", per_cu);
        (void)hipGetLastError();
        grid = 256;
        while (grid > cus && grid > 1) grid >>= 1;
    }
    if (grid < 0) return;
    (void)hipMemsetAsync((char*)d_ws + WS_CTL, 0, CTL_ZERO_BYTES, stream);
    Args a{};
    for (int i = 0; i < 26; ++i) a.in[i] = d_in[i];
    a.out = (float*)d_out; a.ws = (unsigned char*)d_ws;
#if MK_ONE_LAUNCH
    a.ph_lo = 0; a.ph_hi = NPHASE;
    hipLaunchKernelGGL(fwd_kernel, dim3(grid), dim3(512), LDS_BYTES, stream, a);
#else
    for (int p = 0; p < NPHASE; ++p) {
        if (!(p <= LASTPH || p == NPHASE - 1)) continue;
        a.ph_lo = p; a.ph_hi = p + 1;
        hipLaunchKernelGGL(fwd_kernel, dim3(grid), dim3(512), LDS_BYTES, stream, a);
        if (p == MK_REP_PHASE) for (int r = 0; r < MK_REP_N; ++r) hipLaunchKernelGGL(fwd_kernel, dim3(grid), dim3(512), LDS_BYTES, stream, a);
    }
#endif
}
```

```cpp
#include <hip/hip_runtime.h>
#include <cstdio>
#include <cstdint>

#ifndef MK_STAGE
#define MK_STAGE 4
#endif
#ifndef MK_ONE_LAUNCH
#define MK_ONE_LAUNCH 1
#endif

#ifndef MK_REP_PHASE
#define MK_REP_PHASE -1
#define MK_REP_N 0
#endif
#ifndef MK_DUP
#define MK_DUP 0
#endif
#define GAS __attribute__((address_space(1)))
#define LAS __attribute__((address_space(3)))
typedef unsigned short bf16;
typedef unsigned u32x4 __attribute__((ext_vector_type(4)));
typedef unsigned u32x2 __attribute__((ext_vector_type(2)));
typedef float f32x4 __attribute__((ext_vector_type(4)));
typedef float f32x2 __attribute__((ext_vector_type(2)));
typedef float f32x16 __attribute__((ext_vector_type(16)));
typedef short bf16x8 __attribute__((ext_vector_type(8)));
typedef __bf16 bf16x2_t __attribute__((ext_vector_type(2)));

__device__ __forceinline__ unsigned cvtpk(float lo, float hi) { f32x2 v = {lo, hi}; bf16x2_t b = __builtin_convertvector(v, bf16x2_t); return __builtin_bit_cast(unsigned, b); }
typedef int v8i32 __attribute__((ext_vector_type(8)));
typedef int v4i32g __attribute__((ext_vector_type(4)));
__device__ __forceinline__ unsigned pack4_i8(float a, float b, float c, float d) {
    unsigned w = 0u; w = __builtin_amdgcn_cvt_pk_u8_f32(a + 128.f, 0, w); w = __builtin_amdgcn_cvt_pk_u8_f32(b + 128.f, 1, w); w = __builtin_amdgcn_cvt_pk_u8_f32(c + 128.f, 2, w); w = __builtin_amdgcn_cvt_pk_u8_f32(d + 128.f, 3, w);
    return w ^ 0x80808080u; }
typedef short bf16x16v __attribute__((ext_vector_type(16)));
constexpr float FP8_ACT_SCALE = 8.f, FP8_W_SCALE = 32.f, FP8_OUT_SCALE = 1.f / (8.f * 32.f), FP8_H_SCALE = 16.f, FP8_GU_SCALE = 1.f / (16.f * 32.f);
__device__ __forceinline__ unsigned pack4_fp8(float a, float b, float c, float d) {
    a = __builtin_amdgcn_fmed3f(a, -448.f, 448.f); b = __builtin_amdgcn_fmed3f(b, -448.f, 448.f); c = __builtin_amdgcn_fmed3f(c, -448.f, 448.f); d = __builtin_amdgcn_fmed3f(d, -448.f, 448.f);
    int w = 0; w = __builtin_amdgcn_cvt_pk_fp8_f32(a, b, w, false); w = __builtin_amdgcn_cvt_pk_fp8_f32(c, d, w, true); return (unsigned)w; }
__device__ __forceinline__ float bf2f(unsigned short b) { return __uint_as_float((unsigned)b << 16); }
__device__ __forceinline__ float bflo(unsigned w) { return __uint_as_float(w << 16); }
__device__ __forceinline__ float bfhi(unsigned w) { return __uint_as_float(w & 0xffff0000u); }

constexpr int BATCH = 16, SEQ = 2048, T = BATCH * SEQ, D = 1024;
constexpr int NQ = 2304;
constexpr int FF = 2816, FFE = 1408, NE = 8;
constexpr int FFEP = 1536;
constexpr int E_IN = 2312, O_IN = 2120;
constexpr float C2 = 0.125f * 1.4426950408889634f;
constexpr float NORM_EPS = 1e-6f;
constexpr int YROWS = 2 * T + NE * 256;

constexpr size_t MiB = 1u << 20;
constexpr size_t WS_CTL = 0, CTL_ZERO_BYTES = 1 * MiB;
constexpr size_t WS_MOD = 1 * MiB;
constexpr size_t WS_ROPE = 2 * MiB;
constexpr size_t WS_LOGF = 10 * MiB;
constexpr size_t WS_RSS = WS_LOGF;
constexpr size_t WS_KAUG = 11 * MiB;
constexpr size_t WS_IW = 15 * MiB;
constexpr size_t WS_TOK = 16 * MiB;
constexpr size_t WS_RS = 16 * MiB + 512 * 1024;
constexpr size_t WS_CS = WS_RS + 128 * 1024;
constexpr int CS_WIN0 = 0, CS_WGU0 = 2304, CS_WIN1 = CS_WGU0 + 2 * 2816, CS_WGU1 = CS_WIN1 + 2304, CS_END = CS_WGU1 + 8 * 2 * 1408;

static_assert(CS_END == 32768, "column scale table");
constexpr size_t WS_LIST = 17 * MiB;
constexpr size_t WS_MASK = 18 * MiB;
constexpr size_t WS_WIN0 = 26 * MiB, WS_WOUT0 = WS_WIN0 + (size_t)NQ * D * 2, WS_WGU0 = WS_WOUT0 + (size_t)D * D * 2, WS_WDN0 = WS_WGU0 + (size_t)2 * FF * D * 2;
constexpr size_t WS_WIN1 = WS_WDN0 + (size_t)D * FF * 2, WS_WOUT1 = WS_WIN1 + (size_t)NQ * D * 2, WS_WGU1 = WS_WOUT1 + (size_t)D * D * 2, WS_WDN1 = WS_WGU1 + (size_t)NE * 2 * FFE * D * 2;
constexpr size_t WS_WEND = WS_WDN1 + (size_t)NE * D * FFE * 2;
constexpr size_t WS_XR = 122 * MiB;
constexpr size_t WS_H = 186 * MiB;
constexpr size_t WS_Y = WS_H, WS_MIX = WS_H;
constexpr size_t WS_QKV = 250 * MiB;
constexpr size_t WS_VT = 394 * MiB;
constexpr size_t WS_VT_SWA = WS_VT + 32 * MiB;
constexpr size_t WS_ACT0 = WS_QKV;
constexpr size_t WS_ACT1 = 318 * MiB;
constexpr size_t WS_END = 500 * MiB;
static_assert(WS_WEND <= WS_XR && WS_XR + (size_t)T * D * 2 <= WS_H && WS_Y + (size_t)YROWS * D * 2 <= WS_ACT1 && WS_H + (size_t)T * D * 2 <= WS_QKV && WS_QKV + (size_t)T * NQ * 2 <= WS_VT && WS_VT_SWA + (size_t)16 * 128 * SEQ * 2 <= WS_END
              && WS_ACT0 + (size_t)T * FF * 2 <= WS_END && WS_ACT1 + (size_t)YROWS * FFE * 2 <= WS_END, "d_ws map");
constexpr int CW_TMO = 0;
constexpr int CW_BAR = 4096;
constexpr int CW_CNT = 16384;

constexpr int VT_STAGE_OFF = 131072, VT_STAGE_WAVE = 2560;
constexpr int SCR_BYTES = 151552;
constexpr int MISC_OFF = SCR_BYTES;
constexpr int GS_OFF = SCR_BYTES + 1024;
constexpr int LDS_BYTES = SCR_BYTES + 1024 + 4096;

namespace pg8 {
#define PG8_LAS __attribute__((address_space(3)))
constexpr int BM = 256, BK = 64, HALF = 128, HTB = HALF * BK * 2, NXCD = 8, WGM = 8;
__host__ __device__ __forceinline__ int lds_byte(int r, int c) { const int st = (r >> 4) * 2 + (c >> 5), rr = r & 15, cc = c & 31, ob = rr * 64 + cc * 2; return st * 1024 + (ob ^ (((ob >> 9) & 1) << 5)); }
__host__ __device__ __forceinline__ void stage_rc(int b, int& R, int& C) { const int st = b / 1024, sb = b % 1024, swz = sb ^ (((sb >> 9) & 1) << 5); R = (st >> 1) * 16 + swz / 64; C = (st & 1) * 32 + (swz % 64) / 2; }
__host__ __device__ __forceinline__ int perm32(int rho) { const int n = rho >> 4, i = rho & 15; return 8 * (i >> 2) + 4 * n + (i & 3); }
struct Unit { int pm, pn, e; };

struct StaticOrder {
    int nM, nN, nwg, G, c; const char* A; const char* B; size_t tA, tB; const float* cs;
    __device__ __forceinline__ void init(int M, int N, int K, int G_, int c_, const void* A_, const void* B_, const float* cs_ = nullptr) { nM = M / BM; nN = N / BM; nwg = nM * nN; G = G_; c = c_; A = (const char*)A_; B = (const char*)B_; tA = (size_t)BM * K * 2; tB = tA; cs = cs_; }
    __device__ __forceinline__ const float* cs_ptr(const Unit&) const { return cs; }
    __device__ __forceinline__ bool next(int i, Unit& u) const {
        const long L = (long)i * G + c; if (L >= nwg) return false;
        int wgid = (int)L; { const int q = nwg / NXCD, r = nwg % NXCD, xcd = wgid % NXCD, off = wgid / NXCD; wgid = (xcd < r ? xcd * (q + 1) : r * (q + 1) + (xcd - r) * q) + off; }
        const int nig = WGM * nN, gid = wgid / nig, fm = gid * WGM, gsz = (nM - fm) < WGM ? (nM - fm) : WGM;
        u.pm = fm + ((wgid % nig) % gsz); u.pn = (wgid % nig) / gsz; u.e = 0; return true;
    }
    __device__ __forceinline__ const char* a_base(const Unit& u) const { return A + (size_t)u.pm * tA; }
    __device__ __forceinline__ const char* b_base(const Unit& u) const { return B + (size_t)u.pn * tB; }
    __device__ __forceinline__ int arow(const Unit&, int) const { return 0; }
    __device__ __forceinline__ const float* rs_src(const Unit& u, const float* rs) const { return rs + (size_t)u.pm * BM; }
    __device__ __forceinline__ int rows_valid(const Unit&) const { return BM; }
};

struct MoeOrder {
    int nN, G, c; int P[9]; int cnt[8];
    const char* A; const char* B; size_t tA, tB, bstride; const int* list; bool gather; const float* cs; int cs_estride;
    __device__ __forceinline__ void init(const unsigned* gcnt, int N, int K, int G_, int c_, const void* A_, const void* B_, size_t bstride_, const int* list_, bool gather_, const float* cs_ = nullptr, int cs_estride_ = 0) {
        nN = N / BM; G = G_; c = c_; A = (const char*)A_; B = (const char*)B_; tA = (size_t)BM * K * 2; tB = tA; bstride = bstride_; list = list_; gather = gather_; cs = cs_; cs_estride = cs_estride_;
        P[0] = 0;
#pragma unroll
        for (int e = 0; e < 8; ++e) { int ce = (int)gcnt[64 * e]; ce = ce < 0 ? 0 : (ce > T ? T : ce); cnt[e] = ce; P[e + 1] = P[e] + (ce + 255) / 256; }
    }
    __device__ __forceinline__ bool next(int i, Unit& u) const {
        const long L = (long)i * G + c; if (L >= (long)P[8] * nN) return false;
        const int g = (int)(L / nN); u.pm = g; u.pn = (int)(L - (long)g * nN); int e = 0;
#pragma unroll
        for (int j = 1; j < 8; ++j) if (g >= P[j]) e = j;
        u.e = e; return true;
    }
    __device__ __forceinline__ const char* a_base(const Unit& u) const { return gather ? A : A + (size_t)u.pm * tA; }
    __device__ __forceinline__ const char* b_base(const Unit& u) const { return B + (size_t)u.e * bstride + (size_t)u.pn * tB; }
    __device__ __forceinline__ const float* cs_ptr(const Unit& u) const { return cs + (size_t)u.e * cs_estride; }
    __device__ __forceinline__ int arow(const Unit& u, int r) const {
        int Pe = 0, ce = 0;
#pragma unroll
        for (int j = 0; j < 8; ++j) if (u.e == j) { Pe = P[j]; ce = cnt[j]; }
        const int slot = (u.pm - Pe) * 256 + r;
        return slot < ce ? list[(size_t)u.e * T + slot] : 0;
    }
    __device__ __forceinline__ const float* rs_src(const Unit& u, const float* rs) const { int Pe = 0;
#pragma unroll
        for (int j = 0; j < 8; ++j) if (u.e == j) Pe = P[j];
        return rs + (size_t)u.e * T + (size_t)(u.pm - Pe) * BM; }
    __device__ __forceinline__ int rows_valid(const Unit& u) const { int Pe = 0, ce = 0;
#pragma unroll
        for (int j = 0; j < 8; ++j) if (u.e == j) { Pe = P[j]; ce = cnt[j]; }
        const int v = ce - (u.pm - Pe) * BM; return v < BM ? v : BM; }
};

typedef int v4i32 __attribute__((ext_vector_type(4)));
template <int OPK> struct AccSel { typedef f32x4 T; };
template <> struct AccSel<2> { typedef v4i32g T; };
template <int OPK  > struct Frag;
template <> struct Frag<0> { bf16x8 k0, k1;
    __device__ __forceinline__ void load(const PG8_LAS unsigned char* p) { k0 = *(const PG8_LAS bf16x8*)p; k1 = *(const PG8_LAS bf16x8*)(p + 1024); }
    static __device__ __forceinline__ f32x4 mma(const Frag& b, const Frag& a, f32x4 c) { c = __builtin_amdgcn_mfma_f32_16x16x32_bf16(b.k0, a.k0, c, 0, 0, 0); return __builtin_amdgcn_mfma_f32_16x16x32_bf16(b.k1, a.k1, c, 0, 0, 0); } };
template <> struct Frag<2> { v4i32g k0, k1;
    __device__ __forceinline__ void load(const PG8_LAS unsigned char* p) { k0 = *(const PG8_LAS v4i32g*)p; k1 = *(const PG8_LAS v4i32g*)(p + 1024); }
    static __device__ __forceinline__ v4i32g mma(const Frag& b, const Frag& a, v4i32g c) { c = __builtin_amdgcn_mfma_i32_16x16x64_i8(b.k0, a.k0, c, 0, 0, 0); return __builtin_amdgcn_mfma_i32_16x16x64_i8(b.k1, a.k1, c, 0, 0, 0); } };
template <> struct Frag<1> { v8i32 v;
    __device__ __forceinline__ void load(const PG8_LAS unsigned char* p) { const v4i32 lo = *(const PG8_LAS v4i32*)p, hi = *(const PG8_LAS v4i32*)(p + 1024); v = __builtin_shufflevector(lo, hi, 0, 1, 2, 3, 4, 5, 6, 7); }
    static __device__ __forceinline__ f32x4 mma(const Frag& b, const Frag& a, f32x4 c) {
        const int one = 0x7f7f7f7f; asm volatile("v_mfma_scale_f32_16x16x128_f8f6f4 %0, %1, %2, %0, %3, %3 op_sel_hi:[0,0,0]" : "+v"(c) : "v"(b.v), "v"(a.v), "v"(one)); return c; } };
template <class Epi, class Sched, bool ALIGN_EPI, bool GATHER, int OPK = 0>
__device__ __forceinline__ void gemm_phase(PG8_LAS unsigned char* lds, const int K, const Sched& S, const Epi& E, const int wave, const float* rs = nullptr) {
    int lane; asm volatile("v_mbcnt_lo_u32_b32 %0, -1, 0\n\tv_mbcnt_hi_u32_b32 %0, -1, %0" : "=v"(lane));
    const int wid = __builtin_amdgcn_readfirstlane(wave), tid = wid * 64 + lane, wr = wid >> 2, wc = wid & 3, fr = lane & 15, fq = lane >> 4;
    const int nt = K / BK;
    int Rr[2], Cc[2]; unsigned voffB[2];
#pragma unroll
    for (int i = 0; i < 2; ++i) { int R, C; stage_rc(tid * 16 + i * 8192, R, C); Rr[i] = R; Cc[i] = C; const int Rb = Epi::PERM ? ((R & ~31) + perm32(R & 31)) : R; voffB[i] = (unsigned)(Rb * K + C) * 2u; }
    const size_t kstep = (size_t)(BK * 2);
    const size_t hstep = (size_t)HALF * K * 2;
    const unsigned ldsw = (unsigned)wid * 1024u;
    const int aoff = lds_byte(wr * 64 + fr, fq * 8), boff = lds_byte(wc * 32 + fr, fq * 8);
#define PG8_SA(b, h) (((b) * 2 + (h)) * HTB)
#define PG8_SB(b, h) ((4 + (b) * 2 + (h)) * HTB)
#define PG8_STAGE(bufoff, gbase, voff) do { _Pragma("unroll") for (int _i = 0; _i < 2; ++_i) \
        __builtin_amdgcn_global_load_lds((const unsigned*)((const char*)(gbase) + (voff)[_i]), (PG8_LAS unsigned*)(lds + (bufoff) + ldsw + _i * 8192), 16, 0, 0); } while (0)
#define PG8_LDA(dst, b, h) do { _Pragma("unroll") for (int m = 0; m < 4; ++m) dst[m].load(lds + PG8_SA(b, h) + aoff + m * 2048); } while (0)
#define PG8_LDB(dst, b, h) do { _Pragma("unroll") for (int n = 0; n < 2; ++n) dst[n].load(lds + PG8_SB(b, h) + boff + n * 2048); } while (0)
#define PG8_MMA(ai, bj, At, Bt) do { __builtin_amdgcn_s_setprio(1); _Pragma("unroll") for (int m = 0; m < 4; ++m) _Pragma("unroll") for (int n = 0; n < 2; ++n) \
        acc[ai][bj][m][n] = Frag<OPK>::mma(Bt[n], At[m], acc[ai][bj][m][n]); __builtin_amdgcn_s_setprio(0); } while (0)
#define PG8_WAIT_V(n) asm volatile("s_waitcnt vmcnt(" #n ")" ::: "memory")
#define PG8_WAIT_L(n) asm volatile("s_waitcnt lgkmcnt(" #n ")" ::: "memory")
#define PG8_BAR __builtin_amdgcn_s_barrier()
#define PG8_SCHED __builtin_amdgcn_sched_barrier(0)
#define PG8_VA(dst, u) do { _Pragma("unroll") for (int _h = 0; _h < 2; ++_h) _Pragma("unroll") for (int _i = 0; _i < 2; ++_i) \
        dst[_h][_i] = GATHER ? (unsigned)S.arow(u, _h * HALF + Rr[_i]) * (unsigned)(K * 2) + (unsigned)Cc[_i] * 2u : (unsigned)((_h * HALF + Rr[_i]) * K + Cc[_i]) * 2u; } while (0)
    Unit cur, nxt; int ui = 0;
    if (!S.next(0, cur)) return;
    typedef typename AccSel<OPK>::T AccT;
    AccT acc[2][2][4][2];
#pragma unroll
    for (int a = 0; a < 2; ++a)
#pragma unroll
        for (int b = 0; b < 2; ++b)
#pragma unroll
            for (int m = 0; m < 4; ++m)
#pragma unroll
                for (int n = 0; n < 2; ++n) acc[a][b][m][n] = AccT{};
    Frag<OPK> At[4], B0[2], B1[2];
    unsigned vA[2][2], vAn[2][2];
    PG8_VA(vA, cur);
#pragma unroll
    for (int h = 0; h < 2; ++h)
#pragma unroll
        for (int i = 0; i < 2; ++i) vAn[h][i] = vA[h][i];
    const char* cA = S.a_base(cur); const char* cB = S.b_base(cur);
    PG8_STAGE(PG8_SB(0, 0), cB, voffB); PG8_STAGE(PG8_SB(0, 1), cB + hstep, voffB); PG8_STAGE(PG8_SA(0, 0), cA, vA[0]); PG8_STAGE(PG8_SA(0, 1), cA, vA[1]);
    if (wr == 1) PG8_BAR;
    PG8_WAIT_V(2); PG8_BAR;
    PG8_STAGE(PG8_SB(1, 0), cB + kstep, voffB); PG8_STAGE(PG8_SA(1, 0), cA + kstep, vA[0]); PG8_STAGE(PG8_SB(1, 1), cB + hstep + kstep, voffB);
    PG8_WAIT_V(6); PG8_BAR;
    for (;;) {
        const bool has_next = S.next(ui + 1, nxt);
        const char* nA = has_next ? S.a_base(nxt) : cA; const char* nB = has_next ? S.b_base(nxt) : cB;
        if constexpr (GATHER) { if (has_next) { PG8_VA(vAn, nxt); } }
        if constexpr (OPK == 2) {
            int ln; asm volatile("v_mbcnt_lo_u32_b32 %0, -1, 0\n\tv_mbcnt_hi_u32_b32 %0, -1, %0" : "=v"(ln));
            const float* sp = (wid < 4 ? S.rs_src(cur, rs) + 64 * wid : S.cs_ptr(cur) + cur.pn * BM + 64 * (wid - 4)) + ln;
            __builtin_amdgcn_global_load_lds((const unsigned*)sp, (PG8_LAS unsigned*)(lds + GS_OFF + (ui & 1) * 2048 + wid * 256), 4, 0, 0); }
        for (int t = 0; t < nt; t += 2) {
            const bool last = (t == nt - 2);
            const char* a1 = cA + (size_t)(t + 1) * kstep;
            const char* a2 = last ? nA : cA + (size_t)(t + 2) * kstep; const char* b2 = last ? nB : cB + (size_t)(t + 2) * kstep;
            const char* a3 = a2 + kstep; const char* b3 = b2 + kstep;
            unsigned v2[2][2];
#pragma unroll
            for (int h = 0; h < 2; ++h)
#pragma unroll
                for (int i = 0; i < 2; ++i) v2[h][i] = (GATHER && last) ? vAn[h][i] : vA[h][i];
            PG8_LDB(B0, 0, 0); PG8_LDB(B1, 0, 1); PG8_SCHED; PG8_LDA(At, 0, 0); PG8_STAGE(PG8_SA(1, 1), a1, vA[1]);
            PG8_WAIT_V(8); PG8_WAIT_L(0); PG8_BAR; PG8_MMA(0, 0, At, B0); PG8_MMA(0, 1, At, B1); PG8_BAR; PG8_SCHED;
            PG8_LDA(At, 0, 1); PG8_STAGE(PG8_SB(0, 0), b2, voffB); PG8_STAGE(PG8_SB(0, 1), b2 + hstep, voffB); PG8_STAGE(PG8_SA(0, 0), a2, v2[0]);
            PG8_WAIT_V(8); PG8_WAIT_L(0); PG8_BAR; PG8_MMA(1, 0, At, B0); PG8_MMA(1, 1, At, B1); PG8_BAR; PG8_SCHED;
            PG8_LDB(B0, 1, 0); PG8_LDB(B1, 1, 1); PG8_SCHED; PG8_LDA(At, 1, 0); PG8_STAGE(PG8_SA(0, 1), a2, v2[1]);
            PG8_WAIT_V(8); PG8_WAIT_L(0); PG8_BAR; PG8_MMA(0, 0, At, B0); PG8_MMA(0, 1, At, B1); PG8_BAR; PG8_SCHED;
            PG8_LDA(At, 1, 1); PG8_STAGE(PG8_SB(1, 0), b3, voffB); PG8_STAGE(PG8_SB(1, 1), b3 + hstep, voffB); PG8_STAGE(PG8_SA(1, 0), a3, v2[0]);
            PG8_WAIT_V(8); PG8_WAIT_L(0); PG8_BAR; PG8_MMA(1, 0, At, B0); PG8_MMA(1, 1, At, B1); PG8_BAR; PG8_SCHED;
        }
        if constexpr (ALIGN_EPI) { if (wr == 0) PG8_BAR; }
        if constexpr (OPK == 2) {
            const PG8_LAS float* gs = (const PG8_LAS float*)(lds + GS_OFF + (ui & 1) * 2048);
            const PG8_LAS float* cs = gs + 256 + wc * 32 + (Epi::PERM ? 8 * fq : 4 * fq);
            f32x4 csv[2][2]; float rsv[2][4];
#pragma unroll
            for (int bj = 0; bj < 2; ++bj)
#pragma unroll
                for (int n = 0; n < 2; ++n) csv[bj][n] = *(const PG8_LAS f32x4*)(cs + bj * HALF + (Epi::PERM ? 4 * n : 16 * n));
            const int nvalid = S.rows_valid(cur);
#pragma unroll
            for (int ai = 0; ai < 2; ++ai)
#pragma unroll
                for (int m = 0; m < 4; ++m) { const int lr = ai * HALF + wr * 64 + m * 16 + fr; const float v = gs[lr]; rsv[ai][m] = (GATHER && lr >= nvalid) ? 1.f : v; }
            if constexpr (Epi::I8FUSED) E.i8(acc, csv, rsv, cur, wr, wc, fr, fq);
            else {
            f32x4 accf[2][2][4][2];
#pragma unroll
            for (int ai = 0; ai < 2; ++ai)
#pragma unroll
                for (int bj = 0; bj < 2; ++bj)
#pragma unroll
                    for (int m = 0; m < 4; ++m)
#pragma unroll
                        for (int n = 0; n < 2; ++n) { const v4i32g a = acc[ai][bj][m][n]; accf[ai][bj][m][n] = (f32x4){(float)a[0], (float)a[1], (float)a[2], (float)a[3]} * csv[bj][n] * rsv[ai][m]; }
            E(accf, cur, wr, wc, fr, fq); }
        } else E(acc, cur, wr, wc, fr, fq);
        if (!has_next) break;
#pragma unroll
        for (int a = 0; a < 2; ++a)
#pragma unroll
            for (int b = 0; b < 2; ++b)
#pragma unroll
                for (int m = 0; m < 4; ++m)
#pragma unroll
                    for (int n = 0; n < 2; ++n) acc[a][b][m][n] = AccT{};
        cur = nxt; cA = nA; cB = nB; ++ui;
#pragma unroll
        for (int h = 0; h < 2; ++h)
#pragma unroll
            for (int i = 0; i < 2; ++i) vA[h][i] = vAn[h][i];
        if constexpr (ALIGN_EPI) { if (wr == 1) PG8_BAR; }
    }
    PG8_WAIT_V(0);
    if constexpr (!ALIGN_EPI) { if (wr == 0) PG8_BAR; }
    PG8_BAR;
#undef PG8_SA
#undef PG8_SB
#undef PG8_STAGE
#undef PG8_LDA
#undef PG8_LDB
#undef PG8_MMA
#undef PG8_WAIT_V
#undef PG8_WAIT_L
#undef PG8_BAR
#undef PG8_SCHED
#undef PG8_VA
}

template <int L> struct EpiQKV {
    static constexpr bool PERM = true; static constexpr bool I8FUSED = false;
    bf16* QKV; bf16* VT; bf16* VT2; const float* cs; PG8_LAS unsigned char* stg;
    __device__ __forceinline__ void operator()(const f32x4 (&acc)[2][2][4][2], const Unit& u, int wr, int wc, int fr, int fq) const {
        const int row0 = u.pm * BM + wr * 64 + fr, pn = u.pn;
        int kind = 0  , dst = 0; float sc = 1.f; bf16* vt = VT; int vnc = 0, vc0 = 0, vcs = 0;
        if (L == 0) {
            if (pn < 4) { kind = 0; dst = 256 * pn + wc * 32; sc = pn < 2 ? C2 : 1.f; }
            else if (pn < 6) { kind = 2; vt = VT; vnc = 512; vc0 = 256 * (pn - 4) + 32 * wc; vcs = 128; }
            else if (pn < 8) { kind = 1; dst = 1536 + (4 * (pn - 6) + wc) * 64; sc = C2; }
            else { if (wc < 2) { kind = 1; dst = 2048 + wc * 64; sc = 1.f; } else { kind = 2; vt = VT2; vnc = 128; vc0 = (wc - 2) * 32; vcs = 64; } }
        } else {
            if (pn < 4) { kind = 1; dst = (4 * pn + wc) * 64; sc = C2; }
            else if (pn == 4) { kind = 1; dst = 1024 + wc * 64; sc = 1.f; }
            else if (pn == 5) { kind = 2; vt = VT; vnc = 256; vc0 = 32 * wc; vcs = 128; }
            else if (pn < 8) { kind = 1; dst = 1536 + (4 * (pn - 6) + wc) * 64; sc = 1.f; }
            else { if (wc == 0) { kind = 1; dst = 2048; sc = 1.f; } else kind = 3; }
        }
        if (kind == 0) {
#pragma unroll
            for (int ai = 0; ai < 2; ++ai)
#pragma unroll
                for (int m = 0; m < 4; ++m) { bf16* rowp = QKV + (size_t)(row0 + ai * HALF + m * 16) * NQ + dst + 8 * fq;
#pragma unroll
                    for (int bj = 0; bj < 2; ++bj) { const f32x4 v0 = acc[ai][bj][m][0] * sc, v1 = acc[ai][bj][m][1] * sc;
                        u32x4 w; w.x = cvtpk(v0[0], v0[1]); w.y = cvtpk(v0[2], v0[3]); w.z = cvtpk(v1[0], v1[1]); w.w = cvtpk(v1[2], v1[3]);
                        *(u32x4*)(rowp + bj * HALF) = w; } }
        } else if (kind == 1) {
#pragma unroll
            for (int ai = 0; ai < 2; ++ai)
#pragma unroll
                for (int m = 0; m < 4; ++m) { const int r = row0 + ai * HALF + m * 16; const f32x4* cp = (const f32x4*)(cs + (size_t)r * 64 + 16 * fq);
                    const f32x4 t0 = cp[0], t1 = cp[1], t2 = cp[2], t3 = cp[3];
                    const f32x4 x1a = acc[ai][0][m][0], x1b = acc[ai][0][m][1], x2a = acc[ai][1][m][0], x2b = acc[ai][1][m][1];
                    float o1[8], o2[8];
                    o1[0] = x1a[0] * t0[0] - x2a[0] * t0[1]; o2[0] = x2a[0] * t0[0] + x1a[0] * t0[1];
                    o1[1] = x1a[1] * t0[2] - x2a[1] * t0[3]; o2[1] = x2a[1] * t0[2] + x1a[1] * t0[3];
                    o1[2] = x1a[2] * t1[0] - x2a[2] * t1[1]; o2[2] = x2a[2] * t1[0] + x1a[2] * t1[1];
                    o1[3] = x1a[3] * t1[2] - x2a[3] * t1[3]; o2[3] = x2a[3] * t1[2] + x1a[3] * t1[3];
                    o1[4] = x1b[0] * t2[0] - x2b[0] * t2[1]; o2[4] = x2b[0] * t2[0] + x1b[0] * t2[1];
                    o1[5] = x1b[1] * t2[2] - x2b[1] * t2[3]; o2[5] = x2b[1] * t2[2] + x1b[1] * t2[3];
                    o1[6] = x1b[2] * t3[0] - x2b[2] * t3[1]; o2[6] = x2b[2] * t3[0] + x1b[2] * t3[1];
                    o1[7] = x1b[3] * t3[2] - x2b[3] * t3[3]; o2[7] = x2b[3] * t3[2] + x1b[3] * t3[3];
                    bf16* rowp = QKV + (size_t)r * NQ + dst + 8 * fq;
                    u32x4 w; w.x = cvtpk(o1[0] * sc, o1[1] * sc); w.y = cvtpk(o1[2] * sc, o1[3] * sc); w.z = cvtpk(o1[4] * sc, o1[5] * sc); w.w = cvtpk(o1[6] * sc, o1[7] * sc);
                    *(u32x4*)(rowp) = w;
                    w.x = cvtpk(o2[0] * sc, o2[1] * sc); w.y = cvtpk(o2[2] * sc, o2[3] * sc); w.z = cvtpk(o2[4] * sc, o2[5] * sc); w.w = cvtpk(o2[6] * sc, o2[7] * sc);
                    *(u32x4*)(rowp + 32) = w; }
        } else if (kind == 2) {
            const int b = (u.pm * BM) / SEQ, s_tile = (u.pm * BM) % SEQ, lane = fq * 16 + fr;
            PG8_LAS unsigned char* sw = stg + (wr * 4 + wc) * VT_STAGE_WAVE;
#pragma unroll
            for (int ai = 0; ai < 2; ++ai)
#pragma unroll
                for (int bj = 0; bj < 2; ++bj)
#pragma unroll
                    for (int mp = 0; mp < 2; ++mp) {
#pragma unroll
                        for (int mm = 0; mm < 2; ++mm)
#pragma unroll
                            for (int n = 0; n < 2; ++n) { const f32x4 v = acc[ai][bj][2 * mp + mm][n]; const unsigned w0 = cvtpk(v[0], v[1]), w1 = cvtpk(v[2], v[3]);
                                PG8_LAS unsigned char* wp = sw + (8 * fq + 4 * n) * 80 + (16 * mm + fr) * 2;
                                *(PG8_LAS unsigned short*)(wp) = (unsigned short)w0; *(PG8_LAS unsigned short*)(wp + 80) = (unsigned short)(w0 >> 16);
                                *(PG8_LAS unsigned short*)(wp + 160) = (unsigned short)w1; *(PG8_LAS unsigned short*)(wp + 240) = (unsigned short)(w1 >> 16); }
#pragma unroll
                        for (int j = 0; j < 2; ++j) { const int colr = (lane >> 2) + 16 * j, seg = lane & 3;
                            const u32x4 v = *(const PG8_LAS u32x4*)(sw + colr * 80 + seg * 16);
                            *(u32x4*)(vt + ((size_t)b * vnc + vc0 + bj * vcs + colr) * SEQ + s_tile + ai * HALF + wr * 64 + mp * 32 + seg * 8) = v; }
                    }
        }
    }
};
template <bool FIRST> struct EpiResid {
    static constexpr bool PERM = true; static constexpr bool I8FUSED = false;
    const float* xin; bf16* XR; const float* gate; float oscale;
    __device__ __forceinline__ void operator()(const f32x4 (&acc)[2][2][4][2], const Unit& u, int wr, int wc, int fr, int fq) const {
        const int row0 = u.pm * BM + wr * 64 + fr, col0 = u.pn * BM + wc * 32 + 8 * fq; const int b = (u.pm * BM) / SEQ;
        f32x4 gv[2][2];
#pragma unroll
        for (int bj = 0; bj < 2; ++bj)
#pragma unroll
            for (int n = 0; n < 2; ++n) gv[bj][n] = *(const f32x4*)(gate + (size_t)b * 6144 + col0 + bj * HALF + 4 * n) * oscale;
#pragma unroll
        for (int ai = 0; ai < 2; ++ai)
#pragma unroll
            for (int m = 0; m < 4; ++m) { const size_t ro = (size_t)(row0 + ai * HALF + m * 16) * D + col0;
#pragma unroll
                for (int bj = 0; bj < 2; ++bj) { f32x4 b0, b1;
                    if (FIRST) { b0 = *(const f32x4*)(xin + ro + bj * HALF); b1 = *(const f32x4*)(xin + ro + bj * HALF + 4); }
                    else { const u32x4 w = *(const u32x4*)(XR + ro + bj * HALF); b0 = (f32x4){bflo(w.x), bfhi(w.x), bflo(w.y), bfhi(w.y)}; b1 = (f32x4){bflo(w.z), bfhi(w.z), bflo(w.w), bfhi(w.w)}; }
                    const f32x4 v0 = b0 + gv[bj][0] * acc[ai][bj][m][0], v1 = b1 + gv[bj][1] * acc[ai][bj][m][1];
                    u32x4 o; o.x = cvtpk(v0[0], v0[1]); o.y = cvtpk(v0[2], v0[3]); o.z = cvtpk(v1[0], v1[1]); o.w = cvtpk(v1[2], v1[3]);
                    *(u32x4*)(XR + ro + bj * HALF) = o; } }
    }
};
template <bool FP8OUT> struct EpiSwiGLU {
    static constexpr bool PERM = true; static constexpr bool I8FUSED = FP8OUT;
    __device__ __forceinline__ void i8(const v4i32g (&acc)[2][2][4][2], const f32x4 (&csv)[2][2], const float (&rsv)[2][4], const Unit& u, int wr, int wc, int fr, int fq) const {
        const int row0 = u.pm * BM + wr * 64 + fr, col0 = u.pn * HALF + wc * 32 + 8 * fq;
#pragma unroll
        for (int ai = 0; ai < 2; ++ai)
#pragma unroll
            for (int m = 0; m < 4; ++m) { float v[8]; const float rs = rsv[ai][m], rsl = rs * -1.4426950408889634f, rs2 = rs * rs * FP8_ACT_SCALE;
#pragma unroll
                for (int n = 0; n < 2; ++n)
#pragma unroll
                    for (int i = 0; i < 4; ++i) { const float G = (float)acc[ai][0][m][n][i] * csv[0][n][i], U = (float)acc[ai][1][m][n][i] * csv[1][n][i];
                        v[4 * n + i] = (G * U) * (rs2 * __builtin_amdgcn_rcpf(1.f + __builtin_amdgcn_exp2f(G * rsl))); }
                *(u32x2*)((unsigned char*)O + (size_t)(row0 + ai * HALF + m * 16) * ldc + col0) = (u32x2){pack4_fp8(v[0], v[1], v[2], v[3]), pack4_fp8(v[4], v[5], v[6], v[7])}; }
    }
    void* O; int ldc; float iscale;
    __device__ __forceinline__ void operator()(const f32x4 (&acc)[2][2][4][2], const Unit& u, int wr, int wc, int fr, int fq) const {
        const int row0 = u.pm * BM + wr * 64 + fr, col0 = u.pn * HALF + wc * 32 + 8 * fq;
#pragma unroll
        for (int ai = 0; ai < 2; ++ai)
#pragma unroll
            for (int m = 0; m < 4; ++m) { float v[8];
#pragma unroll
                for (int n = 0; n < 2; ++n)
#pragma unroll
                    for (int i = 0; i < 4; ++i) { const float g = acc[ai][0][m][n][i] * iscale, up = acc[ai][1][m][n][i] * iscale; v[4 * n + i] = g * __builtin_amdgcn_rcpf(1.f + __expf(-g)) * up; }
                if (FP8OUT) { const u32x2 w = (u32x2){pack4_fp8(v[0] * FP8_ACT_SCALE, v[1] * FP8_ACT_SCALE, v[2] * FP8_ACT_SCALE, v[3] * FP8_ACT_SCALE), pack4_fp8(v[4] * FP8_ACT_SCALE, v[5] * FP8_ACT_SCALE, v[6] * FP8_ACT_SCALE, v[7] * FP8_ACT_SCALE)};
                    *(u32x2*)((unsigned char*)O + (size_t)(row0 + ai * HALF + m * 16) * ldc + col0) = w; }
                else { u32x4 w; w.x = cvtpk(v[0], v[1]); w.y = cvtpk(v[2], v[3]); w.z = cvtpk(v[4], v[5]); w.w = cvtpk(v[6], v[7]);
                    *(u32x4*)((bf16*)O + (size_t)(row0 + ai * HALF + m * 16) * ldc + col0) = w; } }
    }
};
struct EpiBf16 {
    static constexpr bool PERM = true; static constexpr bool I8FUSED = false;
    bf16* O; int ldc; float oscale;
    __device__ __forceinline__ void operator()(const f32x4 (&acc)[2][2][4][2], const Unit& u, int wr, int wc, int fr, int fq) const {
        const int row0 = u.pm * BM + wr * 64 + fr, col0 = u.pn * BM + wc * 32 + 8 * fq;
#pragma unroll
        for (int ai = 0; ai < 2; ++ai)
#pragma unroll
            for (int m = 0; m < 4; ++m) { bf16* rowp = O + (size_t)(row0 + ai * HALF + m * 16) * ldc + col0;
#pragma unroll
                for (int bj = 0; bj < 2; ++bj) { const f32x4 v0 = acc[ai][bj][m][0] * oscale, v1 = acc[ai][bj][m][1] * oscale;
                    u32x4 w; w.x = cvtpk(v0[0], v0[1]); w.y = cvtpk(v0[2], v0[3]); w.z = cvtpk(v1[0], v1[1]); w.w = cvtpk(v1[2], v1[3]);
                    *(u32x4*)(rowp + bj * HALF) = w; } }
    }
};
}

#define XB_TMO      128
#define XB_XCNT(j)  (256  + 64 * (j))
#define XB_XSUB(j)  (1280 + 64 * (j))
#define XB_XGEN(j)  (2304 + 64 * (j))
#define XB_TOP      3328
#define XB_TOPGEN   3392
#define XCD_BAR_WORDS 3456
#define XB_SPIN_CAP (1u << 18)
__device__ __forceinline__ unsigned xb_ld(unsigned* p)              { return __hip_atomic_load(p, __ATOMIC_RELAXED, __HIP_MEMORY_SCOPE_AGENT); }
__device__ __forceinline__ unsigned xb_add(unsigned* p, unsigned v) { return __hip_atomic_fetch_add(p, v, __ATOMIC_RELAXED, __HIP_MEMORY_SCOPE_AGENT); }
__device__ __forceinline__ unsigned xb_xcc_id() { return (unsigned)__builtin_amdgcn_s_getreg((3 << 11) | 20) & 0xFu; }
#define XB_SPIN(cond, bar) do { unsigned _sp = 0; while (cond) { __builtin_amdgcn_s_sleep(1); \
    if ((++_sp & 255u) == 0u) { if (xb_ld(&(bar)[XB_TMO])) break; if (_sp > XB_SPIN_CAP) { atomicAdd(&(bar)[XB_TMO], 1u); break; } } } } while (0)
struct XcdBarrier { unsigned* bar; unsigned x; volatile LAS unsigned* st; };
__device__ __forceinline__ XcdBarrier xcd_barrier_post(unsigned* bar, volatile LAS unsigned* st) {
    XcdBarrier b; b.bar = bar; b.x = xb_xcc_id(); b.st = st;
    if (threadIdx.x == 0) (void)xb_add(&bar[XB_XCNT(b.x)], 1u);
    return b;
}
__device__ __forceinline__ void xcd_barrier_complete(unsigned* bar, unsigned x, unsigned& nloc, unsigned& nx) {
    const unsigned G = gridDim.x * gridDim.y * gridDim.z;
    unsigned sum, cnt, mine, sp = 0u;
    for (;;) {
        sum = 0u; cnt = 0u; mine = 0u;
#pragma unroll
        for (unsigned j = 0; j < 16; ++j) { const unsigned c = xb_ld(&bar[XB_XCNT(j)]); sum += c; cnt += (c > 0u) ? 1u : 0u; mine = (j == x) ? c : mine; }
        if (sum == G) break;
        __builtin_amdgcn_s_sleep(1);
        if ((++sp & 255u) == 0u) { if (xb_ld(&bar[XB_TMO])) break; if (sp > XB_SPIN_CAP) { atomicAdd(&bar[XB_TMO], 1u); break; } }
    }
    nloc = mine > 0u ? mine : 1u; nx = cnt > 0u ? cnt : 1u;
}
__device__ __forceinline__ void xcd_barrier(const XcdBarrier& b) {
    asm volatile("s_waitcnt vmcnt(0)" ::: "memory");
    __syncthreads();
    if (threadIdx.x == 0) {
        unsigned* bar = b.bar;
        __builtin_amdgcn_s_waitcnt(0);
        unsigned nloc = b.st[0], nx = b.st[1];
        if (nloc == 0u) { xcd_barrier_complete(bar, b.x, nloc, nx); b.st[0] = nloc; b.st[1] = nx; }
        const unsigned old = xb_add(&bar[XB_XSUB(b.x)], 1u);
        const unsigned gen = old / nloc;
        if (old + 1u == (gen + 1u) * nloc) {
            __builtin_amdgcn_fence(__ATOMIC_RELEASE, "agent");
            asm volatile("s_waitcnt vmcnt(0)" ::: "memory");
            const unsigned og = xb_add(&bar[XB_TOP], 1u);
            const unsigned tg = og / nx;
            if (og + 1u == (tg + 1u) * nx) xb_add(&bar[XB_TOPGEN], 1u);
            else XB_SPIN(xb_ld(&bar[XB_TOPGEN]) == tg, bar);
            __builtin_amdgcn_fence(__ATOMIC_ACQUIRE, "agent");
            xb_add(&bar[XB_XGEN(b.x)], 1u);
            asm volatile("s_waitcnt vmcnt(0)" ::: "memory");
        } else {
            XB_SPIN(xb_ld(&bar[XB_XGEN(b.x)]) == gen, bar);
            __builtin_amdgcn_fence(__ATOMIC_ACQUIRE, "agent");
            asm volatile("s_waitcnt vmcnt(0)" ::: "memory");
        }
    }
    __syncthreads();
}

#define DPP_MOV(v, CTRL) __int_as_float(__builtin_amdgcn_update_dpp(0, __float_as_int(v), (CTRL), 0xf, 0xf, true))
__device__ __forceinline__ float wave_sum(float v) {
    v += DPP_MOV(v, 0xB1); v += DPP_MOV(v, 0x4E); v += DPP_MOV(v, 0x141); v += DPP_MOV(v, 0x140);
    v += __shfl_xor(v, 16);
    auto rr = __builtin_amdgcn_permlane32_swap(__float_as_uint(v), __float_as_uint(v), false, false); return __uint_as_float(rr[0]) + __uint_as_float(rr[1]);
}
__device__ __forceinline__ float wave_max(float v) {
    v = fmaxf(v, DPP_MOV(v, 0xB1)); v = fmaxf(v, DPP_MOV(v, 0x4E)); v = fmaxf(v, DPP_MOV(v, 0x141)); v = fmaxf(v, DPP_MOV(v, 0x140));
    v = fmaxf(v, __shfl_xor(v, 16));
    auto rr = __builtin_amdgcn_permlane32_swap(__float_as_uint(v), __float_as_uint(v), false, false); return fmaxf(__uint_as_float(rr[0]), __uint_as_float(rr[1]));
}
__device__ __forceinline__ float swap_max(float v) { auto rr = __builtin_amdgcn_permlane32_swap(__float_as_uint(v), __float_as_uint(v), false, false); return fmaxf(__uint_as_float(rr[0]), __uint_as_float(rr[1])); }
__device__ __forceinline__ float swap_sum(float v) { auto rr = __builtin_amdgcn_permlane32_swap(__float_as_uint(v), __float_as_uint(v), false, false); return __uint_as_float(rr[0]) + __uint_as_float(rr[1]); }

__device__ __forceinline__ void sincos_d(double a, float& sn, float& cn) {
    const double k = __builtin_rint(a * 0.63661977236758134308);
    double r = __builtin_fma(-k, 1.57079632673412561417e+00, a);
    r = __builtin_fma(-k, 6.07710050650619224932e-11, r);
    r = __builtin_fma(-k, 2.02226624879595063154e-21, r);
    const double z = r * r;
    const double sp = r + r * z * (-1.66666666666666324348e-01 + z * (8.33333333332248946124e-03 + z * (-1.98412698298579493134e-04 + z * (2.75573137070700676789e-06 + z * (-2.50507602534068634195e-08 + z * 1.58969099521155010221e-10)))));
    const double cp = 1.0 - 0.5 * z + z * z * (4.16666666666666019037e-02 + z * (-1.38888888888741095749e-03 + z * (2.48015872894767294178e-05 + z * (-2.75573143513906633035e-07 + z * (2.08757232129817482790e-09 + z * -1.13596475577881948265e-11)))));
    const int q = ((int)k) & 3;
    const double s = (q == 0) ? sp : (q == 1) ? cp : (q == 2) ? -sp : -cp;
    const double c = (q == 0) ? cp : (q == 1) ? -sp : (q == 2) ? -cp : sp;
    sn = (float)s; cn = (float)c;
}

struct Args { const void* in[26]; float* out; unsigned char* ws; int ph_lo, ph_hi; };
struct Frame {
    LAS unsigned char* lds; unsigned* ctl; unsigned char* ws;
    int tid, lane, wave, G, blk;
};

__device__ __forceinline__ void conv_item(const float* W, int ld, int col0, bf16* WT, int K, int dstrow0, int k0, LAS float* scr, int lane) {
    if (col0 >= 0) {
#pragma unroll 8
        for (int i = 0; i < 32; ++i) { const int kk = 2 * i + (lane >> 5); scr[kk * 33 + (lane & 31)] = W[(size_t)(k0 + kk) * ld + col0 + (lane & 31)]; }
    } else {
#pragma unroll 8
        for (int i = 0; i < 32; ++i) { const int kk = 2 * i + (lane >> 5); scr[kk * 33 + (lane & 31)] = 0.f; }
    }
    asm volatile("s_waitcnt lgkmcnt(0)" ::: "memory");
    const int c = lane & 7;
#pragma unroll
    for (int j = 0; j < 4; ++j) { const int n = (lane >> 3) + 8 * j; const LAS float* s = scr + (8 * c) * 33 + n;
        u32x4 o; o.x = cvtpk(s[0 * 33], s[1 * 33]); o.y = cvtpk(s[2 * 33], s[3 * 33]); o.z = cvtpk(s[4 * 33], s[5 * 33]); o.w = cvtpk(s[6 * 33], s[7 * 33]);
        *(u32x4*)(WT + (size_t)(dstrow0 + n) * K + k0 + 8 * c) = o; }
    asm volatile("s_waitcnt lgkmcnt(0)" ::: "memory");
}
__device__ __forceinline__ void conv_item_fp8(const float* W, int ld, int col0, unsigned char* WT, int Kp, int dstrow0, int k0, LAS float* scr, int lane) {
#pragma unroll 8
    for (int i = 0; i < 32; ++i) { const int kk = 2 * i + (lane >> 5); scr[kk * 33 + (lane & 31)] = W[(size_t)(k0 + kk) * ld + col0 + (lane & 31)] * FP8_W_SCALE; }
    asm volatile("s_waitcnt lgkmcnt(0)" ::: "memory");
    const int c = lane & 7;
#pragma unroll
    for (int j = 0; j < 4; ++j) { const int n = (lane >> 3) + 8 * j; const LAS float* sp = scr + (8 * c) * 33 + n;
        const u32x2 o = (u32x2){pack4_fp8(sp[0 * 33], sp[1 * 33], sp[2 * 33], sp[3 * 33]), pack4_fp8(sp[4 * 33], sp[5 * 33], sp[6 * 33], sp[7 * 33])};
        *(u32x2*)(WT + (size_t)(dstrow0 + n) * Kp + k0 + 8 * c) = o; }
    asm volatile("s_waitcnt lgkmcnt(0)" ::: "memory");
}
__device__ __forceinline__ int map_win0(int n0) {
    const int pn = n0 >> 8, bj = (n0 >> 7) & 1, x = n0 & 127;
    if (pn < 6) return n0;
    if (pn < 8) return 1544 + (4 * (pn - 6) + (x >> 5)) * 64 + 32 * bj;
    return x < 64 ? 2056 + (x >> 5) * 64 + 32 * bj : 2184 + 64 * bj + (x - 64);
}
__device__ __forceinline__ int map_win1(int n0) {
    const int pn = n0 >> 8, bj = (n0 >> 7) & 1, x = n0 & 127;
    if (pn < 4) return (4 * pn + (x >> 5)) * 64 + 32 * bj;
    if (pn == 4) return 1024 + (x >> 5) * 64 + 32 * bj;
    if (pn == 5) return 1280 + 128 * bj + x;
    if (pn < 8) return 1536 + (4 * (pn - 6) + (x >> 5)) * 64 + 32 * bj;
    return x == 0 ? 2048 + 32 * bj : -1;
}

__device__ __forceinline__ void p0_prologue(Frame& F, const Args& a) {
    const float* c_in = (const float*)a.in[1]; const int* pos = (const int*)a.in[2];
    float* mod = (float*)(F.ws + WS_MOD);
    {
        LAS float* sl = (LAS float*)F.lds; LAS float* red = (LAS float*)(F.lds + 65536);
        bool have = false;
        for (int job = F.blk; job < 192; job += F.G) {
            if (!have) { for (int i = F.tid; i < 16 * 1024; i += 512) { const float c = c_in[i]; sl[i] = c / (1.f + __expf(-c)); } __syncthreads(); have = true; }
            const int l = job / 96, n0 = (job % 96) * 64;
            const float* W = (const float*)a.in[l == 0 ? 3 : 14] + n0 + F.lane; const float* bias = (const float*)a.in[l == 0 ? 4 : 15];
            float acc[16];
#pragma unroll
            for (int b = 0; b < 16; ++b) acc[b] = 0.f;
            const int kb = F.wave * 128;
#pragma unroll 4
            for (int k = 0; k < 128; ++k) { const float wv = W[(size_t)(kb + k) * 6144];
#pragma unroll
                for (int b = 0; b < 16; ++b) acc[b] += sl[b * 1024 + kb + k] * wv; }
#pragma unroll
            for (int b = 0; b < 16; ++b) red[(F.wave * 16 + b) * 64 + F.lane] = acc[b];
            __syncthreads();
            for (int i = F.tid; i < 16 * 64; i += 512) { const int b = i >> 6, ln = i & 63; float s = bias[n0 + ln];
#pragma unroll
                for (int w = 0; w < 8; ++w) s += red[(w * 16 + b) * 64 + ln];
                mod[((size_t)l * 16 + b) * 6144 + n0 + ln] = s; }
            __syncthreads();
        }
        __syncthreads();
    }
    {
        float* cs = (float*)(F.ws + WS_ROPE);
        for (int i = F.blk * 512 + F.tid; i < T * 32; i += F.G * 512) { const int t = i >> 5, f = i & 31;
            const float inv = exp2f(-(float)f * (13.287712379549449f / 32.f));
            const float ang = (float)pos[t] * inv; float sn, cn; sincos_d((double)ang, sn, cn);
            *(f32x2*)(cs + (size_t)i * 2) = (f32x2){cn, sn}; }
    }
    {
        LAS float* scr = (LAS float*)(F.lds + F.wave * 16384);
        const int gw = F.blk * 8 + F.wave, NGW = F.G * 8;
        constexpr int I1 = 16 * (NQ / 32), I2 = 16 * 32, I3 = 16 * (2 * FF / 32), I4 = (FF / 64) * 32, I7 = 16 * (2 * FFE / 32), I8 = (FFE / 64) * 32;
        constexpr int NITEMS = 2 * I2 + I4 + NE * I8;
        for (int it = gw; it < NITEMS; it += NGW) {
            int r = it;
            if (r < I2) { const int nb = r % 32, kb = r / 32; conv_item((const float*)a.in[10], D, 32 * nb, (bf16*)(F.ws + WS_WOUT0), D, 32 * nb, 64 * kb, scr, F.lane); continue; } r -= I2;
            if (r < I4) { const int nb = r % 32, kb = r / 32; conv_item_fp8((const float*)a.in[13], D, 32 * nb, F.ws + WS_WDN0, FF, 32 * nb, 64 * kb, scr, F.lane); continue; } r -= I4;
            if (r < I2) { const int nb = r % 32, kb = r / 32; conv_item((const float*)a.in[19], D, 32 * nb, (bf16*)(F.ws + WS_WOUT1), D, 32 * nb, 64 * kb, scr, F.lane); continue; } r -= I2;
            { const int e = r / I8; r -= e * I8; const int nb = r % 32, kb = r / 32;
                conv_item_fp8((const float*)a.in[24] + (size_t)e * FFE * D, D, 32 * nb, F.ws + WS_WDN1 + (size_t)e * D * FFEP, FFEP, 32 * nb, 64 * kb, scr, F.lane); }
        }
    }
}

struct QItem { const float* W; unsigned char* WT; int ld, col0, drow, k0, cs; };
__device__ __forceinline__ QItem q_item(int it, const Args& a, unsigned char* ws) {
    QItem q; const int kb = it & 15; int nb = it >> 4; q.k0 = 64 * kb; q.cs = 32 * nb;
    if (nb < 72) { q.W = (const float*)a.in[7]; q.ld = E_IN; q.col0 = map_win0(32 * nb); q.WT = ws + WS_WIN0; q.drow = 32 * nb; return q; } nb -= 72;
    if (nb < 176) { const int n0 = 32 * nb, pn = n0 >> 8, bj = (n0 >> 7) & 1, x = n0 & 127; q.W = (const float*)a.in[bj ? 12 : 11]; q.ld = FF; q.col0 = 128 * pn + x; q.WT = ws + WS_WGU0; q.drow = n0; return q; } nb -= 176;
    if (nb < 72) { q.W = (const float*)a.in[18]; q.ld = O_IN; q.col0 = map_win1(32 * nb); q.WT = ws + WS_WIN1; q.drow = 32 * nb; return q; } nb -= 72;
    { const int e = nb / 88; nb -= e * 88; const int n0 = 32 * nb, pn = n0 >> 8, bj = (n0 >> 7) & 1, x = n0 & 127;
      q.W = (const float*)a.in[bj ? 23 : 22] + (size_t)e * D * FFE; q.ld = FFE; q.col0 = 128 * pn + x; q.WT = ws + WS_WGU1 + (size_t)e * 2 * FFE * D; q.drow = n0; return q; }
}
__device__ __forceinline__ void q_strips(Frame& F, const Args& a) {
    LAS float* scr = (LAS float*)(F.lds + F.wave * 16384);
    LAS float* cmx = (LAS float*)(F.lds + VT_STAGE_OFF);
    float* cst = (float*)(F.ws + WS_CS);
    for (int st = F.blk; st < CS_END / 32; st += F.G) {
        const QItem q = q_item(st * 16, a, F.ws);
        float r[2][32]; float am = 0.f;
#pragma unroll
        for (int j = 0; j < 2; ++j) {
            if (q.col0 >= 0) { const float* wp = q.W + (size_t)(64 * (2 * F.wave + j) + (F.lane >> 5)) * q.ld + q.col0 + (F.lane & 31);
#pragma unroll
                for (int i = 0; i < 32; ++i) r[j][i] = wp[(size_t)(2 * i) * q.ld]; }
            else {
#pragma unroll
                for (int i = 0; i < 32; ++i) r[j][i] = 0.f; } }
#pragma unroll
        for (int j = 0; j < 2; ++j)
#pragma unroll
            for (int i = 0; i < 32; ++i) am = fmaxf(am, fabsf(r[j][i]));
        am = fmaxf(am, __shfl_xor(am, 32));
        if (F.lane < 32) cmx[F.wave * 32 + F.lane] = am;
        __syncthreads();
        am = cmx[F.lane & 31];
#pragma unroll
        for (int w = 1; w < 8; ++w) am = fmaxf(am, cmx[w * 32 + (F.lane & 31)]);
        const float inv = am > 0.f ? 127.f / am : 0.f;
        if (F.wave == 0 && F.lane < 32) cst[q.cs + F.lane] = am > 0.f ? am * (1.f / 127.f) : 1.f;
#pragma unroll
        for (int j = 0; j < 2; ++j) { const int k0 = 64 * (2 * F.wave + j);
#pragma unroll
            for (int i = 0; i < 32; ++i) scr[(2 * i + (F.lane >> 5)) * 33 + (F.lane & 31)] = rintf(r[j][i] * inv);
            asm volatile("s_waitcnt lgkmcnt(0)" ::: "memory");
            const int c = F.lane & 7;
#pragma unroll
            for (int jj = 0; jj < 4; ++jj) { const int n = (F.lane >> 3) + 8 * jj; const LAS float* sp = scr + (8 * c) * 33 + n;
                *(u32x2*)(q.WT + (size_t)(q.drow + n) * D + k0 + 8 * c) = (u32x2){pack4_i8(sp[0 * 33], sp[1 * 33], sp[2 * 33], sp[3 * 33]), pack4_i8(sp[4 * 33], sp[5 * 33], sp[6 * 33], sp[7 * 33])}; }
            asm volatile("s_waitcnt lgkmcnt(0)" ::: "memory"); }
        __syncthreads();
    }
}
__device__ __forceinline__ void zero_kpad(Frame& F, unsigned char* base, int rows) {
    constexpr int CH = (FFEP - FFE) / 16;
    for (int i = F.blk * 512 + F.tid; i < rows * CH; i += F.G * 512) { const int row = i / CH, ch = i % CH; *(u32x4*)(base + (size_t)row * FFEP + FFE + 16 * ch) = (u32x4){0u, 0u, 0u, 0u}; }
}
template <int SIDE  , bool SRC_BF16, int HOUT = 0  >
__device__ __forceinline__ void norm_phase(Frame& F, const void* src, const float* gamma, const float* modl, int sh_off, int sc_off, bf16* H,
                                           const float* Wside, int ldw, int wcol0, const float* bside, float* side_out) {
    const int rpb = T / F.G, row_lo = F.blk * rpb;
    LAS int* lcnt = (LAS int*)F.lds;
    LAS int* rinfo = (LAS int*)(F.lds + 256);
    if (SIDE == 3) { if (F.tid < 16) lcnt[F.tid] = 0; __syncthreads(); }
    float wreg[4][4][8];
    if (SIDE != 0) {
#pragma unroll
        for (int jj = 0; jj < 4; ++jj)
#pragma unroll
            for (int i = 0; i < 4; ++i) { const int k = 4 * F.lane + 256 * jj + i; const f32x4 w0 = *(const f32x4*)(Wside + (size_t)k * ldw + wcol0), w1 = *(const f32x4*)(Wside + (size_t)k * ldw + wcol0 + 4);
                wreg[jj][i][0] = w0[0]; wreg[jj][i][1] = w0[1]; wreg[jj][i][2] = w0[2]; wreg[jj][i][3] = w0[3]; wreg[jj][i][4] = w1[0]; wreg[jj][i][5] = w1[1]; wreg[jj][i][6] = w1[2]; wreg[jj][i][7] = w1[3]; }
    }
    f32x4 gm[4], av[4], shv[4];
#pragma unroll
    for (int jj = 0; jj < 4; ++jj) gm[jj] = *(const f32x4*)(gamma + 4 * F.lane + 256 * jj);
    int curb = -1;
    f32x4 nxf[4]; u32x2 nxh[4];
#define NORM_LOAD(row_) do { _Pragma("unroll") for (int jj = 0; jj < 4; ++jj) { \
        if (SRC_BF16) nxh[jj] = ((const u32x2*)((const bf16*)src + (size_t)(row_) * D) + F.lane)[64 * jj]; \
        else nxf[jj] = ((const f32x4*)((const float*)src + (size_t)(row_) * D) + F.lane)[64 * jj]; } } while (0)
    NORM_LOAD(row_lo + F.wave);
    for (int lr = F.wave; lr < rpb; lr += 8) {
        const int row = row_lo + lr, b = row / SEQ;
        if (b != curb) { curb = b;
#pragma unroll
            for (int jj = 0; jj < 4; ++jj) { const f32x4 scv = *(const f32x4*)(modl + (size_t)b * 6144 + sc_off + 4 * F.lane + 256 * jj); shv[jj] = *(const f32x4*)(modl + (size_t)b * 6144 + sh_off + 4 * F.lane + 256 * jj); av[jj] = gm[jj] * (scv + 1.f); } }
        f32x4 v[4]; float ss = 0.f, rowscale = 1.f;
#pragma unroll
        for (int jj = 0; jj < 4; ++jj) {
            if (SRC_BF16) { const u32x2 w = nxh[jj]; v[jj] = (f32x4){bflo(w.x), bfhi(w.x), bflo(w.y), bfhi(w.y)}; }
            else v[jj] = nxf[jj]; }
        if (lr + 8 < rpb) NORM_LOAD(row + 8);
#pragma unroll
        for (int jj = 0; jj < 4; ++jj) {
            ss += (v[jj][0] * v[jj][0] + v[jj][1] * v[jj][1]) + (v[jj][2] * v[jj][2] + v[jj][3] * v[jj][3]); }
        const float rstd = rsqrtf(wave_sum(ss) * (1.f / D) + NORM_EPS);
        u32x2* o8 = (u32x2*)(H + (size_t)row * D) + F.lane;
#pragma unroll
        for (int jj = 0; jj < 4; ++jj) { v[jj] = v[jj] * rstd * av[jj] + shv[jj];
            if (HOUT == 1) ((unsigned*)((unsigned char*)H + (size_t)row * D) + F.lane)[64 * jj] = pack4_fp8(v[jj][0] * FP8_H_SCALE, v[jj][1] * FP8_H_SCALE, v[jj][2] * FP8_H_SCALE, v[jj][3] * FP8_H_SCALE);
            else if (HOUT == 0) o8[64 * jj] = (u32x2){cvtpk(v[jj][0], v[jj][1]), cvtpk(v[jj][2], v[jj][3])}; }
        if (HOUT == 2) {
            float am = 0.f;
#pragma unroll
            for (int jj = 0; jj < 4; ++jj) am = fmaxf(fmaxf(am, fmaxf(fabsf(v[jj][0]), fabsf(v[jj][1]))), fmaxf(fabsf(v[jj][2]), fabsf(v[jj][3])));
            am = wave_max(am);
            const float inv = am > 0.f ? 127.f / am : 0.f;
#pragma unroll
            for (int jj = 0; jj < 4; ++jj) ((unsigned*)((unsigned char*)H + (size_t)row * D) + F.lane)[64 * jj] = pack4_i8(rintf(v[jj][0] * inv), rintf(v[jj][1] * inv), rintf(v[jj][2] * inv), rintf(v[jj][3] * inv));
            rowscale = am > 0.f ? am * (1.f / 127.f) : 1.f;
            if (F.lane == 0) ((float*)(F.ws + WS_RS))[row] = rowscale;
        }
        if (SIDE != 0) {
            float s[8];
#pragma unroll
            for (int j = 0; j < 8; ++j) { float t = 0.f;
#pragma unroll
                for (int jj = 0; jj < 4; ++jj)
#pragma unroll
                    for (int i = 0; i < 4; ++i) t += v[jj][i] * wreg[jj][i][j];
                s[j] = wave_sum(t); }
            if (SIDE == 1 || SIDE == 2) {
                float mine = 0.f;
#pragma unroll
                for (int j = 0; j < 8; ++j) if (F.lane == j) mine = s[j];
                if (F.lane < 8) {
                    if (SIDE == 1) { const float z = mine + bside[F.lane]; mine = z < 0.f ? z - log1pf(__expf(z)) : -log1pf(__expf(-z)); }
                    else mine *= 0.04419417382415922f;
                    side_out[(size_t)row * 8 + F.lane] = mine; }
            } else {
                float l1 = -INFINITY, l2 = -INFINITY; int e1 = 0, e2 = 0;
#pragma unroll
                for (int j = 0; j < 8; ++j) { const float lg = s[j] + bside[j]; if (lg > l1) { l2 = l1; e2 = e1; l1 = lg; e1 = j; } else if (lg > l2) { l2 = lg; e2 = j; } }
                const float g1 = 1.f / (1.f + __expf(l2 - l1));
                if (F.lane == 0) { const int sl1 = atomicAdd((int*)&lcnt[e1], 1), sl2 = atomicAdd((int*)&lcnt[e2], 1);
                    LAS int* ri = rinfo + lr * 8; ri[0] = e1; ri[1] = e2; ri[2] = sl1; ri[3] = sl2; ri[4] = (int)__float_as_uint(g1); ri[5] = (int)__float_as_uint(rowscale); }
            }
        }
    }
#undef NORM_LOAD
    if (SIDE == 3) {
        __syncthreads();
        if (F.tid < 8) lcnt[8 + F.tid] = (int)__hip_atomic_fetch_add(F.ctl + CW_CNT + 64 * F.tid, (unsigned)lcnt[F.tid], __ATOMIC_RELAXED, __HIP_MEMORY_SCOPE_AGENT);
        __syncthreads();
        int* list = (int*)(F.ws + WS_LIST); u32x4* tok = (u32x4*)(F.ws + WS_TOK);
        for (int lr = F.tid; lr < rpb; lr += 512) { const LAS int* ri = rinfo + lr * 8; const int e1 = ri[0], e2 = ri[1]; const int s1 = lcnt[8 + e1] + ri[2], s2 = lcnt[8 + e2] + ri[3]; const int row = row_lo + lr;
            list[(size_t)e1 * T + s1] = row; list[(size_t)e2 * T + s2] = row;
            { float* rss = (float*)(F.ws + WS_RSS); const float sc = __uint_as_float((unsigned)ri[5]); rss[(size_t)e1 * T + s1] = sc; rss[(size_t)e2 * T + s2] = sc; }
            tok[row] = (u32x4){(unsigned)(e1 | (e2 << 8)), (unsigned)s1, (unsigned)s2, (unsigned)ri[4]}; }
        __syncthreads();
    }
}

__device__ __forceinline__ void cumsum_kaug(Frame& F) {
    const int gw = F.blk * 8 + F.wave;
    if (gw >= BATCH * 8) return;
    const int b = gw >> 3, h = gw & 7;
    const float* lf = (const float*)(F.ws + WS_LOGF) + (size_t)b * SEQ * 8 + h;
    float v[32]; float run = 0.f;
#pragma unroll
    for (int i = 0; i < 32; ++i) { run += lf[(size_t)(32 * F.lane + i) * 8]; v[i] = run; }
    float incl = run;
#pragma unroll
    for (int o = 1; o < 64; o <<= 1) { const float t = __shfl_up(incl, o); if (F.lane >= o) incl += t; }
    const float excl = incl - run;
    u32x4* ka = (u32x4*)(F.ws + WS_KAUG) + (size_t)gw * SEQ + 32 * F.lane;
#pragma unroll
    for (int i = 0; i < 32; ++i) { const float bias = -(excl + v[i]) * 1.4426950408889634f;
        const unsigned h1 = cvtpk(bias, 0.f) & 0xffffu; const float r1 = bias - bflo(h1);
        const unsigned h2 = cvtpk(r1, 0.f) & 0xffffu; const float r2 = r1 - bflo(h2);
        const unsigned h3 = cvtpk(r2, 0.f) & 0xffffu;
        ka[i] = (u32x4){h1 | (h2 << 16), h3, 0u, 0u}; }
}

constexpr int ATT_BUF = 17408;
template <int MODE  >
__device__ __forceinline__ void attn_unit(LAS unsigned char* lds, const int wave, const int lane,
                                          const bf16* __restrict__ Kg, const bf16* __restrict__ VTg, const u32x4* __restrict__ kaug_g,
                                          const bf16* __restrict__ Qp, bf16* __restrict__ Op, const int q0, const int tw_lo, const int tw_hi, const int T_lo, const int T_hi,
                                          const float sinkl2, const unsigned long long* __restrict__ mb) {
    const int r32 = lane & 31, hi = lane >> 5;
    bf16x8 qf[4];
#pragma unroll
    for (int d0 = 0; d0 < 4; ++d0) qf[d0] = *(const bf16x8*)(Qp + (size_t)r32 * NQ + d0 * 16 + hi * 8);
    const int kr = (r32 & ~12) | ((r32 & 4) << 1) | ((r32 & 8) >> 1);
    const int ksw = (kr >> 1) & 7, vsw = (r32 >> 1) & 7;
    int koff[4], voff[2][2];
#pragma unroll
    for (int d0 = 0; d0 < 4; ++d0) koff[d0] = kr * 128 + (((2 * d0 + hi) ^ ksw) << 4);
#pragma unroll
    for (int hf = 0; hf < 2; ++hf)
#pragma unroll
        for (int s = 0; s < 2; ++s) voff[hf][s] = 8192 + r32 * 128 + (((4 * hf + 2 * s + hi) ^ vsw) << 4);
    const int kaoff = 16384 + kr * 16;
    const int drow = 8 * wave + (lane >> 3), dc = (lane & 7) ^ ((drow >> 1) & 7);
    const bf16* ksrc = Kg + (size_t)drow * NQ + dc * 8;
    const bf16* vsrc = VTg + (size_t)drow * SEQ + dc * 8;
#define ATT_DMA(t, b) do { \
        __builtin_amdgcn_global_load_lds((const unsigned*)(ksrc + (size_t)(t) * 64 * NQ), (LAS unsigned*)(lds + (b) * ATT_BUF + wave * 1024), 16, 0, 0); \
        __builtin_amdgcn_global_load_lds((const unsigned*)(vsrc + (t) * 64), (LAS unsigned*)(lds + (b) * ATT_BUF + 8192 + wave * 1024), 16, 0, 0); \
        if (MODE == 0) { if (wave == 0) __builtin_amdgcn_global_load_lds((const unsigned*)(kaug_g + (t) * 64 + lane), (LAS unsigned*)(lds + (b) * ATT_BUF + 16384), 16, 0, 0); } } while (0)
    bf16x8 qaug = (bf16x8){0, 0, 0, 0, 0, 0, 0, 0};
    if (MODE == 0 && hi == 0) { qaug[0] = (short)0x3F80; qaug[1] = (short)0x3F80; qaug[2] = (short)0x3F80; }
    f32x16 o0, o1;
#pragma unroll
    for (int r = 0; r < 16; ++r) { o0[r] = 0.f; o1[r] = 0.f; }
    float m = (MODE == 1) ? sinkl2 : 0.f, l = (MODE == 1 && hi == 0) ? 1.f : 0.f;
    f32x16 negm;
#pragma unroll
    for (int r = 0; r < 16; ++r) negm[r] = -m;
    const int q = q0 + r32;
    asm volatile("" ::: "memory"); __builtin_amdgcn_s_barrier(); asm volatile("" ::: "memory");
    ATT_DMA(T_lo, 0);
    unsigned long long wn = 0ull;
    if (MODE == 2) wn = mb[(size_t)r32 * 32 + T_lo];
    for (int t = T_lo; t < T_hi; ++t) {
        const int buf = (t - T_lo) & 1;
        asm volatile("s_waitcnt vmcnt(0)" ::: "memory"); __builtin_amdgcn_s_barrier(); asm volatile("" ::: "memory");
        if (t + 1 < T_hi) ATT_DMA(t + 1, buf ^ 1);
        const unsigned long long w = wn;
        if (MODE == 2) { if (t + 1 < T_hi) wn = mb[(size_t)r32 * 32 + t + 1]; }
        if (t < tw_lo || t >= tw_hi) continue;
        const int key0 = t * 64;
        const LAS unsigned char* tb = lds + buf * ATT_BUF;
        f32x16 p0, p1;
#pragma unroll
        for (int d0 = 0; d0 < 4; ++d0) { const bf16x8 k0 = *(const LAS bf16x8*)(tb + koff[d0]), k1 = *(const LAS bf16x8*)(tb + 4096 + koff[d0]);
            p0 = __builtin_amdgcn_mfma_f32_32x32x16_bf16(k0, qf[d0], d0 == 0 ? negm : p0, 0, 0, 0); p1 = __builtin_amdgcn_mfma_f32_32x32x16_bf16(k1, qf[d0], d0 == 0 ? negm : p1, 0, 0, 0); }
        if (MODE == 0) { const bf16x8 a0 = *(const LAS bf16x8*)(tb + kaoff), a1 = *(const LAS bf16x8*)(tb + kaoff + 512);
            p0 = __builtin_amdgcn_mfma_f32_32x32x16_bf16(a0, qaug, p0, 0, 0, 0); p1 = __builtin_amdgcn_mfma_f32_32x32x16_bf16(a1, qaug, p1, 0, 0, 0); }
        bf16x8 vf[2][2][2];
#pragma unroll
        for (int dt = 0; dt < 2; ++dt)
#pragma unroll
            for (int hf = 0; hf < 2; ++hf)
#pragma unroll
                for (int s = 0; s < 2; ++s) vf[dt][hf][s] = *(const LAS bf16x8*)(tb + dt * 4096 + voff[hf][s]);
        if (MODE == 0) { if (key0 + 63 > q0) {
#pragma unroll
            for (int r = 0; r < 16; ++r) { const int key = key0 + 16 * (r >> 3) + 8 * hi + (r & 7); if (key > q) p0[r] = -1e30f; if (key + 32 > q) p1[r] = -1e30f; } } }
        if (MODE == 1) {
#pragma unroll
            for (int r = 0; r < 16; ++r) { const int key = key0 + 16 * (r >> 3) + 8 * hi + (r & 7); if (key > q || key <= q - 128) p0[r] = -1e30f; if (key + 32 > q || key + 32 <= q - 128) p1[r] = -1e30f; } }
        float mx = fmaxf(fmaxf(p0[0], p1[0]), p0[1]);
#pragma unroll
        for (int r = 1; r < 16; ++r) mx = fmaxf(fmaxf(mx, p1[r]), r + 1 < 16 ? p0[r + 1] : p1[r]);
        mx = swap_max(mx);
        if (__any(mx > 8.f)) {
            const float dl = fmaxf(mx, 0.f); const float f = __builtin_amdgcn_exp2f(-dl); m += dl; l *= f;
#pragma unroll
            for (int r = 0; r < 16; ++r) { o0[r] *= f; o1[r] *= f; p0[r] -= dl; p1[r] -= dl; negm[r] = -m; }
        }
#pragma unroll
        for (int r = 0; r < 16; ++r) { p0[r] = __builtin_amdgcn_exp2f(p0[r]); p1[r] = __builtin_amdgcn_exp2f(p1[r]); }
        if (MODE == 2) {
            const unsigned wlo = (unsigned)w >> (8 * hi), whi = (unsigned)(w >> 32) >> (8 * hi);
#pragma unroll
            for (int r = 0; r < 16; ++r) { const int bit = 16 * (r >> 3) + (r & 7); int m0, m1;
                asm("v_bfe_i32 %0, %1, %2, 1" : "=v"(m0) : "v"(wlo), "n"(bit)); asm("v_bfe_i32 %0, %1, %2, 1" : "=v"(m1) : "v"(whi), "n"(bit));
                p0[r] = __uint_as_float(__float_as_uint(p0[r]) & (unsigned)m0); p1[r] = __uint_as_float(__float_as_uint(p1[r]) & (unsigned)m1); }
        }
        float ls = 0.f;
#pragma unroll
        for (int r = 0; r < 16; ++r) ls += p0[r] + p1[r];
        l += ls;
        bf16x8 pb[2][2];
#pragma unroll
        for (int s = 0; s < 2; ++s) {
            u32x4 a, b2;
            a.x = cvtpk(p0[8 * s + 0], p0[8 * s + 1]); a.y = cvtpk(p0[8 * s + 2], p0[8 * s + 3]); a.z = cvtpk(p0[8 * s + 4], p0[8 * s + 5]); a.w = cvtpk(p0[8 * s + 6], p0[8 * s + 7]);
            b2.x = cvtpk(p1[8 * s + 0], p1[8 * s + 1]); b2.y = cvtpk(p1[8 * s + 2], p1[8 * s + 3]); b2.z = cvtpk(p1[8 * s + 4], p1[8 * s + 5]); b2.w = cvtpk(p1[8 * s + 6], p1[8 * s + 7]);
            pb[0][s] = __builtin_bit_cast(bf16x8, a); pb[1][s] = __builtin_bit_cast(bf16x8, b2); }
#pragma unroll
        for (int hf = 0; hf < 2; ++hf)
#pragma unroll
            for (int s = 0; s < 2; ++s) { o0 = __builtin_amdgcn_mfma_f32_32x32x16_bf16(vf[0][hf][s], pb[hf][s], o0, 0, 0, 0); o1 = __builtin_amdgcn_mfma_f32_32x32x16_bf16(vf[1][hf][s], pb[hf][s], o1, 0, 0, 0); }
    }
#undef ATT_DMA
    l = swap_sum(l);
    const float inv = 1.f / l;
    bf16* orow = Op + (size_t)r32 * D + 4 * hi;
#pragma unroll
    for (int g = 0; g < 4; ++g) {
        *(u32x2*)(orow + 8 * g) = (u32x2){cvtpk(o0[4 * g] * inv, o0[4 * g + 1] * inv), cvtpk(o0[4 * g + 2] * inv, o0[4 * g + 3] * inv)};
        *(u32x2*)(orow + 32 + 8 * g) = (u32x2){cvtpk(o1[4 * g] * inv, o1[4 * g + 1] * inv), cvtpk(o1[4 * g + 2] * inv, o1[4 * g + 3] * inv)}; }
}

__device__ __forceinline__ void attn0_phase(Frame& F, const float* sinks) {
    const bf16* QKV = (const bf16*)(F.ws + WS_QKV); bf16* MIX = (bf16*)(F.ws + WS_MIX);
    const bf16* VTF = (const bf16*)(F.ws + WS_VT); const bf16* VTS = (const bf16*)(F.ws + WS_VT_SWA);
    const u32x4* KA = (const u32x4*)(F.ws + WS_KAUG);
    for (int it = 0;; ++it) {
        const int idx = it * F.G + F.blk; if (idx >= BATCH * 8 * 8) break;
        const int bh = idx & 127, jn = idx >> 7, itp = jn >> 1, base = 2 * (itp >> 1) + (jn & 1), qb = (itp & 1) ? 7 - base : base;
        const int b = bh >> 3, h = bh & 7, q0 = 256 * qb + 32 * F.wave;
        attn_unit<0>(F.lds, F.wave, F.lane, QKV + (size_t)(b * SEQ) * NQ + 512 + h * 64, VTF + (size_t)(b * 512 + h * 64) * SEQ, KA + (size_t)bh * SEQ,
                     QKV + (size_t)(b * SEQ + q0) * NQ + h * 64, MIX + (size_t)(b * SEQ + q0) * D + h * 64, q0, 0, (q0 + 32 + 63) / 64, 0, 4 * qb + 4, 0.f, nullptr);
    }
    for (int it = 0;; ++it) {
        const int idx = it * F.G + F.blk; if (idx >= BATCH * 2 * 32) break;
        const int b = (idx & 31) >> 1, kvh = idx & 1, qp = idx >> 5, h = kvh * 4 + (F.wave & 3), q0 = 64 * qp + 32 * (F.wave >> 2);
        const int lo = q0 - 127, tw_lo = lo > 0 ? lo / 64 : 0, Lo = 64 * qp - 127, T_lo = Lo > 0 ? Lo / 64 : 0;
        attn_unit<1>(F.lds, F.wave, F.lane, QKV + (size_t)(b * SEQ) * NQ + 2048 + kvh * 64, VTS + (size_t)(b * 128 + kvh * 64) * SEQ, nullptr,
                     QKV + (size_t)(b * SEQ + q0) * NQ + 1536 + h * 64, MIX + (size_t)(b * SEQ + q0) * D + 512 + h * 64, q0, tw_lo, (q0 + 32 + 63) / 64, T_lo, qp + 1,
                     sinks[h] * 1.4426950408889634f, nullptr);
    }
}
__device__ __forceinline__ void attn1_phase(Frame& F) {
    const bf16* QKV = (const bf16*)(F.ws + WS_QKV); bf16* MIX = (bf16*)(F.ws + WS_MIX);
    const bf16* VTD = (const bf16*)(F.ws + WS_VT); const unsigned long long* MB = (const unsigned long long*)(F.ws + WS_MASK);
    for (int it = 0;; ++it) {
        const int idx = it * F.G + F.blk; if (idx >= BATCH * 4 * 32) break;
        const int b = (idx & 63) >> 2, kvh = idx & 3, jn = idx >> 6, h3 = jn >> 2, a2 = jn & 3;
        const int qp = 4 * ((h3 & 1) ? 7 - (h3 >> 1) : (h3 >> 1)) + ((h3 & 1) ? 3 - a2 : a2);
        const int h = kvh * 4 + (F.wave & 3), q0 = 64 * qp + 32 * (F.wave >> 2);
        attn_unit<2>(F.lds, F.wave, F.lane, QKV + (size_t)(b * SEQ) * NQ + 1024 + kvh * 64, VTD + (size_t)(b * 256 + kvh * 64) * SEQ, nullptr,
                     QKV + (size_t)(b * SEQ + q0) * NQ + h * 64, MIX + (size_t)(b * SEQ + q0) * D + h * 64, q0, 0, qp + 1, 0, qp + 1, 0.f, MB + (size_t)(b * SEQ + q0) * 32);
    }
}

#define WRLANE(dst, val, LANE) asm("s_nop 1\n\tv_writelane_b32 %0, %1, %2" : "+v"(dst) : "s"(val), "n"(LANE))
template <int NR>
__device__ __forceinline__ unsigned select_query(const LAS float* srow_in, LAS unsigned* hist, const int q, const int lane_in, unsigned& Tprev) {
    unsigned myword = 0u;
    int lane = lane_in; asm volatile("" : "+v"(lane));
    const LAS float* srow = srow_in; asm volatile("" : "+v"(srow));
    unsigned ky[NR];
#pragma unroll
    for (int i = 0; i < NR; ++i) { const unsigned bits = __float_as_uint(srow[64 * i]); const unsigned key = (bits & 0x80000000u) ? ~bits : (bits | 0x80000000u); ky[i] = (lane <= q - 64 * i) ? key : 0u; }
#define SEL_COUNT(dst, thr) do { int c0_ = 0, c1_ = 0, c2_ = 0, c3_ = 0; \
        _Pragma("unroll") for (int i = 0; i < NR; i += 4) { c0_ += __popcll(__ballot(ky[i] >= (thr))); c1_ += __popcll(__ballot(ky[i + 1] >= (thr))); c2_ += __popcll(__ballot(ky[i + 2] >= (thr))); c3_ += __popcll(__ballot(ky[i + 3] >= (thr))); } \
        dst = (c0_ + c1_) + (c2_ + c3_); } while (0)
    unsigned Tk = 0u; bool exact = false; int above = 0;
    bool have = false;
    if (Tprev != 0u && (Tprev >> 23) != 0x1ffu) {
        const unsigned lo = Tprev & 0xff800000u, hi = lo + 0x00800000u; int clo, chi;
        SEL_COUNT(clo, lo); SEL_COUNT(chi, hi);
        if (clo >= 256 && chi < 256) { Tk = lo; above = chi; have = true; if (clo == 256) exact = true; }
    }
    if (!have) {
#pragma unroll 1
        for (int bit = 31; bit >= 23; --bit) { const unsigned cand = Tk | (1u << bit); int cnt; SEL_COUNT(cnt, cand);
            if (cnt >= 256) Tk = cand; else above = cnt;
            if (cnt == 256) { exact = true; break; } }
    }
    int lowbit = 22;
    if (!exact) {
        *(LAS u32x4*)(hist + 4 * lane) = (u32x4){0u, 0u, 0u, 0u};
#pragma unroll
        for (int i = 0; i < NR; ++i) { if ((ky[i] >> 23) == (Tk >> 23)) __hip_atomic_fetch_add(hist + ((ky[i] >> 15) & 255u), 1u, __ATOMIC_RELAXED, __HIP_MEMORY_SCOPE_WORKGROUP); }
        const u32x4 c = *(LAS u32x4*)(hist + 4 * lane);
        const int kk = 256 - above;
        const int s4 = (int)(c.x + c.y + c.z + c.w); int suf = s4;
#pragma unroll
        for (int o = 1; o < 64; o <<= 1) { const int t = __shfl_down(suf, o); if (lane + o < 64) suf += t; }
        const int ab3 = suf - s4, ab2 = ab3 + (int)c.w, ab1 = ab2 + (int)c.z, ab0 = ab1 + (int)c.y;
        int dmine = -1, kmine = 0, cmine = 0;
        if (ab3 < kk && kk <= ab3 + (int)c.w) { dmine = 4 * lane + 3; kmine = kk - ab3; cmine = (int)c.w; }
        else if (ab2 < kk && kk <= ab2 + (int)c.z) { dmine = 4 * lane + 2; kmine = kk - ab2; cmine = (int)c.z; }
        else if (ab1 < kk && kk <= ab1 + (int)c.y) { dmine = 4 * lane + 1; kmine = kk - ab1; cmine = (int)c.y; }
        else if (ab0 < kk && kk <= ab0 + (int)c.x) { dmine = 4 * lane; kmine = kk - ab0; cmine = (int)c.x; }
        const unsigned long long fb = __ballot(dmine >= 0);
        if (fb != 0ull) { const int src = __ffsll((long long)fb) - 1; const int dsel = __shfl(dmine, src), ksel = __shfl(kmine, src), csel = __shfl(cmine, src);
            Tk |= (unsigned)(dsel & 255) << 15; lowbit = 14; if (csel == ksel) exact = true; }
    }
    if (!exact) {
#pragma unroll 1
        for (int bit = lowbit; bit >= 0; --bit) { const unsigned cand = Tk | (1u << bit); int cnt; SEL_COUNT(cnt, cand);
            if (cnt >= 256) Tk = cand;
            if (cnt == 256) { exact = true; break; } }
    }
#undef SEL_COUNT
    asm volatile("" : "+v"(Tk));
    Tprev = Tk;
    if (exact) {
#pragma unroll
        for (int i = 0; i < NR; ++i) { const unsigned long long bs = __ballot(ky[i] >= Tk);
            WRLANE(myword, (unsigned)bs, 2 * i); WRLANE(myword, (unsigned)(bs >> 32), 2 * i + 1); }
    } else {
        int cgt = 0;
#pragma unroll
        for (int i = 0; i < NR; ++i) cgt += __popcll(__ballot(ky[i] > Tk));
        const int need = 256 - cgt; int running = 0;
        const unsigned long long ltmask = (1ull << lane) - 1ull;
#pragma unroll
        for (int i = 0; i < NR; ++i) { const bool eq = ky[i] == Tk; const unsigned long long beq = __ballot(eq);
            const int rank = running + __popcll(beq & ltmask); const bool sel = (ky[i] > Tk || (eq && rank < need)) && (lane <= q - 64 * i);
            const unsigned long long bs = __ballot(sel); running += __popcll(beq);
            WRLANE(myword, (unsigned)bs, 2 * i); WRLANE(myword, (unsigned)(bs >> 32), 2 * i + 1); }
    }
    return myword;
}
__device__ __forceinline__ void indexer_phase(Frame& F) {
    const bf16* QKV = (const bf16*)(F.ws + WS_QKV); const float* IW = (const float*)(F.ws + WS_IW); unsigned* MASK = (unsigned*)(F.ws + WS_MASK);
    LAS float* sc = (LAS float*)F.lds;
    constexpr int SP = 2052;
    const int fr = F.lane & 15, fq = F.lane >> 4;
    LAS unsigned* hist = (LAS unsigned*)(F.lds + 16 * SP * 4 + F.wave * 1024);
    unsigned Tprev = 0u;
#define IDX_DECODE(it_, valid_, rb_, q0_) do { const int idx_ = (it_) * F.G + F.blk; valid_ = idx_ < BATCH * 128; const int jn_ = (idx_ >> 4) & 127, h3_ = jn_ >> 4, a4_ = jn_ & 15; \
        q0_ = 16 * (16 * ((h3_ & 1) ? 7 - (h3_ >> 1) : (h3_ >> 1)) + ((h3_ & 1) ? 15 - a4_ : a4_)); rb_ = (size_t)(idx_ & 15) * SEQ; } while (0)
#define IDX_LOAD(rb_, q0_) do { const int nt_ = (q0_) / 16 + 1; const bf16* kb_ = QKV + ((rb_) + fr) * NQ + 2048 + fq * 8; \
        _Pragma("unroll") for (int k = 0; k < 8; ++k) { const int tl = F.wave + 8 * k < nt_ ? F.wave + 8 * k : 0; ik[k][0] = *(const bf16x8*)(kb_ + (size_t)tl * 16 * NQ); ik[k][1] = *(const bf16x8*)(kb_ + (size_t)tl * 16 * NQ + 32); } \
        iw0 = *(const f32x4*)(IW + ((rb_) + (q0_) + fr) * 8); iw1 = *(const f32x4*)(IW + ((rb_) + (q0_) + fr) * 8 + 4); \
        _Pragma("unroll") for (int h = 0; h < 8; ++h) _Pragma("unroll") for (int ks = 0; ks < 2; ++ks) iqf[h][ks] = *(const bf16x8*)(QKV + ((rb_) + (q0_) + fr) * NQ + 1536 + h * 64 + ks * 32 + fq * 8); } while (0)
#define IDX_TILE(IKF, tile_) do { f32x4 s_ = (f32x4){0.f, 0.f, 0.f, 0.f}; \
        _Pragma("unroll") for (int h = 0; h < 8; ++h) { f32x4 a_ = (f32x4){0.f, 0.f, 0.f, 0.f}; const float iwh = h < 4 ? iw0[h & 3] : iw1[h & 3]; \
            a_ = __builtin_amdgcn_mfma_f32_16x16x32_bf16((IKF)[0], iqf[h][0], a_, 0, 0, 0); a_ = __builtin_amdgcn_mfma_f32_16x16x32_bf16((IKF)[1], iqf[h][1], a_, 0, 0, 0); \
            _Pragma("unroll") for (int i = 0; i < 4; ++i) { const int ai_ = __float_as_int(a_[i]); const float r_ = __int_as_float(ai_ > 0 ? ai_ : 0);     asm("v_fmac_f32 %0, %1, %2" : "+v"(s_[i]) : "v"(iwh), "v"(r_)); } } \
        *(LAS f32x4*)(sc + fr * SP + (tile_) * 16 + 4 * fq) = s_; } while (0)
    bf16x8 iqf[8][2], ik[8][2]; f32x4 iw0, iw1;
    bool valid; size_t rb; int q0;
    IDX_DECODE(0, valid, rb, q0);
    if (valid && q0 + 16 > 256) IDX_LOAD(rb, q0);
    for (int it = 0; valid; ++it) {
        const bool light = q0 + 16 <= 256;
        const int ntile = light ? 0 : q0 / 16 + 1;
        if (ntile > 0) {
#pragma unroll
            for (int k = 0; k < 8; ++k) { if (F.wave + 8 * k < ntile) IDX_TILE(ik[k], F.wave + 8 * k); }
            if (ntile > 64) {
                const bf16* kb = QKV + (rb + fr) * NQ + 2048 + fq * 8;
#pragma unroll
                for (int k = 0; k < 8; ++k) { const int tl = F.wave + 64 + 8 * k < ntile ? F.wave + 64 + 8 * k : 0; ik[k][0] = *(const bf16x8*)(kb + (size_t)tl * 16 * NQ); ik[k][1] = *(const bf16x8*)(kb + (size_t)tl * 16 * NQ + 32); }
#pragma unroll
                for (int k = 0; k < 8; ++k) { if (F.wave + 64 + 8 * k < ntile) IDX_TILE(ik[k], F.wave + 64 + 8 * k); } }
        }
        __syncthreads();
        bool nvalid; size_t nrb; int nq0;
        IDX_DECODE(it + 1, nvalid, nrb, nq0);
        if (nvalid && nq0 + 16 > 256) IDX_LOAD(nrb, nq0);
#pragma unroll 1
        for (int k = 0; k < 2; ++k) {
            const int ql = 2 * F.wave + k, q = q0 + ql;
            unsigned myword = 0u;
            if (light) { const int n = q + 1 - 32 * F.lane; myword = n >= 32 ? 0xffffffffu : (n <= 0 ? 0u : ((1u << n) - 1u)); }
            else {
            const int nrb = (((q0 + 15) >> 6) + 8) >> 3;
            const LAS float* srow = sc + ql * SP + F.lane;
            if (nrb == 1) myword = select_query<8>(srow, hist, q, F.lane, Tprev); else if (nrb == 2) myword = select_query<16>(srow, hist, q, F.lane, Tprev);
            else if (nrb == 3) myword = select_query<24>(srow, hist, q, F.lane, Tprev); else myword = select_query<32>(srow, hist, q, F.lane, Tprev);
            }
            MASK[(rb + q) * 64 + F.lane] = myword;
        }
        __syncthreads();
        valid = nvalid; rb = nrb; q0 = nq0;
    }
#undef IDX_DECODE
#undef IDX_LOAD
#undef IDX_TILE
}

template <bool MOE, bool SRC_BF16>
__device__ __forceinline__ void final_phase(Frame& F, const void* src, float* out, const float* fnorm, const float* mod1) {
    const int gw = F.blk * 8 + F.wave, NGW = F.G * 8;
    int P[9]; P[0] = 0;
    if (MOE) {
#pragma unroll
        for (int e = 0; e < 8; ++e) { int ce = (int)F.ctl[CW_CNT + 64 * e]; ce = ce < 0 ? 0 : (ce > T ? T : ce); P[e + 1] = P[e] + (ce + 255) / 256; }
    }
    const bf16* Y = (const bf16*)(F.ws + WS_Y); const u32x4* tok = (const u32x4*)(F.ws + WS_TOK);
    f32x4 fn[4];
#pragma unroll
    for (int jj = 0; jj < 4; ++jj) fn[jj] = *(const f32x4*)(fnorm + 4 * F.lane + 256 * jj);
    for (int row = gw; row < T; row += NGW) {
        f32x4 v[4];
#pragma unroll
        for (int jj = 0; jj < 4; ++jj) {
            if (SRC_BF16) { const u32x2 w = ((const u32x2*)((const bf16*)src + (size_t)row * D) + F.lane)[64 * jj]; v[jj] = (f32x4){bflo(w.x), bfhi(w.x), bflo(w.y), bfhi(w.y)}; }
            else v[jj] = ((const f32x4*)((const float*)src + (size_t)row * D) + F.lane)[64 * jj]; }
        if (MOE) {
            const u32x4 ti = tok[row]; const int e1 = ti.x & 0xff, e2 = (ti.x >> 8) & 0xff; int p1 = 0, p2 = 0;
#pragma unroll
            for (int e = 0; e < 8; ++e) { if (e1 == e) p1 = P[e]; if (e2 == e) p2 = P[e]; }
            const size_t r1 = (size_t)p1 * 256 + ti.y, r2 = (size_t)p2 * 256 + ti.z; const float g1 = __uint_as_float(ti.w), g2 = 1.f - g1;
            const int b = row / SEQ;
            const u32x2* y1 = (const u32x2*)(Y + r1 * D) + F.lane; const u32x2* y2 = (const u32x2*)(Y + r2 * D) + F.lane;
#pragma unroll
            for (int jj = 0; jj < 4; ++jj) { const u32x2 a = y1[64 * jj], c = y2[64 * jj]; const f32x4 gf = *(const f32x4*)(mod1 + (size_t)b * 6144 + 5 * 1024 + 4 * F.lane + 256 * jj);
                v[jj][0] += gf[0] * (g1 * bflo(a.x) + g2 * bflo(c.x)); v[jj][1] += gf[1] * (g1 * bfhi(a.x) + g2 * bfhi(c.x));
                v[jj][2] += gf[2] * (g1 * bflo(a.y) + g2 * bflo(c.y)); v[jj][3] += gf[3] * (g1 * bfhi(a.y) + g2 * bfhi(c.y)); }
        }
        float ss = 0.f;
#pragma unroll
        for (int jj = 0; jj < 4; ++jj) ss += (v[jj][0] * v[jj][0] + v[jj][1] * v[jj][1]) + (v[jj][2] * v[jj][2] + v[jj][3] * v[jj][3]);
        const float rstd = rsqrtf(wave_sum(ss) * (1.f / D) + NORM_EPS);
        f32x4* orow = (f32x4*)(out + (size_t)row * D) + F.lane;
#pragma unroll
        for (int jj = 0; jj < 4; ++jj) orow[64 * jj] = v[jj] * rstd * fn[jj];
    }
}

constexpr int NPHASE = 17;
constexpr int LASTPH = (MK_STAGE == 0) ? 0 : (MK_STAGE == 1) ? 4 : (MK_STAGE == 2) ? 7 : (MK_STAGE == 3) ? 12 : 15;
__global__ void __launch_bounds__(512, 2) fwd_kernel(Args args) {
    extern __shared__ __attribute__((aligned(16))) unsigned char lds_raw[];
    Frame F;
    F.lds = (LAS unsigned char*)lds_raw; F.ws = args.ws; F.ctl = (unsigned*)(args.ws + WS_CTL);
    F.tid = threadIdx.x; F.lane = F.tid & 63; F.wave = __builtin_amdgcn_readfirstlane(F.tid >> 6); F.G = gridDim.x; F.blk = blockIdx.x;
    volatile LAS unsigned* MISC = (volatile LAS unsigned*)(F.lds + MISC_OFF);
    if (F.tid < 64) MISC[F.tid] = 0u;
    __syncthreads();
    XcdBarrier bar; bar.bar = F.ctl + CW_BAR; bar.x = 0; bar.st = MISC + 8;
    if (MK_ONE_LAUNCH) bar = xcd_barrier_post(F.ctl + CW_BAR, MISC + 8);
    const int lo = args.ph_lo, hi = args.ph_hi;
#define IN(k) (lo <= (k) && (k) < hi && ((k) <= LASTPH || (k) == NPHASE - 1))
#define SEAM(k) do { if (MK_ONE_LAUNCH && (k) + 1 < hi) xcd_barrier(bar); } while (0)
    const float* x = (const float*)args.in[0];
    float* mod0 = (float*)(F.ws + WS_MOD); float* mod1 = mod0 + 16 * 6144;
    bf16* Hb = (bf16*)(F.ws + WS_H); bf16* QKV = (bf16*)(F.ws + WS_QKV); bf16* MIX = (bf16*)(F.ws + WS_MIX); unsigned char* ACT0 = F.ws + WS_ACT0; unsigned char* ACT1 = F.ws + WS_ACT1; bf16* Yb = (bf16*)(F.ws + WS_Y); bf16* XR = (bf16*)(F.ws + WS_XR);
    const float* cs = (const float*)(F.ws + WS_ROPE);
    LAS unsigned char* ring = F.lds;

#define PHASE(k, ...) do { if (IN(k)) { { int l_; asm volatile("v_mbcnt_lo_u32_b32 %0, -1, 0\n\tv_mbcnt_hi_u32_b32 %0, -1, %0" : "=v"(l_)); F.lane = l_; F.tid = F.wave * 64 + l_; } __VA_ARGS__; if (MK_DUP & (1 << (k))) { xcd_barrier(bar); __VA_ARGS__; } } SEAM(k); } while (0)
    PHASE(0, { p0_prologue(F, args); q_strips(F, args); zero_kpad(F, F.ws + WS_WDN1, NE * D); });
    PHASE(1, { norm_phase<1, false, 2>(F, x, (const float*)args.in[5], mod0, 0, 1024, Hb, (const float*)args.in[7], E_IN, 1536, (const float*)args.in[8], (float*)(F.ws + WS_LOGF)); });
    const float* rsc = (const float*)(F.ws + WS_RS); const float* csc = (const float*)(F.ws + WS_CS);
    PHASE(2, { cumsum_kaug(F);
        pg8::StaticOrder S; S.init(T, NQ, D / 2, F.G, F.blk, Hb, F.ws + WS_WIN0, csc + CS_WIN0);
        pg8::EpiQKV<0> E{QKV, (bf16*)(F.ws + WS_VT), (bf16*)(F.ws + WS_VT_SWA), cs, F.lds + VT_STAGE_OFF};
        pg8::gemm_phase<pg8::EpiQKV<0>, pg8::StaticOrder, true, false, 2>(ring, D / 2, S, E, F.wave, rsc); });
    PHASE(3, attn0_phase(F, (const float*)args.in[9]));
    PHASE(4, { pg8::StaticOrder S; S.init(T, D, D, F.G, F.blk, MIX, F.ws + WS_WOUT0);
        pg8::EpiResid<true> E{x, XR, mod0 + 2048, 1.f};
        pg8::gemm_phase<pg8::EpiResid<true>, pg8::StaticOrder, true, false>(ring, D, S, E, F.wave); });
    PHASE(5, norm_phase<0, true, 2>(F, XR, (const float*)args.in[6], mod0, 3072, 4096, Hb, nullptr, 0, 0, nullptr, nullptr));
    PHASE(6, { pg8::StaticOrder S; S.init(T, 2 * FF, D / 2, F.G, F.blk, Hb, F.ws + WS_WGU0, csc + CS_WGU0);
        pg8::EpiSwiGLU<true> E{ACT0, FF, 1.f};
        pg8::gemm_phase<pg8::EpiSwiGLU<true>, pg8::StaticOrder, true, false, 2>(ring, D / 2, S, E, F.wave, rsc); });
    PHASE(7, { pg8::StaticOrder S; S.init(T, D, FF / 2, F.G, F.blk, ACT0, F.ws + WS_WDN0);
        pg8::EpiResid<false> E{nullptr, XR, mod0 + 5120, FP8_OUT_SCALE};
        pg8::gemm_phase<pg8::EpiResid<false>, pg8::StaticOrder, true, false, 1>(ring, FF / 2, S, E, F.wave); });
    PHASE(8, norm_phase<2, true, 2>(F, XR, (const float*)args.in[16], mod1, 0, 1024, Hb, (const float*)args.in[18], O_IN, 2112, nullptr, (float*)(F.ws + WS_IW)));
    PHASE(9, { pg8::StaticOrder S; S.init(T, NQ, D / 2, F.G, F.blk, Hb, F.ws + WS_WIN1, csc + CS_WIN1);
        pg8::EpiQKV<1> E{QKV, (bf16*)(F.ws + WS_VT), nullptr, cs, F.lds + VT_STAGE_OFF};
        pg8::gemm_phase<pg8::EpiQKV<1>, pg8::StaticOrder, true, false, 2>(ring, D / 2, S, E, F.wave, rsc); });
    PHASE(10, indexer_phase(F));
    PHASE(11, attn1_phase(F));
    PHASE(12, { pg8::StaticOrder S; S.init(T, D, D, F.G, F.blk, MIX, F.ws + WS_WOUT1);
        pg8::EpiResid<false> E{nullptr, XR, mod1 + 2048, 1.f};
        pg8::gemm_phase<pg8::EpiResid<false>, pg8::StaticOrder, true, false>(ring, D, S, E, F.wave); });
    PHASE(13, { zero_kpad(F, F.ws + WS_ACT1, YROWS); norm_phase<3, true, 2>(F, XR, (const float*)args.in[17], mod1, 3072, 4096, Hb, (const float*)args.in[20], 8, 0, (const float*)args.in[21], nullptr); });
    PHASE(14, { pg8::MoeOrder S; S.init(F.ctl + CW_CNT, 2 * FFE, D / 2, F.G, F.blk, Hb, F.ws + WS_WGU1, (size_t)2 * FFE * D, (const int*)(F.ws + WS_LIST), true, csc + CS_WGU1, 2 * FFE);
        pg8::EpiSwiGLU<true> E{ACT1, FFEP, 1.f};
        pg8::gemm_phase<pg8::EpiSwiGLU<true>, pg8::MoeOrder, true, true, 2>(ring, D / 2, S, E, F.wave, (const float*)(F.ws + WS_RSS)); });
    PHASE(15, { pg8::MoeOrder S; S.init(F.ctl + CW_CNT, D, FFEP / 2, F.G, F.blk, ACT1, F.ws + WS_WDN1, (size_t)D * FFEP, nullptr, false);
        pg8::EpiBf16 E{Yb, D, FP8_OUT_SCALE};
        pg8::gemm_phase<pg8::EpiBf16, pg8::MoeOrder, true, false, 1>(ring, FFEP / 2, S, E, F.wave); });
    if (IN(16)) {
        if (MK_STAGE == 0) final_phase<false, false>(F, x, args.out, (const float*)args.in[25], mod1);
        else if (MK_STAGE < 4) final_phase<false, true>(F, XR, args.out, (const float*)args.in[25], mod1);
        else final_phase<true, true>(F, XR, args.out, (const float*)args.in[25], mod1);
    }
#undef IN
#undef SEAM
#undef PHASE
}

extern "C" void kernel_launch(void* const* d_in, const int* in_sizes, int n_in, void* d_out, int out_size, void* d_ws, size_t ws_size, hipStream_t stream) {
    static int grid = 0;
    if (grid == 0) {
        if (n_in != 26 || out_size != T * D || ws_size < WS_END) { fprintf(stderr, "kernel_launch: unexpected shapes (n_in %d out %d ws %zu)\n", n_in, out_size, ws_size); grid = -1; return; }
        int dev = 0, cus = 0;
        if (hipGetDevice(&dev) != hipSuccess || hipDeviceGetAttribute(&cus, hipDeviceAttributeMultiprocessorCount, dev) != hipSuccess) { grid = -1; return; }
        if (hipFuncSetAttribute((const void*)fwd_kernel, hipFuncAttributeMaxDynamicSharedMemorySize, LDS_BYTES) != hipSuccess) { fprintf(stderr, "kernel_launch: hipFuncSetAttribute failed\n"); grid = -1; return; }
        int per_cu = 0;
        if (hipOccupancyMaxActiveBlocksPerMultiprocessor(&per_cu, (const void*)fwd_kernel, 512, LDS_BYTES) != hipSuccess || per_cu < 1) fprintf(stderr, "kernel_launch: occupancy query reports %d\n", per_cu);
        (void)hipGetLastError();
        grid = 256;
        while (grid > cus && grid > 1) grid >>= 1;
    }
    if (grid < 0) return;
    (void)hipMemsetAsync((char*)d_ws + WS_CTL, 0, CTL_ZERO_BYTES, stream);
    Args a{};
    for (int i = 0; i < 26; ++i) a.in[i] = d_in[i];
    a.out = (float*)d_out; a.ws = (unsigned char*)d_ws;
#if MK_ONE_LAUNCH
    a.ph_lo = 0; a.ph_hi = NPHASE;
    hipLaunchKernelGGL(fwd_kernel, dim3(grid), dim3(512), LDS_BYTES, stream, a);
#else
    for (int p = 0; p < NPHASE; ++p) {
        if (!(p <= LASTPH || p == NPHASE - 1)) continue;
        a.ph_lo = p; a.ph_hi = p + 1;
        hipLaunchKernelGGL(fwd_kernel, dim3(grid), dim3(512), LDS_BYTES, stream, a);
        if (p == MK_REP_PHASE) for (int r = 0; r < MK_REP_N; ++r) hipLaunchKernelGGL(fwd_kernel, dim3(grid), dim3(512), LDS_BYTES, stream, a);
    }
#endif
}
```

```cpp
#include <hip/hip_runtime.h>
#include <cstdio>
#include <cstdint>

#ifndef MK_STAGE
#define MK_STAGE 4
#endif
#ifndef MK_ONE_LAUNCH
#define MK_ONE_LAUNCH 1
#endif

#ifndef MK_REP_PHASE
#define MK_REP_PHASE -1
#define MK_REP_N 0
#endif
#ifndef MK_DUP
#define MK_DUP 0
#endif
#define GAS __attribute__((address_space(1)))
#define LAS __attribute__((address_space(3)))
typedef unsigned short bf16;
typedef unsigned u32x4 __attribute__((ext_vector_type(4)));
typedef unsigned u32x2 __attribute__((ext_vector_type(2)));
typedef float f32x4 __attribute__((ext_vector_type(4)));
typedef float f32x2 __attribute__((ext_vector_type(2)));
typedef float f32x16 __attribute__((ext_vector_type(16)));
typedef short bf16x8 __attribute__((ext_vector_type(8)));
typedef __bf16 bf16x2_t __attribute__((ext_vector_type(2)));

__device__ __forceinline__ unsigned cvtpk(float lo, float hi) { f32x2 v = {lo, hi}; bf16x2_t b = __builtin_convertvector(v, bf16x2_t); return __builtin_bit_cast(unsigned, b); }
typedef int v8i32 __attribute__((ext_vector_type(8)));
typedef int v4i32g __attribute__((ext_vector_type(4)));
__device__ __forceinline__ unsigned pack4_i8(float a, float b, float c, float d) {
    unsigned w = 0u; w = __builtin_amdgcn_cvt_pk_u8_f32(a + 128.f, 0, w); w = __builtin_amdgcn_cvt_pk_u8_f32(b + 128.f, 1, w); w = __builtin_amdgcn_cvt_pk_u8_f32(c + 128.f, 2, w); w = __builtin_amdgcn_cvt_pk_u8_f32(d + 128.f, 3, w);
    return w ^ 0x80808080u; }
typedef short bf16x16v __attribute__((ext_vector_type(16)));
constexpr float FP8_MIX_SCALE = 16.f;
constexpr float FP8_ACT_SCALE = 8.f, FP8_W_SCALE = 32.f, FP8_OUT_SCALE = 1.f / (8.f * 32.f), FP8_H_SCALE = 16.f, FP8_GU_SCALE = 1.f / (16.f * 32.f);
__device__ __forceinline__ unsigned pack4_fp8(float a, float b, float c, float d) {
    a = __builtin_amdgcn_fmed3f(a, -448.f, 448.f); b = __builtin_amdgcn_fmed3f(b, -448.f, 448.f); c = __builtin_amdgcn_fmed3f(c, -448.f, 448.f); d = __builtin_amdgcn_fmed3f(d, -448.f, 448.f);
    int w = 0; w = __builtin_amdgcn_cvt_pk_fp8_f32(a, b, w, false); w = __builtin_amdgcn_cvt_pk_fp8_f32(c, d, w, true); return (unsigned)w; }
__device__ __forceinline__ float bf2f(unsigned short b) { return __uint_as_float((unsigned)b << 16); }
__device__ __forceinline__ float bflo(unsigned w) { return __uint_as_float(w << 16); }
__device__ __forceinline__ float bfhi(unsigned w) { return __uint_as_float(w & 0xffff0000u); }

constexpr int BATCH = 16, SEQ = 2048, T = BATCH * SEQ, D = 1024;
constexpr int NQ = 2304;
constexpr int FF = 2816, FFE = 1408, NE = 8;
constexpr int FFEP = 1536;
constexpr int E_IN = 2312, O_IN = 2120;
constexpr float C2 = 0.125f * 1.4426950408889634f;
constexpr float NORM_EPS = 1e-6f;
constexpr int YROWS = 2 * T + NE * 256;

constexpr size_t MiB = 1u << 20;
constexpr size_t WS_CTL = 0, CTL_ZERO_BYTES = 1 * MiB;
constexpr size_t WS_MOD = 1 * MiB;
constexpr size_t WS_ROPE = 2 * MiB;
constexpr size_t WS_LOGF = 10 * MiB;
constexpr size_t WS_RSS = WS_LOGF;
constexpr size_t WS_KAUG = 11 * MiB;
constexpr size_t WS_IW = 15 * MiB;
constexpr size_t WS_TOK = 16 * MiB;
constexpr size_t WS_RS = 16 * MiB + 512 * 1024;
constexpr size_t WS_CS = WS_RS + 128 * 1024;
constexpr int CS_WIN0 = 0, CS_WGU0 = 2304, CS_WIN1 = CS_WGU0 + 2 * 2816, CS_WGU1 = CS_WIN1 + 2304, CS_END = CS_WGU1 + 8 * 2 * 1408;

static_assert(CS_END == 32768, "column scale table");
constexpr size_t WS_LIST = 17 * MiB;
constexpr size_t WS_MASK = 18 * MiB;
constexpr size_t WS_WIN0 = 26 * MiB, WS_WOUT0 = WS_WIN0 + (size_t)NQ * D * 2, WS_WGU0 = WS_WOUT0 + (size_t)D * D * 2, WS_WDN0 = WS_WGU0 + (size_t)2 * FF * D * 2;
constexpr size_t WS_WIN1 = WS_WDN0 + (size_t)D * FF * 2, WS_WOUT1 = WS_WIN1 + (size_t)NQ * D * 2, WS_WGU1 = WS_WOUT1 + (size_t)D * D * 2, WS_WDN1 = WS_WGU1 + (size_t)NE * 2 * FFE * D * 2;
constexpr size_t WS_WEND = WS_WDN1 + (size_t)NE * D * FFE * 2;
constexpr size_t WS_XR = 122 * MiB;
constexpr size_t WS_H = 186 * MiB;
constexpr size_t WS_Y = WS_H, WS_MIX = WS_H;
constexpr size_t WS_QKV = 250 * MiB;
constexpr size_t WS_VT = 394 * MiB;
constexpr size_t WS_VT_SWA = WS_VT + 32 * MiB;
constexpr size_t WS_ACT0 = WS_QKV;
constexpr size_t WS_ACT1 = 318 * MiB;
constexpr size_t WS_END = 500 * MiB;
static_assert(WS_WEND <= WS_XR && WS_XR + (size_t)T * D * 2 <= WS_H && WS_Y + (size_t)YROWS * D * 2 <= WS_ACT1 && WS_H + (size_t)T * D * 2 <= WS_QKV && WS_QKV + (size_t)T * NQ * 2 <= WS_VT && WS_VT_SWA + (size_t)16 * 128 * SEQ * 2 <= WS_END
              && WS_ACT0 + (size_t)T * FF * 2 <= WS_END && WS_ACT1 + (size_t)YROWS * FFE * 2 <= WS_END, "d_ws map");
constexpr int CW_TMO = 0;
constexpr int CW_BAR = 4096;
constexpr int CW_CNT = 16384;

constexpr int VT_STAGE_OFF = 131072, VT_STAGE_WAVE = 2560;
constexpr int SCR_BYTES = 151552;
constexpr int MISC_OFF = SCR_BYTES;
constexpr int GS_OFF = SCR_BYTES + 1024;
constexpr int LDS_BYTES = SCR_BYTES + 1024 + 4096 + 2048;

namespace pg8 {
#define PG8_LAS __attribute__((address_space(3)))
constexpr int BM = 256, BK = 64, HALF = 128, HTB = HALF * BK * 2, NXCD = 8, WGM = 8;
__host__ __device__ __forceinline__ int lds_byte(int r, int c) { const int st = (r >> 4) * 2 + (c >> 5), rr = r & 15, cc = c & 31, ob = rr * 64 + cc * 2; return st * 1024 + (ob ^ (((ob >> 9) & 1) << 5)); }
__host__ __device__ __forceinline__ void stage_rc(int b, int& R, int& C) { const int st = b / 1024, sb = b % 1024, swz = sb ^ (((sb >> 9) & 1) << 5); R = (st >> 1) * 16 + swz / 64; C = (st & 1) * 32 + (swz % 64) / 2; }
__host__ __device__ __forceinline__ int perm32(int rho) { const int n = rho >> 4, i = rho & 15; return 8 * (i >> 2) + 4 * n + (i & 3); }
struct Unit { int pm, pn, e; };

struct StaticOrder {
    int nM, nN, nwg, G, c; const char* A; const char* B; size_t tA, tB; const float* cs;
    __device__ __forceinline__ void init(int M, int N, int K, int G_, int c_, const void* A_, const void* B_, const float* cs_ = nullptr) { nM = M / BM; nN = N / BM; nwg = nM * nN; G = G_; c = c_; A = (const char*)A_; B = (const char*)B_; tA = (size_t)BM * K * 2; tB = tA; cs = cs_; }
    __device__ __forceinline__ const float* cs_ptr(const Unit&) const { return cs; }
    __device__ __forceinline__ bool next(int i, Unit& u) const {
        const long L = (long)i * G + c; if (L >= nwg) return false;
        int wgid = (int)L; { const int q = nwg / NXCD, r = nwg % NXCD, xcd = wgid % NXCD, off = wgid / NXCD; wgid = (xcd < r ? xcd * (q + 1) : r * (q + 1) + (xcd - r) * q) + off; }
        const int nig = WGM * nN, gid = wgid / nig, fm = gid * WGM, gsz = (nM - fm) < WGM ? (nM - fm) : WGM;
        u.pm = fm + ((wgid % nig) % gsz); u.pn = (wgid % nig) / gsz; u.e = 0; return true;
    }
    __device__ __forceinline__ const char* a_base(const Unit& u) const { return A + (size_t)u.pm * tA; }
    __device__ __forceinline__ const char* b_base(const Unit& u) const { return B + (size_t)u.pn * tB; }
    __device__ __forceinline__ int arow(const Unit&, int) const { return 0; }
    __device__ __forceinline__ const float* rs_src(const Unit& u, const float* rs) const { return rs + (size_t)u.pm * BM; }
    __device__ __forceinline__ int rows_valid(const Unit&) const { return BM; }
};

struct MoeOrder {
    int nN, G, c; int P[9]; int cnt[8];
    const char* A; const char* B; size_t tA, tB, bstride; const int* list; bool gather; const float* cs; int cs_estride;
    __device__ __forceinline__ void init(const unsigned* gcnt, int N, int K, int G_, int c_, const void* A_, const void* B_, size_t bstride_, const int* list_, bool gather_, const float* cs_ = nullptr, int cs_estride_ = 0) {
        nN = N / BM; G = G_; c = c_; A = (const char*)A_; B = (const char*)B_; tA = (size_t)BM * K * 2; tB = tA; bstride = bstride_; list = list_; gather = gather_; cs = cs_; cs_estride = cs_estride_;
        P[0] = 0;
#pragma unroll
        for (int e = 0; e < 8; ++e) { int ce = (int)gcnt[64 * e]; ce = ce < 0 ? 0 : (ce > T ? T : ce); cnt[e] = ce; P[e + 1] = P[e] + (ce + 255) / 256; }
    }
    __device__ __forceinline__ bool next(int i, Unit& u) const {
        const long L = (long)i * G + c; if (L >= (long)P[8] * nN) return false;
        const int g = (int)(L / nN); u.pm = g; u.pn = (int)(L - (long)g * nN); int e = 0;
#pragma unroll
        for (int j = 1; j < 8; ++j) if (g >= P[j]) e = j;
        u.e = e; return true;
    }
    __device__ __forceinline__ const char* a_base(const Unit& u) const { return gather ? A : A + (size_t)u.pm * tA; }
    __device__ __forceinline__ const char* b_base(const Unit& u) const { return B + (size_t)u.e * bstride + (size_t)u.pn * tB; }
    __device__ __forceinline__ const float* cs_ptr(const Unit& u) const { return cs + (size_t)u.e * cs_estride; }
    __device__ __forceinline__ int arow(const Unit& u, int r) const {
        int Pe = 0, ce = 0;
#pragma unroll
        for (int j = 0; j < 8; ++j) if (u.e == j) { Pe = P[j]; ce = cnt[j]; }
        const int slot = (u.pm - Pe) * 256 + r;
        return slot < ce ? list[(size_t)u.e * T + slot] : 0;
    }
    __device__ __forceinline__ const float* rs_src(const Unit& u, const float* rs) const { int Pe = 0;
#pragma unroll
        for (int j = 0; j < 8; ++j) if (u.e == j) Pe = P[j];
        return rs + (size_t)u.e * T + (size_t)(u.pm - Pe) * BM; }
    __device__ __forceinline__ int rows_valid(const Unit& u) const { int Pe = 0, ce = 0;
#pragma unroll
        for (int j = 0; j < 8; ++j) if (u.e == j) { Pe = P[j]; ce = cnt[j]; }
        const int v = ce - (u.pm - Pe) * BM; return v < BM ? v : BM; }
};

typedef int v4i32 __attribute__((ext_vector_type(4)));
template <int OPK> struct AccSel { typedef f32x4 T; };
template <> struct AccSel<2> { typedef v4i32g T; };
template <int OPK  > struct Frag;
template <> struct Frag<0> { bf16x8 k0, k1;
    __device__ __forceinline__ void load(const PG8_LAS unsigned char* p) { k0 = *(const PG8_LAS bf16x8*)p; k1 = *(const PG8_LAS bf16x8*)(p + 1024); }
    static __device__ __forceinline__ f32x4 mma(const Frag& b, const Frag& a, f32x4 c) { c = __builtin_amdgcn_mfma_f32_16x16x32_bf16(b.k0, a.k0, c, 0, 0, 0); return __builtin_amdgcn_mfma_f32_16x16x32_bf16(b.k1, a.k1, c, 0, 0, 0); } };
template <> struct Frag<2> { v4i32g k0, k1;
    __device__ __forceinline__ void load(const PG8_LAS unsigned char* p) { k0 = *(const PG8_LAS v4i32g*)p; k1 = *(const PG8_LAS v4i32g*)(p + 1024); }
    static __device__ __forceinline__ v4i32g mma(const Frag& b, const Frag& a, v4i32g c) { c = __builtin_amdgcn_mfma_i32_16x16x64_i8(b.k0, a.k0, c, 0, 0, 0); return __builtin_amdgcn_mfma_i32_16x16x64_i8(b.k1, a.k1, c, 0, 0, 0); } };
template <> struct Frag<1> { v8i32 v;
    __device__ __forceinline__ void load(const PG8_LAS unsigned char* p) { const v4i32 lo = *(const PG8_LAS v4i32*)p, hi = *(const PG8_LAS v4i32*)(p + 1024); v = __builtin_shufflevector(lo, hi, 0, 1, 2, 3, 4, 5, 6, 7); }
    static __device__ __forceinline__ f32x4 mma(const Frag& b, const Frag& a, f32x4 c) {
        const int one = 0x7f7f7f7f; asm volatile("v_mfma_scale_f32_16x16x128_f8f6f4 %0, %1, %2, %0, %3, %3 op_sel_hi:[0,0,0]" : "+v"(c) : "v"(b.v), "v"(a.v), "v"(one)); return c; } };
template <class Epi, class Sched, bool ALIGN_EPI, bool GATHER, int OPK = 0>
__device__ __forceinline__ void gemm_phase(PG8_LAS unsigned char* lds, const int K, const Sched& S, const Epi& E, const int wave, const float* rs = nullptr) {
    int lane; asm volatile("v_mbcnt_lo_u32_b32 %0, -1, 0\n\tv_mbcnt_hi_u32_b32 %0, -1, %0" : "=v"(lane));
    const int wid = __builtin_amdgcn_readfirstlane(wave), tid = wid * 64 + lane, wr = wid >> 2, wc = wid & 3, fr = lane & 15, fq = lane >> 4;
    const int nt = K / BK;
    int Rr[2], Cc[2]; unsigned voffB[2];
#pragma unroll
    for (int i = 0; i < 2; ++i) { int R, C; stage_rc(tid * 16 + i * 8192, R, C); Rr[i] = R; Cc[i] = C; const int Rb = Epi::PERM ? ((R & ~31) + perm32(R & 31)) : R; voffB[i] = (unsigned)(Rb * K + C) * 2u; }
    const size_t kstep = (size_t)(BK * 2);
    const size_t hstep = (size_t)HALF * K * 2;
    const unsigned ldsw = (unsigned)wid * 1024u;
    const int aoff = lds_byte(wr * 64 + fr, fq * 8), boff = lds_byte(wc * 32 + fr, fq * 8);
#define PG8_SA(b, h) (((b) * 2 + (h)) * HTB)
#define PG8_SB(b, h) ((4 + (b) * 2 + (h)) * HTB)
#define PG8_STAGE(bufoff, gbase, voff) do { _Pragma("unroll") for (int _i = 0; _i < 2; ++_i) \
        __builtin_amdgcn_global_load_lds((const unsigned*)((const char*)(gbase) + (voff)[_i]), (PG8_LAS unsigned*)(lds + (bufoff) + ldsw + _i * 8192), 16, 0, 0); } while (0)
#define PG8_LDA(dst, b, h) do { _Pragma("unroll") for (int m = 0; m < 4; ++m) dst[m].load(lds + PG8_SA(b, h) + aoff + m * 2048); } while (0)
#define PG8_LDB(dst, b, h) do { _Pragma("unroll") for (int n = 0; n < 2; ++n) dst[n].load(lds + PG8_SB(b, h) + boff + n * 2048); } while (0)
#define PG8_MMA(ai, bj, At, Bt) do { __builtin_amdgcn_s_setprio(1); _Pragma("unroll") for (int m = 0; m < 4; ++m) _Pragma("unroll") for (int n = 0; n < 2; ++n) \
        acc[ai][bj][m][n] = Frag<OPK>::mma(Bt[n], At[m], acc[ai][bj][m][n]); __builtin_amdgcn_s_setprio(0); } while (0)
#define PG8_WAIT_V(n) asm volatile("s_waitcnt vmcnt(" #n ")" ::: "memory")
#define PG8_WAIT_L(n) asm volatile("s_waitcnt lgkmcnt(" #n ")" ::: "memory")
#define PG8_BAR __builtin_amdgcn_s_barrier()
#define PG8_SCHED __builtin_amdgcn_sched_barrier(0)
#define PG8_VA(dst, u) do { _Pragma("unroll") for (int _h = 0; _h < 2; ++_h) _Pragma("unroll") for (int _i = 0; _i < 2; ++_i) \
        dst[_h][_i] = GATHER ? (unsigned)S.arow(u, _h * HALF + Rr[_i]) * (unsigned)(K * 2) + (unsigned)Cc[_i] * 2u : (unsigned)((_h * HALF + Rr[_i]) * K + Cc[_i]) * 2u; } while (0)
    Unit cur, nxt; int ui = 0;
    if (!S.next(0, cur)) return;
    typedef typename AccSel<OPK>::T AccT;
    AccT acc[2][2][4][2];
#pragma unroll
    for (int a = 0; a < 2; ++a)
#pragma unroll
        for (int b = 0; b < 2; ++b)
#pragma unroll
            for (int m = 0; m < 4; ++m)
#pragma unroll
                for (int n = 0; n < 2; ++n) acc[a][b][m][n] = AccT{};
    Frag<OPK> At[4], B0[2], B1[2];
    unsigned vA[2][2], vAn[2][2];
    PG8_VA(vA, cur);
#pragma unroll
    for (int h = 0; h < 2; ++h)
#pragma unroll
        for (int i = 0; i < 2; ++i) vAn[h][i] = vA[h][i];
    const char* cA = S.a_base(cur); const char* cB = S.b_base(cur);
    PG8_STAGE(PG8_SB(0, 0), cB, voffB); PG8_STAGE(PG8_SB(0, 1), cB + hstep, voffB); PG8_STAGE(PG8_SA(0, 0), cA, vA[0]); PG8_STAGE(PG8_SA(0, 1), cA, vA[1]);
    if (wr == 1) PG8_BAR;
    PG8_WAIT_V(2); PG8_BAR;
    PG8_STAGE(PG8_SB(1, 0), cB + kstep, voffB); PG8_STAGE(PG8_SA(1, 0), cA + kstep, vA[0]); PG8_STAGE(PG8_SB(1, 1), cB + hstep + kstep, voffB);
    PG8_WAIT_V(6); PG8_BAR;
    for (;;) {
        const bool has_next = S.next(ui + 1, nxt);
        const char* nA = has_next ? S.a_base(nxt) : cA; const char* nB = has_next ? S.b_base(nxt) : cB;
        if constexpr (GATHER) { if (has_next) { PG8_VA(vAn, nxt); } }
        if constexpr (OPK == 2) {
            int ln; asm volatile("v_mbcnt_lo_u32_b32 %0, -1, 0\n\tv_mbcnt_hi_u32_b32 %0, -1, %0" : "=v"(ln));
            const float* sp = (wid < 4 ? S.rs_src(cur, rs) + 64 * wid : S.cs_ptr(cur) + cur.pn * BM + 64 * (wid - 4)) + ln;
            __builtin_amdgcn_global_load_lds((const unsigned*)sp, (PG8_LAS unsigned*)(lds + GS_OFF + (ui & 1) * 2048 + wid * 256), 4, 0, 0); }
        for (int t = 0; t < nt; t += 2) {
            const bool last = (t == nt - 2);
            const char* a1 = cA + (size_t)(t + 1) * kstep;
            const char* a2 = last ? nA : cA + (size_t)(t + 2) * kstep; const char* b2 = last ? nB : cB + (size_t)(t + 2) * kstep;
            const char* a3 = a2 + kstep; const char* b3 = b2 + kstep;
            unsigned v2[2][2];
#pragma unroll
            for (int h = 0; h < 2; ++h)
#pragma unroll
                for (int i = 0; i < 2; ++i) v2[h][i] = (GATHER && last) ? vAn[h][i] : vA[h][i];
            PG8_LDB(B0, 0, 0); PG8_LDB(B1, 0, 1); PG8_SCHED; PG8_LDA(At, 0, 0); PG8_STAGE(PG8_SA(1, 1), a1, vA[1]);
            PG8_WAIT_V(8); PG8_WAIT_L(0); PG8_BAR; PG8_MMA(0, 0, At, B0); PG8_MMA(0, 1, At, B1); PG8_BAR; PG8_SCHED;
            PG8_LDA(At, 0, 1); PG8_STAGE(PG8_SB(0, 0), b2, voffB); PG8_STAGE(PG8_SB(0, 1), b2 + hstep, voffB); PG8_STAGE(PG8_SA(0, 0), a2, v2[0]);
            PG8_WAIT_V(8); PG8_WAIT_L(0); PG8_BAR; PG8_MMA(1, 0, At, B0); PG8_MMA(1, 1, At, B1); PG8_BAR; PG8_SCHED;
            PG8_LDB(B0, 1, 0); PG8_LDB(B1, 1, 1); PG8_SCHED; PG8_LDA(At, 1, 0); PG8_STAGE(PG8_SA(0, 1), a2, v2[1]);
            PG8_WAIT_V(8); PG8_WAIT_L(0); PG8_BAR; PG8_MMA(0, 0, At, B0); PG8_MMA(0, 1, At, B1); PG8_BAR; PG8_SCHED;
            PG8_LDA(At, 1, 1); PG8_STAGE(PG8_SB(1, 0), b3, voffB); PG8_STAGE(PG8_SB(1, 1), b3 + hstep, voffB); PG8_STAGE(PG8_SA(1, 0), a3, v2[0]);
            PG8_WAIT_V(8); PG8_WAIT_L(0); PG8_BAR; PG8_MMA(1, 0, At, B0); PG8_MMA(1, 1, At, B1); PG8_BAR; PG8_SCHED;
        }
        if constexpr (ALIGN_EPI) { if (wr == 0) PG8_BAR; }
        if constexpr (OPK == 2) {
            const PG8_LAS float* gs = (const PG8_LAS float*)(lds + GS_OFF + (ui & 1) * 2048);
            const PG8_LAS float* cs = gs + 256 + wc * 32 + (Epi::PERM ? 8 * fq : 4 * fq);
            f32x4 csv[2][2]; float rsv[2][4];
#pragma unroll
            for (int bj = 0; bj < 2; ++bj)
#pragma unroll
                for (int n = 0; n < 2; ++n) csv[bj][n] = *(const PG8_LAS f32x4*)(cs + bj * HALF + (Epi::PERM ? 4 * n : 16 * n));
            const int nvalid = S.rows_valid(cur);
#pragma unroll
            for (int ai = 0; ai < 2; ++ai)
#pragma unroll
                for (int m = 0; m < 4; ++m) { const int lr = ai * HALF + wr * 64 + m * 16 + fr; const float v = gs[lr]; rsv[ai][m] = (GATHER && lr >= nvalid) ? 1.f : v; }
            if constexpr (Epi::I8FUSED) E.i8(acc, csv, rsv, cur, wr, wc, fr, fq);
            else {
            f32x4 accf[2][2][4][2];
#pragma unroll
            for (int ai = 0; ai < 2; ++ai)
#pragma unroll
                for (int bj = 0; bj < 2; ++bj)
#pragma unroll
                    for (int m = 0; m < 4; ++m)
#pragma unroll
                        for (int n = 0; n < 2; ++n) { const v4i32g a = acc[ai][bj][m][n]; accf[ai][bj][m][n] = (f32x4){(float)a[0], (float)a[1], (float)a[2], (float)a[3]} * csv[bj][n] * rsv[ai][m]; }
            E(accf, cur, wr, wc, fr, fq); }
        } else E(acc, cur, wr, wc, fr, fq);
        if (!has_next) break;
#pragma unroll
        for (int a = 0; a < 2; ++a)
#pragma unroll
            for (int b = 0; b < 2; ++b)
#pragma unroll
                for (int m = 0; m < 4; ++m)
#pragma unroll
                    for (int n = 0; n < 2; ++n) acc[a][b][m][n] = AccT{};
        cur = nxt; cA = nA; cB = nB; ++ui;
#pragma unroll
        for (int h = 0; h < 2; ++h)
#pragma unroll
            for (int i = 0; i < 2; ++i) vA[h][i] = vAn[h][i];
        if constexpr (ALIGN_EPI) { if (wr == 1) PG8_BAR; }
    }
    PG8_WAIT_V(0);
    if constexpr (!ALIGN_EPI) { if (wr == 0) PG8_BAR; }
    PG8_BAR;
#undef PG8_SA
#undef PG8_SB
#undef PG8_STAGE
#undef PG8_LDA
#undef PG8_LDB
#undef PG8_MMA
#undef PG8_WAIT_V
#undef PG8_WAIT_L
#undef PG8_BAR
#undef PG8_SCHED
#undef PG8_VA
}

template <int L> struct EpiQKV {
    static constexpr bool PERM = true; static constexpr bool I8FUSED = false;
    bf16* QKV; bf16* VT; bf16* VT2; const int* pos; PG8_LAS unsigned char* stg; float* iw;
    __device__ __forceinline__ void operator()(const f32x4 (&acc)[2][2][4][2], const Unit& u, int wr, int wc, int fr, int fq) const {
        const int row0 = u.pm * BM + wr * 64 + fr, pn = u.pn;
        int kind = 0  , dst = 0; float sc = 1.f; bf16* vt = VT; int vnc = 0, vc0 = 0, vcs = 0;
        if (L == 0) {
            if (pn < 4) { kind = 0; dst = 256 * pn + wc * 32; sc = pn < 2 ? C2 : 1.f; }
            else if (pn < 6) { kind = 2; vt = VT; vnc = 512; vc0 = 256 * (pn - 4) + 32 * wc; vcs = 128; }
            else if (pn < 8) { kind = 1; dst = 1536 + (4 * (pn - 6) + wc) * 64; sc = C2; }
            else { if (wc < 2) { kind = 1; dst = 2048 + wc * 64; sc = 1.f; } else { kind = 2; vt = VT2; vnc = 128; vc0 = (wc - 2) * 32; vcs = 64; } }
        } else {
            if (pn < 4) { kind = 1; dst = (4 * pn + wc) * 64; sc = C2; }
            else if (pn == 4) { kind = 1; dst = 1024 + wc * 64; sc = 1.f; }
            else if (pn == 5) { kind = 2; vt = VT; vnc = 256; vc0 = 32 * wc; vcs = 128; }
            else if (pn < 8) { kind = 1; dst = 1536 + (4 * (pn - 6) + wc) * 64; sc = 1.f; }
            else { if (wc == 0) { kind = 1; dst = 2048; sc = 1.f; } else kind = wc == 1 ? 4 : 3; }
        }
        if (kind == 0) {
#pragma unroll
            for (int ai = 0; ai < 2; ++ai)
#pragma unroll
                for (int m = 0; m < 4; ++m) { bf16* rowp = QKV + (size_t)(row0 + ai * HALF + m * 16) * NQ + dst + 8 * fq;
#pragma unroll
                    for (int bj = 0; bj < 2; ++bj) { const f32x4 v0 = acc[ai][bj][m][0] * sc, v1 = acc[ai][bj][m][1] * sc;
                        u32x4 w; w.x = cvtpk(v0[0], v0[1]); w.y = cvtpk(v0[2], v0[3]); w.z = cvtpk(v1[0], v1[1]); w.w = cvtpk(v1[2], v1[3]);
                        *(u32x4*)(rowp + bj * HALF) = w; } }
        } else if (kind == 1) {
            float ivf[8];
#pragma unroll
            for (int j = 0; j < 8; ++j) ivf[j] = __builtin_amdgcn_exp2f(-(float)(8 * fq + j) * (13.287712379549449f / 32.f));
            int pos8[2][4];
#pragma unroll
            for (int ai = 0; ai < 2; ++ai)
#pragma unroll
                for (int m = 0; m < 4; ++m) pos8[ai][m] = pos[row0 + ai * HALF + m * 16];
            asm volatile("" ::: "memory");
#pragma unroll
            for (int ai = 0; ai < 2; ++ai)
#pragma unroll
                for (int m = 0; m < 4; ++m) { const int r = row0 + ai * HALF + m * 16; const float pf = (float)pos8[ai][m];
                    f32x4 t0, t1, t2, t3;
#define ROPE_CS(T_, k_, j_) do { const float rev_ = __builtin_amdgcn_fractf((pf * ivf[j_]) * 0.15915494309189535f); T_[k_] = __builtin_amdgcn_cosf(rev_); T_[(k_) + 1] = __builtin_amdgcn_sinf(rev_); } while (0)
                    ROPE_CS(t0, 0, 0); ROPE_CS(t0, 2, 1); ROPE_CS(t1, 0, 2); ROPE_CS(t1, 2, 3); ROPE_CS(t2, 0, 4); ROPE_CS(t2, 2, 5); ROPE_CS(t3, 0, 6); ROPE_CS(t3, 2, 7);
#undef ROPE_CS
                    const f32x4 x1a = acc[ai][0][m][0], x1b = acc[ai][0][m][1], x2a = acc[ai][1][m][0], x2b = acc[ai][1][m][1];
                    float o1[8], o2[8];
                    o1[0] = x1a[0] * t0[0] - x2a[0] * t0[1]; o2[0] = x2a[0] * t0[0] + x1a[0] * t0[1];
                    o1[1] = x1a[1] * t0[2] - x2a[1] * t0[3]; o2[1] = x2a[1] * t0[2] + x1a[1] * t0[3];
                    o1[2] = x1a[2] * t1[0] - x2a[2] * t1[1]; o2[2] = x2a[2] * t1[0] + x1a[2] * t1[1];
                    o1[3] = x1a[3] * t1[2] - x2a[3] * t1[3]; o2[3] = x2a[3] * t1[2] + x1a[3] * t1[3];
                    o1[4] = x1b[0] * t2[0] - x2b[0] * t2[1]; o2[4] = x2b[0] * t2[0] + x1b[0] * t2[1];
                    o1[5] = x1b[1] * t2[2] - x2b[1] * t2[3]; o2[5] = x2b[1] * t2[2] + x1b[1] * t2[3];
                    o1[6] = x1b[2] * t3[0] - x2b[2] * t3[1]; o2[6] = x2b[2] * t3[0] + x1b[2] * t3[1];
                    o1[7] = x1b[3] * t3[2] - x2b[3] * t3[3]; o2[7] = x2b[3] * t3[2] + x1b[3] * t3[3];
                    bf16* rowp = QKV + (size_t)r * NQ + dst + 8 * fq;
                    u32x4 w; w.x = cvtpk(o1[0] * sc, o1[1] * sc); w.y = cvtpk(o1[2] * sc, o1[3] * sc); w.z = cvtpk(o1[4] * sc, o1[5] * sc); w.w = cvtpk(o1[6] * sc, o1[7] * sc);
                    *(u32x4*)(rowp) = w;
                    w.x = cvtpk(o2[0] * sc, o2[1] * sc); w.y = cvtpk(o2[2] * sc, o2[3] * sc); w.z = cvtpk(o2[4] * sc, o2[5] * sc); w.w = cvtpk(o2[6] * sc, o2[7] * sc);
                    *(u32x4*)(rowp + 32) = w; }
        } else if (kind == 4) {
            if (fq == 0) {
#pragma unroll
                for (int ai = 0; ai < 2; ++ai)
#pragma unroll
                    for (int m = 0; m < 4; ++m) { float* ip = iw + (size_t)(row0 + ai * HALF + m * 16) * 8;
                        *(f32x4*)ip = acc[ai][0][m][0] * 0.04419417382415922f; *(f32x4*)(ip + 4) = acc[ai][0][m][1] * 0.04419417382415922f; } }
        } else if (kind == 2) {
            const int b = (u.pm * BM) / SEQ, s_tile = (u.pm * BM) % SEQ, lane = fq * 16 + fr;
            PG8_LAS unsigned char* sw = stg + (wr * 4 + wc) * VT_STAGE_WAVE;
#pragma unroll
            for (int ai = 0; ai < 2; ++ai)
#pragma unroll
                for (int bj = 0; bj < 2; ++bj)
#pragma unroll
                    for (int mp = 0; mp < 2; ++mp) {
#pragma unroll
                        for (int mm = 0; mm < 2; ++mm)
#pragma unroll
                            for (int n = 0; n < 2; ++n) { const f32x4 v = acc[ai][bj][2 * mp + mm][n]; const unsigned w0 = cvtpk(v[0], v[1]), w1 = cvtpk(v[2], v[3]);
                                PG8_LAS unsigned char* wp = sw + (8 * fq + 4 * n) * 80 + (16 * mm + fr) * 2;
                                *(PG8_LAS unsigned short*)(wp) = (unsigned short)w0; *(PG8_LAS unsigned short*)(wp + 80) = (unsigned short)(w0 >> 16);
                                *(PG8_LAS unsigned short*)(wp + 160) = (unsigned short)w1; *(PG8_LAS unsigned short*)(wp + 240) = (unsigned short)(w1 >> 16); }
#pragma unroll
                        for (int j = 0; j < 2; ++j) { const int colr = (lane >> 2) + 16 * j, seg = lane & 3;
                            const u32x4 v = *(const PG8_LAS u32x4*)(sw + colr * 80 + seg * 16);
                            *(u32x4*)(vt + ((size_t)b * vnc + vc0 + bj * vcs + colr) * SEQ + s_tile + ai * HALF + wr * 64 + mp * 32 + seg * 8) = v; }
                    }
        }
    }
};
template <bool FIRST> struct EpiResid {
    static constexpr bool PERM = true; static constexpr bool I8FUSED = false;
    const float* xin; bf16* XR; const float* gate; float oscale;
    __device__ __forceinline__ void operator()(const f32x4 (&acc)[2][2][4][2], const Unit& u, int wr, int wc, int fr, int fq) const {
        const int row0 = u.pm * BM + wr * 64 + fr, col0 = u.pn * BM + wc * 32 + 8 * fq; const int b = (u.pm * BM) / SEQ;
        f32x4 gv[2][2];
#pragma unroll
        for (int bj = 0; bj < 2; ++bj)
#pragma unroll
            for (int n = 0; n < 2; ++n) gv[bj][n] = *(const f32x4*)(gate + (size_t)b * 6144 + col0 + bj * HALF + 4 * n) * oscale;
        if constexpr (!FIRST) {
#pragma unroll
            for (int ai = 0; ai < 2; ++ai) {
                u32x4 rh[4][2];
#pragma unroll
                for (int m = 0; m < 4; ++m)
#pragma unroll
                    for (int bj = 0; bj < 2; ++bj) rh[m][bj] = *(const u32x4*)(XR + (size_t)(row0 + ai * HALF + m * 16) * D + col0 + bj * HALF);
                asm volatile("" ::: "memory");
#pragma unroll
                for (int m = 0; m < 4; ++m) { const size_t ro = (size_t)(row0 + ai * HALF + m * 16) * D + col0;
#pragma unroll
                    for (int bj = 0; bj < 2; ++bj) { const u32x4 w = rh[m][bj];
                        const f32x4 b0 = (f32x4){bflo(w.x), bfhi(w.x), bflo(w.y), bfhi(w.y)}, b1 = (f32x4){bflo(w.z), bfhi(w.z), bflo(w.w), bfhi(w.w)};
                        const f32x4 v0 = b0 + gv[bj][0] * acc[ai][bj][m][0], v1 = b1 + gv[bj][1] * acc[ai][bj][m][1];
                        u32x4 o; o.x = cvtpk(v0[0], v0[1]); o.y = cvtpk(v0[2], v0[3]); o.z = cvtpk(v1[0], v1[1]); o.w = cvtpk(v1[2], v1[3]);
                        *(u32x4*)(XR + ro + bj * HALF) = o; } }
            }
        } else
#pragma unroll
        for (int ai = 0; ai < 2; ++ai)
#pragma unroll
            for (int m = 0; m < 4; ++m) { const size_t ro = (size_t)(row0 + ai * HALF + m * 16) * D + col0;
#pragma unroll
                for (int bj = 0; bj < 2; ++bj) { f32x4 b0, b1;
                    if (FIRST) { b0 = *(const f32x4*)(xin + ro + bj * HALF); b1 = *(const f32x4*)(xin + ro + bj * HALF + 4); }
                    else { const u32x4 w = *(const u32x4*)(XR + ro + bj * HALF); b0 = (f32x4){bflo(w.x), bfhi(w.x), bflo(w.y), bfhi(w.y)}; b1 = (f32x4){bflo(w.z), bfhi(w.z), bflo(w.w), bfhi(w.w)}; }
                    const f32x4 v0 = b0 + gv[bj][0] * acc[ai][bj][m][0], v1 = b1 + gv[bj][1] * acc[ai][bj][m][1];
                    u32x4 o; o.x = cvtpk(v0[0], v0[1]); o.y = cvtpk(v0[2], v0[3]); o.z = cvtpk(v1[0], v1[1]); o.w = cvtpk(v1[2], v1[3]);
                    *(u32x4*)(XR + ro + bj * HALF) = o; } }
    }
};
template <bool FP8OUT> struct EpiSwiGLU {
    static constexpr bool PERM = true; static constexpr bool I8FUSED = FP8OUT;
    __device__ __forceinline__ void i8(const v4i32g (&acc)[2][2][4][2], const f32x4 (&csv)[2][2], const float (&rsv)[2][4], const Unit& u, int wr, int wc, int fr, int fq) const {
        const int row0 = u.pm * BM + wr * 64 + fr, col0 = u.pn * HALF + wc * 32 + 8 * fq;
#pragma unroll
        for (int ai = 0; ai < 2; ++ai)
#pragma unroll
            for (int m = 0; m < 4; ++m) { float v[8]; const float rs = rsv[ai][m], rsl = rs * -1.4426950408889634f, rs2 = rs * rs * FP8_ACT_SCALE;
#pragma unroll
                for (int n = 0; n < 2; ++n)
#pragma unroll
                    for (int i = 0; i < 4; ++i) { const float G = (float)acc[ai][0][m][n][i] * csv[0][n][i], U = (float)acc[ai][1][m][n][i] * csv[1][n][i];
                        v[4 * n + i] = (G * U) * (rs2 * __builtin_amdgcn_rcpf(1.f + __builtin_amdgcn_exp2f(G * rsl))); }
                unsigned char* op_ = (unsigned char*)O + (size_t)(row0 + ai * HALF + m * 16) * ldc + col0;
                *(u32x2*)op_ = (u32x2){pack4_fp8(v[0], v[1], v[2], v[3]), pack4_fp8(v[4], v[5], v[6], v[7])};
                if (ldc == FFEP && u.pn == FFE / HALF - 1) *(u32x2*)(op_ + HALF) = (u32x2){0u, 0u}; }
    }
    void* O; int ldc; float iscale;
    __device__ __forceinline__ void operator()(const f32x4 (&acc)[2][2][4][2], const Unit& u, int wr, int wc, int fr, int fq) const {
        const int row0 = u.pm * BM + wr * 64 + fr, col0 = u.pn * HALF + wc * 32 + 8 * fq;
#pragma unroll
        for (int ai = 0; ai < 2; ++ai)
#pragma unroll
            for (int m = 0; m < 4; ++m) { float v[8];
#pragma unroll
                for (int n = 0; n < 2; ++n)
#pragma unroll
                    for (int i = 0; i < 4; ++i) { const float g = acc[ai][0][m][n][i] * iscale, up = acc[ai][1][m][n][i] * iscale; v[4 * n + i] = g * __builtin_amdgcn_rcpf(1.f + __expf(-g)) * up; }
                if (FP8OUT) { const u32x2 w = (u32x2){pack4_fp8(v[0] * FP8_ACT_SCALE, v[1] * FP8_ACT_SCALE, v[2] * FP8_ACT_SCALE, v[3] * FP8_ACT_SCALE), pack4_fp8(v[4] * FP8_ACT_SCALE, v[5] * FP8_ACT_SCALE, v[6] * FP8_ACT_SCALE, v[7] * FP8_ACT_SCALE)};
                    *(u32x2*)((unsigned char*)O + (size_t)(row0 + ai * HALF + m * 16) * ldc + col0) = w; }
                else { u32x4 w; w.x = cvtpk(v[0], v[1]); w.y = cvtpk(v[2], v[3]); w.z = cvtpk(v[4], v[5]); w.w = cvtpk(v[6], v[7]);
                    *(u32x4*)((bf16*)O + (size_t)(row0 + ai * HALF + m * 16) * ldc + col0) = w; } }
    }
};
struct EpiBf16 {
    static constexpr bool PERM = true; static constexpr bool I8FUSED = false;
    bf16* O; int ldc; float oscale;
    __device__ __forceinline__ void operator()(const f32x4 (&acc)[2][2][4][2], const Unit& u, int wr, int wc, int fr, int fq) const {
        const int row0 = u.pm * BM + wr * 64 + fr, col0 = u.pn * BM + wc * 32 + 8 * fq;
#pragma unroll
        for (int ai = 0; ai < 2; ++ai)
#pragma unroll
            for (int m = 0; m < 4; ++m) { bf16* rowp = O + (size_t)(row0 + ai * HALF + m * 16) * ldc + col0;
#pragma unroll
                for (int bj = 0; bj < 2; ++bj) { const f32x4 v0 = acc[ai][bj][m][0] * oscale, v1 = acc[ai][bj][m][1] * oscale;
                    u32x4 w; w.x = cvtpk(v0[0], v0[1]); w.y = cvtpk(v0[2], v0[3]); w.z = cvtpk(v1[0], v1[1]); w.w = cvtpk(v1[2], v1[3]);
                    *(u32x4*)(rowp + bj * HALF) = w; } }
    }
};
}

#define XB_TMO      128
#define XB_XCNT(j)  (256  + 64 * (j))
#define XB_XSUB(j)  (1280 + 64 * (j))
#define XB_XGEN(j)  (2304 + 64 * (j))
#define XB_TOP      3328
#define XB_TOPGEN   3392
#define XCD_BAR_WORDS 3456
#define XB_SPIN_CAP (1u << 18)
__device__ __forceinline__ unsigned xb_ld(unsigned* p)              { return __hip_atomic_load(p, __ATOMIC_RELAXED, __HIP_MEMORY_SCOPE_AGENT); }
__device__ __forceinline__ unsigned xb_add(unsigned* p, unsigned v) { return __hip_atomic_fetch_add(p, v, __ATOMIC_RELAXED, __HIP_MEMORY_SCOPE_AGENT); }
__device__ __forceinline__ unsigned xb_xcc_id() { return (unsigned)__builtin_amdgcn_s_getreg((3 << 11) | 20) & 0xFu; }
#define XB_SPIN(cond, bar) do { unsigned _sp = 0; while (cond) { __builtin_amdgcn_s_sleep(1); \
    if ((++_sp & 255u) == 0u) { if (xb_ld(&(bar)[XB_TMO])) break; if (_sp > XB_SPIN_CAP) { atomicAdd(&(bar)[XB_TMO], 1u); break; } } } } while (0)
struct XcdBarrier { unsigned* bar; unsigned x; volatile LAS unsigned* st; };
__device__ __forceinline__ XcdBarrier xcd_barrier_post(unsigned* bar, volatile LAS unsigned* st) {
    XcdBarrier b; b.bar = bar; b.x = xb_xcc_id(); b.st = st;
    if (threadIdx.x == 0) (void)xb_add(&bar[XB_XCNT(b.x)], 1u);
    return b;
}
__device__ __forceinline__ void xcd_barrier_complete(unsigned* bar, unsigned x, unsigned& nloc, unsigned& nx) {
    const unsigned G = gridDim.x * gridDim.y * gridDim.z;
    unsigned sum, cnt, mine, sp = 0u;
    for (;;) {
        sum = 0u; cnt = 0u; mine = 0u;
#pragma unroll
        for (unsigned j = 0; j < 16; ++j) { const unsigned c = xb_ld(&bar[XB_XCNT(j)]); sum += c; cnt += (c > 0u) ? 1u : 0u; mine = (j == x) ? c : mine; }
        if (sum == G) break;
        __builtin_amdgcn_s_sleep(1);
        if ((++sp & 255u) == 0u) { if (xb_ld(&bar[XB_TMO])) break; if (sp > XB_SPIN_CAP) { atomicAdd(&bar[XB_TMO], 1u); break; } }
    }
    nloc = mine > 0u ? mine : 1u; nx = cnt > 0u ? cnt : 1u;
}
__device__ __forceinline__ void xcd_barrier(const XcdBarrier& b) {
    asm volatile("s_waitcnt vmcnt(0)" ::: "memory");
    __syncthreads();
    if (threadIdx.x == 0) {
        unsigned* bar = b.bar;
        __builtin_amdgcn_s_waitcnt(0);
        unsigned nloc = b.st[0], nx = b.st[1];
        if (nloc == 0u) { xcd_barrier_complete(bar, b.x, nloc, nx); b.st[0] = nloc; b.st[1] = nx; }
        const unsigned old = xb_add(&bar[XB_XSUB(b.x)], 1u);
        const unsigned gen = old / nloc;
        if (old + 1u == (gen + 1u) * nloc) {
            __builtin_amdgcn_fence(__ATOMIC_RELEASE, "agent");
            asm volatile("s_waitcnt vmcnt(0)" ::: "memory");
            const unsigned og = xb_add(&bar[XB_TOP], 1u);
            const unsigned tg = og / nx;
            if (og + 1u == (tg + 1u) * nx) xb_add(&bar[XB_TOPGEN], 1u);
            else XB_SPIN(xb_ld(&bar[XB_TOPGEN]) == tg, bar);
            __builtin_amdgcn_fence(__ATOMIC_ACQUIRE, "agent");
            xb_add(&bar[XB_XGEN(b.x)], 1u);
            asm volatile("s_waitcnt vmcnt(0)" ::: "memory");
        } else {
            XB_SPIN(xb_ld(&bar[XB_XGEN(b.x)]) == gen, bar);
            __builtin_amdgcn_fence(__ATOMIC_ACQUIRE, "agent");
            asm volatile("s_waitcnt vmcnt(0)" ::: "memory");
        }
    }
    __syncthreads();
}

#define DPP_MOV(v, CTRL) __int_as_float(__builtin_amdgcn_update_dpp(0, __float_as_int(v), (CTRL), 0xf, 0xf, true))
__device__ __forceinline__ float wave_sum(float v) {
    v += DPP_MOV(v, 0xB1); v += DPP_MOV(v, 0x4E); v += DPP_MOV(v, 0x141); v += DPP_MOV(v, 0x140);
    v += __shfl_xor(v, 16);
    auto rr = __builtin_amdgcn_permlane32_swap(__float_as_uint(v), __float_as_uint(v), false, false); return __uint_as_float(rr[0]) + __uint_as_float(rr[1]);
}
__device__ __forceinline__ float wave_max(float v) {
    v = fmaxf(v, DPP_MOV(v, 0xB1)); v = fmaxf(v, DPP_MOV(v, 0x4E)); v = fmaxf(v, DPP_MOV(v, 0x141)); v = fmaxf(v, DPP_MOV(v, 0x140));
    v = fmaxf(v, __shfl_xor(v, 16));
    auto rr = __builtin_amdgcn_permlane32_swap(__float_as_uint(v), __float_as_uint(v), false, false); return fmaxf(__uint_as_float(rr[0]), __uint_as_float(rr[1]));
}
__device__ __forceinline__ float swap_max(float v) { auto rr = __builtin_amdgcn_permlane32_swap(__float_as_uint(v), __float_as_uint(v), false, false); return fmaxf(__uint_as_float(rr[0]), __uint_as_float(rr[1])); }
__device__ __forceinline__ float swap_sum(float v) { auto rr = __builtin_amdgcn_permlane32_swap(__float_as_uint(v), __float_as_uint(v), false, false); return __uint_as_float(rr[0]) + __uint_as_float(rr[1]); }

__device__ __forceinline__ void sincos_d(double a, float& sn, float& cn) {
    const double k = __builtin_rint(a * 0.63661977236758134308);
    double r = __builtin_fma(-k, 1.57079632673412561417e+00, a);
    r = __builtin_fma(-k, 6.07710050650619224932e-11, r);
    r = __builtin_fma(-k, 2.02226624879595063154e-21, r);
    const double z = r * r;
    const double sp = r + r * z * (-1.66666666666666324348e-01 + z * (8.33333333332248946124e-03 + z * (-1.98412698298579493134e-04 + z * (2.75573137070700676789e-06 + z * (-2.50507602534068634195e-08 + z * 1.58969099521155010221e-10)))));
    const double cp = 1.0 - 0.5 * z + z * z * (4.16666666666666019037e-02 + z * (-1.38888888888741095749e-03 + z * (2.48015872894767294178e-05 + z * (-2.75573143513906633035e-07 + z * (2.08757232129817482790e-09 + z * -1.13596475577881948265e-11)))));
    const int q = ((int)k) & 3;
    const double s = (q == 0) ? sp : (q == 1) ? cp : (q == 2) ? -sp : -cp;
    const double c = (q == 0) ? cp : (q == 1) ? -sp : (q == 2) ? -cp : sp;
    sn = (float)s; cn = (float)c;
}

struct Args { const void* in[26]; float* out; unsigned char* ws; int ph_lo, ph_hi; };
struct Frame {
    LAS unsigned char* lds; unsigned* ctl; unsigned char* ws;
    int tid, lane, wave, G, blk;
};

__device__ __forceinline__ void conv_item(const float* W, int ld, int col0, bf16* WT, int K, int dstrow0, int k0, LAS float* scr, int lane) {
    if (col0 >= 0) {
#pragma unroll 8
        for (int i = 0; i < 32; ++i) { const int kk = 2 * i + (lane >> 5); scr[kk * 33 + (lane & 31)] = W[(size_t)(k0 + kk) * ld + col0 + (lane & 31)]; }
    } else {
#pragma unroll 8
        for (int i = 0; i < 32; ++i) { const int kk = 2 * i + (lane >> 5); scr[kk * 33 + (lane & 31)] = 0.f; }
    }
    asm volatile("s_waitcnt lgkmcnt(0)" ::: "memory");
    const int c = lane & 7;
#pragma unroll
    for (int j = 0; j < 4; ++j) { const int n = (lane >> 3) + 8 * j; const LAS float* s = scr + (8 * c) * 33 + n;
        u32x4 o; o.x = cvtpk(s[0 * 33], s[1 * 33]); o.y = cvtpk(s[2 * 33], s[3 * 33]); o.z = cvtpk(s[4 * 33], s[5 * 33]); o.w = cvtpk(s[6 * 33], s[7 * 33]);
        *(u32x4*)(WT + (size_t)(dstrow0 + n) * K + k0 + 8 * c) = o; }
    asm volatile("s_waitcnt lgkmcnt(0)" ::: "memory");
}
__device__ __forceinline__ void conv_item_fp8(const float* W, int ld, int col0, unsigned char* WT, int Kp, int dstrow0, int k0, LAS float* scr, int lane) {
#pragma unroll 8
    for (int i = 0; i < 32; ++i) { const int kk = 2 * i + (lane >> 5); scr[kk * 33 + (lane & 31)] = W[(size_t)(k0 + kk) * ld + col0 + (lane & 31)] * FP8_W_SCALE; }
    asm volatile("s_waitcnt lgkmcnt(0)" ::: "memory");
    const int c = lane & 7;
#pragma unroll
    for (int j = 0; j < 4; ++j) { const int n = (lane >> 3) + 8 * j; const LAS float* sp = scr + (8 * c) * 33 + n;
        const u32x2 o = (u32x2){pack4_fp8(sp[0 * 33], sp[1 * 33], sp[2 * 33], sp[3 * 33]), pack4_fp8(sp[4 * 33], sp[5 * 33], sp[6 * 33], sp[7 * 33])};
        *(u32x2*)(WT + (size_t)(dstrow0 + n) * Kp + k0 + 8 * c) = o; }
    asm volatile("s_waitcnt lgkmcnt(0)" ::: "memory");
}
__device__ __forceinline__ int map_win0(int n0) {
    const int pn = n0 >> 8, bj = (n0 >> 7) & 1, x = n0 & 127;
    if (pn < 6) return n0;
    if (pn < 8) return 1544 + (4 * (pn - 6) + (x >> 5)) * 64 + 32 * bj;
    return x < 64 ? 2056 + (x >> 5) * 64 + 32 * bj : 2184 + 64 * bj + (x - 64);
}
__device__ __forceinline__ int map_win1(int n0) {
    const int pn = n0 >> 8, bj = (n0 >> 7) & 1, x = n0 & 127;
    if (pn < 4) return (4 * pn + (x >> 5)) * 64 + 32 * bj;
    if (pn == 4) return 1024 + (x >> 5) * 64 + 32 * bj;
    if (pn == 5) return 1280 + 128 * bj + x;
    if (pn < 8) return 1536 + (4 * (pn - 6) + (x >> 5)) * 64 + 32 * bj;
    if (x == 32 && bj == 0) return 2112;
    return x == 0 ? 2048 + 32 * bj : -1;
}

__device__ __forceinline__ void p0_prologue(Frame& F, const Args& a) {
    const float* c_in = (const float*)a.in[1]; const int* pos = (const int*)a.in[2];
    float* mod = (float*)(F.ws + WS_MOD);
    {
        LAS float* sl = (LAS float*)F.lds; LAS float* red = (LAS float*)(F.lds + 65536);
        bool have = false;
        for (int job = F.blk; job < 192; job += F.G) {
            if (!have) { for (int i = F.tid; i < 16 * 1024; i += 512) { const float c = c_in[i]; sl[i] = c / (1.f + __expf(-c)); } __syncthreads(); have = true; }
            const int l = job / 96, n0 = (job % 96) * 64;
            const float* W = (const float*)a.in[l == 0 ? 3 : 14] + n0 + F.lane; const float* bias = (const float*)a.in[l == 0 ? 4 : 15];
            float acc[16];
#pragma unroll
            for (int b = 0; b < 16; ++b) acc[b] = 0.f;
            const int kb = F.wave * 128;
            float wv[2][32];
#pragma unroll
            for (int i = 0; i < 32; ++i) wv[0][i] = W[(size_t)(kb + i) * 6144];
#pragma unroll
            for (int c = 0; c < 4; ++c) {
                if (c + 1 < 4) {
#pragma unroll
                    for (int i = 0; i < 32; ++i) wv[(c + 1) & 1][i] = W[(size_t)(kb + 32 * (c + 1) + i) * 6144]; }
#pragma unroll
                for (int b = 0; b < 16; ++b)
#pragma unroll
                    for (int i4 = 0; i4 < 8; ++i4) { const f32x4 sv = *(const LAS f32x4*)(sl + b * 1024 + kb + 32 * c + 4 * i4);
                        acc[b] += (sv[0] * wv[c & 1][4 * i4] + sv[1] * wv[c & 1][4 * i4 + 1]) + (sv[2] * wv[c & 1][4 * i4 + 2] + sv[3] * wv[c & 1][4 * i4 + 3]); }
            }
#pragma unroll
            for (int b = 0; b < 16; ++b) red[(F.wave * 16 + b) * 64 + F.lane] = acc[b];
            __syncthreads();
            for (int i = F.tid; i < 16 * 64; i += 512) { const int b = i >> 6, ln = i & 63; float s = bias[n0 + ln];
#pragma unroll
                for (int w = 0; w < 8; ++w) s += red[(w * 16 + b) * 64 + ln];
                mod[((size_t)l * 16 + b) * 6144 + n0 + ln] = s; }
            __syncthreads();
        }
        __syncthreads();
    }
    {
        LAS float* scr = (LAS float*)(F.lds + F.wave * 16384);
        const int gw = F.blk * 8 + F.wave, NGW = F.G * 8;
        constexpr int I1 = 16 * (NQ / 32), I2 = 16 * 32, I3 = 16 * (2 * FF / 32), I4 = (FF / 64) * 32, I7 = 16 * (2 * FFE / 32), I8 = (FFE / 64) * 32;
        constexpr int NITEMS = 2 * I2 + I4 + NE * I8;
        for (int it = gw; it < NITEMS; it += NGW) {
            int r = it;
            if (r < I2) { const int nb = r % 32, kb = r / 32; conv_item_fp8((const float*)a.in[10], D, 32 * nb, F.ws + WS_WOUT0, D, 32 * nb, 64 * kb, scr, F.lane); continue; } r -= I2;
            if (r < I4) { const int nb = r % 32, kb = r / 32; conv_item_fp8((const float*)a.in[13], D, 32 * nb, F.ws + WS_WDN0, FF, 32 * nb, 64 * kb, scr, F.lane); continue; } r -= I4;
            if (r < I2) { const int nb = r % 32, kb = r / 32; conv_item_fp8((const float*)a.in[19], D, 32 * nb, F.ws + WS_WOUT1, D, 32 * nb, 64 * kb, scr, F.lane); continue; } r -= I2;
            { const int e = r / I8; r -= e * I8; const int nb = r % 32, kb = r / 32;
                conv_item_fp8((const float*)a.in[24] + (size_t)e * FFE * D, D, 32 * nb, F.ws + WS_WDN1 + (size_t)e * D * FFEP, FFEP, 32 * nb, 64 * kb, scr, F.lane); }
        }
    }
}

struct QItem { const float* W; unsigned char* WT; int ld, col0, drow, k0, cs, ncol; };
__device__ __forceinline__ QItem q_item(int it, const Args& a, unsigned char* ws) {
    QItem q; const int kb = it & 15; int nb = it >> 4; q.k0 = 64 * kb; q.cs = 32 * nb; q.ncol = 32;
    if (nb < 72) { q.W = (const float*)a.in[7]; q.ld = E_IN; q.col0 = map_win0(32 * nb); q.WT = ws + WS_WIN0; q.drow = 32 * nb; return q; } nb -= 72;
    if (nb < 176) { const int n0 = 32 * nb, pn = n0 >> 8, bj = (n0 >> 7) & 1, x = n0 & 127; q.W = (const float*)a.in[bj ? 12 : 11]; q.ld = FF; q.col0 = 128 * pn + x; q.WT = ws + WS_WGU0; q.drow = n0; return q; } nb -= 176;
    if (nb < 72) { q.W = (const float*)a.in[18]; q.ld = O_IN; q.col0 = map_win1(32 * nb); q.WT = ws + WS_WIN1; q.drow = 32 * nb; if (q.col0 == 2112) q.ncol = O_IN - 2112; return q; } nb -= 72;
    { const int e = nb / 88; nb -= e * 88; const int n0 = 32 * nb, pn = n0 >> 8, bj = (n0 >> 7) & 1, x = n0 & 127;
      q.W = (const float*)a.in[bj ? 23 : 22] + (size_t)e * D * FFE; q.ld = FFE; q.col0 = 128 * pn + x; q.WT = ws + WS_WGU1 + (size_t)e * 2 * FFE * D; q.drow = n0; return q; }
}
__device__ __forceinline__ void q_strips(Frame& F, const Args& a) {
    LAS float* scr = (LAS float*)(F.lds + F.wave * 16384);
    LAS float* cmx = (LAS float*)(F.lds + VT_STAGE_OFF);
    float* cst = (float*)(F.ws + WS_CS);
    for (int st = F.blk; st < CS_END / 32; st += F.G) {
        const QItem q = q_item(st * 16, a, F.ws);
        float r[2][32]; float am = 0.f;
#pragma unroll
        for (int j = 0; j < 2; ++j) {
            if (q.col0 >= 0) { const bool cv = (F.lane & 31) < q.ncol;
                const float* wp = q.W + (size_t)(64 * (2 * F.wave + j) + (F.lane >> 5)) * q.ld + q.col0 + (cv ? (F.lane & 31) : 0);
#pragma unroll
                for (int i = 0; i < 32; ++i) { const float w = wp[(size_t)(2 * i) * q.ld]; r[j][i] = cv ? w : 0.f; } }
            else {
#pragma unroll
                for (int i = 0; i < 32; ++i) r[j][i] = 0.f; } }
#pragma unroll
        for (int j = 0; j < 2; ++j)
#pragma unroll
            for (int i = 0; i < 32; ++i) am = fmaxf(am, fabsf(r[j][i]));
        am = fmaxf(am, __shfl_xor(am, 32));
        if (F.lane < 32) cmx[F.wave * 32 + F.lane] = am;
        __syncthreads();
        am = cmx[F.lane & 31];
#pragma unroll
        for (int w = 1; w < 8; ++w) am = fmaxf(am, cmx[w * 32 + (F.lane & 31)]);
        const float inv = am > 0.f ? 127.f / am : 0.f;
        if (F.wave == 0 && F.lane < 32) cst[q.cs + F.lane] = am > 0.f ? am * (1.f / 127.f) : 1.f;
#pragma unroll
        for (int j = 0; j < 2; ++j) { const int k0 = 64 * (2 * F.wave + j);
#pragma unroll
            for (int i = 0; i < 32; ++i) scr[(2 * i + (F.lane >> 5)) * 33 + (F.lane & 31)] = rintf(r[j][i] * inv);
            asm volatile("s_waitcnt lgkmcnt(0)" ::: "memory");
            const int c = F.lane & 7;
#pragma unroll
            for (int jj = 0; jj < 4; ++jj) { const int n = (F.lane >> 3) + 8 * jj; const LAS float* sp = scr + (8 * c) * 33 + n;
                *(u32x2*)(q.WT + (size_t)(q.drow + n) * D + k0 + 8 * c) = (u32x2){pack4_i8(sp[0 * 33], sp[1 * 33], sp[2 * 33], sp[3 * 33]), pack4_i8(sp[4 * 33], sp[5 * 33], sp[6 * 33], sp[7 * 33])}; }
            asm volatile("s_waitcnt lgkmcnt(0)" ::: "memory"); }
        __syncthreads();
    }
}
__device__ __forceinline__ void zero_kpad(Frame& F, unsigned char* base, int rows) {
    constexpr int CH = (FFEP - FFE) / 16;
    for (int i = F.blk * 512 + F.tid; i < rows * CH; i += F.G * 512) { const int row = i / CH, ch = i % CH; *(u32x4*)(base + (size_t)row * FFEP + FFE + 16 * ch) = (u32x4){0u, 0u, 0u, 0u}; }
}
template <int SIDE  , bool SRC_BF16, int HOUT = 0  >
__device__ __forceinline__ void norm_phase(Frame& F, const void* src, const float* gamma, const float* modl, int sh_off, int sc_off, bf16* H,
                                           const float* Wside, int ldw, int wcol0, const float* bside, float* side_out) {
    const int rpb = T / F.G, row_lo = F.blk * rpb;
    LAS int* lcnt = (LAS int*)F.lds;
    LAS int* rinfo = (LAS int*)(F.lds + 256);
    if (SIDE == 3) { if (F.tid < 16) lcnt[F.tid] = 0; __syncthreads(); }
    float wreg[4][4][8];
    if (SIDE != 0) {
#pragma unroll
        for (int jj = 0; jj < 4; ++jj)
#pragma unroll
            for (int i = 0; i < 4; ++i) { const int k = 4 * F.lane + 256 * jj + i; const f32x4 w0 = *(const f32x4*)(Wside + (size_t)k * ldw + wcol0), w1 = *(const f32x4*)(Wside + (size_t)k * ldw + wcol0 + 4);
                wreg[jj][i][0] = w0[0]; wreg[jj][i][1] = w0[1]; wreg[jj][i][2] = w0[2]; wreg[jj][i][3] = w0[3]; wreg[jj][i][4] = w1[0]; wreg[jj][i][5] = w1[1]; wreg[jj][i][6] = w1[2]; wreg[jj][i][7] = w1[3]; }
    }
    f32x4 gm[4], av[4], shv[4];
#pragma unroll
    for (int jj = 0; jj < 4; ++jj) gm[jj] = *(const f32x4*)(gamma + 4 * F.lane + 256 * jj);
    float bs8[8]; float bs_lane = 0.f;
#pragma unroll
    for (int j = 0; j < 8; ++j) bs8[j] = 0.f;
    if (SIDE == 3) {
#pragma unroll
        for (int j = 0; j < 8; ++j) bs8[j] = bside[j]; }
    if (SIDE == 1) { if (F.lane < 8) bs_lane = bside[F.lane]; }
    int curb = -1;
    f32x4 nxf[4]; u32x2 nxh[4];
#define NORM_LOAD(row_) do { _Pragma("unroll") for (int jj = 0; jj < 4; ++jj) { \
        if (SRC_BF16) nxh[jj] = ((const u32x2*)((const bf16*)src + (size_t)(row_) * D) + F.lane)[64 * jj]; \
        else nxf[jj] = ((const f32x4*)((const float*)src + (size_t)(row_) * D) + F.lane)[64 * jj]; } } while (0)
    NORM_LOAD(row_lo + F.wave);
    for (int lr = F.wave; lr < rpb; lr += 8) {
        const int row = row_lo + lr, b = row / SEQ;
        if (b != curb) { curb = b;
#pragma unroll
            for (int jj = 0; jj < 4; ++jj) { const f32x4 scv = *(const f32x4*)(modl + (size_t)b * 6144 + sc_off + 4 * F.lane + 256 * jj); shv[jj] = *(const f32x4*)(modl + (size_t)b * 6144 + sh_off + 4 * F.lane + 256 * jj); av[jj] = gm[jj] * (scv + 1.f); } }
        f32x4 v[4]; float ss = 0.f, rowscale = 1.f;
#pragma unroll
        for (int jj = 0; jj < 4; ++jj) {
            if (SRC_BF16) { const u32x2 w = nxh[jj]; v[jj] = (f32x4){bflo(w.x), bfhi(w.x), bflo(w.y), bfhi(w.y)}; }
            else v[jj] = nxf[jj]; }
        if (lr + 8 < rpb) NORM_LOAD(row + 8);
#pragma unroll
        for (int jj = 0; jj < 4; ++jj) {
            ss += (v[jj][0] * v[jj][0] + v[jj][1] * v[jj][1]) + (v[jj][2] * v[jj][2] + v[jj][3] * v[jj][3]); }
        const float rstd = rsqrtf(wave_sum(ss) * (1.f / D) + NORM_EPS);
        u32x2* o8 = (u32x2*)(H + (size_t)row * D) + F.lane;
#pragma unroll
        for (int jj = 0; jj < 4; ++jj) { v[jj] = v[jj] * rstd * av[jj] + shv[jj];
            if (HOUT == 1) ((unsigned*)((unsigned char*)H + (size_t)row * D) + F.lane)[64 * jj] = pack4_fp8(v[jj][0] * FP8_H_SCALE, v[jj][1] * FP8_H_SCALE, v[jj][2] * FP8_H_SCALE, v[jj][3] * FP8_H_SCALE);
            else if (HOUT == 0) o8[64 * jj] = (u32x2){cvtpk(v[jj][0], v[jj][1]), cvtpk(v[jj][2], v[jj][3])}; }
        if (HOUT == 2) {
            float am = 0.f;
#pragma unroll
            for (int jj = 0; jj < 4; ++jj) am = fmaxf(fmaxf(am, fmaxf(fabsf(v[jj][0]), fabsf(v[jj][1]))), fmaxf(fabsf(v[jj][2]), fabsf(v[jj][3])));
            am = wave_max(am);
            const float inv = am > 0.f ? 127.f / am : 0.f;
#pragma unroll
            for (int jj = 0; jj < 4; ++jj) ((unsigned*)((unsigned char*)H + (size_t)row * D) + F.lane)[64 * jj] = pack4_i8(rintf(v[jj][0] * inv), rintf(v[jj][1] * inv), rintf(v[jj][2] * inv), rintf(v[jj][3] * inv));
            rowscale = am > 0.f ? am * (1.f / 127.f) : 1.f;
            if (F.lane == 0) ((float*)(F.ws + WS_RS))[row] = rowscale;
        }
        if (SIDE != 0) {
            float s[8];
#pragma unroll
            for (int j = 0; j < 8; ++j) { float t = 0.f;
#pragma unroll
                for (int jj = 0; jj < 4; ++jj)
#pragma unroll
                    for (int i = 0; i < 4; ++i) t += v[jj][i] * wreg[jj][i][j];
                s[j] = wave_sum(t); }
            if (SIDE == 1 || SIDE == 2) {
                float mine = 0.f;
#pragma unroll
                for (int j = 0; j < 8; ++j) if (F.lane == j) mine = s[j];
                if (F.lane < 8) {
                    if (SIDE == 1) { const float z = mine + bs_lane; mine = z < 0.f ? z - __logf(1.f + __expf(z)) : -__logf(1.f + __expf(-z)); }
                    else mine *= 0.04419417382415922f;
                    side_out[(size_t)row * 8 + F.lane] = mine; }
            } else {
                float l1 = -INFINITY, l2 = -INFINITY; int e1 = 0, e2 = 0;
#pragma unroll
                for (int j = 0; j < 8; ++j) { const float lg = s[j] + bs8[j]; if (lg > l1) { l2 = l1; e2 = e1; l1 = lg; e1 = j; } else if (lg > l2) { l2 = lg; e2 = j; } }
                const float g1 = 1.f / (1.f + __expf(l2 - l1));
                if (F.lane == 0) { const int sl1 = atomicAdd((int*)&lcnt[e1], 1), sl2 = atomicAdd((int*)&lcnt[e2], 1);
                    LAS int* ri = rinfo + lr * 8; ri[0] = e1; ri[1] = e2; ri[2] = sl1; ri[3] = sl2; ri[4] = (int)__float_as_uint(g1); ri[5] = (int)__float_as_uint(rowscale); }
            }
        }
    }
#undef NORM_LOAD
    if (SIDE == 3) {
        __syncthreads();
        if (F.tid < 8) lcnt[8 + F.tid] = (int)__hip_atomic_fetch_add(F.ctl + CW_CNT + 64 * F.tid, (unsigned)lcnt[F.tid], __ATOMIC_RELAXED, __HIP_MEMORY_SCOPE_AGENT);
        __syncthreads();
        int* list = (int*)(F.ws + WS_LIST); u32x4* tok = (u32x4*)(F.ws + WS_TOK);
        for (int lr = F.tid; lr < rpb; lr += 512) { const LAS int* ri = rinfo + lr * 8; const int e1 = ri[0], e2 = ri[1]; const int s1 = lcnt[8 + e1] + ri[2], s2 = lcnt[8 + e2] + ri[3]; const int row = row_lo + lr;
            list[(size_t)e1 * T + s1] = row; list[(size_t)e2 * T + s2] = row;
            { float* rss = (float*)(F.ws + WS_RSS); const float sc = __uint_as_float((unsigned)ri[5]); rss[(size_t)e1 * T + s1] = sc; rss[(size_t)e2 * T + s2] = sc; }
            tok[row] = (u32x4){(unsigned)(e1 | (e2 << 8)), (unsigned)s1, (unsigned)s2, (unsigned)ri[4]}; }
        __syncthreads();
    }
}

__device__ __forceinline__ void cumsum_kaug(Frame& F) {
    const int gw = (F.blk - (F.G - BATCH)) * 8 + F.wave;
    if (F.blk < F.G - BATCH || gw >= BATCH * 8) return;
    const int b = gw >> 3, h = gw & 7;
    const float* lf = (const float*)(F.ws + WS_LOGF) + (size_t)b * SEQ * 8 + h;
    float v[32]; float run = 0.f;
#pragma unroll
    for (int i = 0; i < 32; ++i) { run += lf[(size_t)(32 * F.lane + i) * 8]; v[i] = run; }
    float incl = run;
#pragma unroll
    for (int o = 1; o < 64; o <<= 1) { const float t = __shfl_up(incl, o); if (F.lane >= o) incl += t; }
    const float excl = incl - run;
    u32x4* ka = (u32x4*)(F.ws + WS_KAUG) + (size_t)gw * SEQ + 32 * F.lane;
#pragma unroll
    for (int i = 0; i < 32; ++i) { const float bias = -(excl + v[i]) * 1.4426950408889634f;
        const unsigned h1 = cvtpk(bias, 0.f) & 0xffffu; const float r1 = bias - bflo(h1);
        const unsigned h2 = cvtpk(r1, 0.f) & 0xffffu; const float r2 = r1 - bflo(h2);
        const unsigned h3 = cvtpk(r2, 0.f) & 0xffffu;
        ka[i] = (u32x4){h1 | (h2 << 16), h3, 0u, 0u}; }
}

constexpr int ATT_BUF = 17408;
template <int MODE  >
__device__ __forceinline__ void attn_unit(LAS unsigned char* lds, const int wave, const int lane,
                                          const bf16* __restrict__ Kg, const bf16* __restrict__ VTg, const u32x4* __restrict__ kaug_g,
                                          const bf16* __restrict__ Qp, unsigned char* __restrict__ Op, const int q0, const int tw_lo, const int tw_hi, const int T_lo, const int T_hi,
                                          const float sinkl2, const unsigned long long* __restrict__ mb) {
    const int r32 = lane & 31, hi = lane >> 5;
    bf16x8 qf[4];
#pragma unroll
    for (int d0 = 0; d0 < 4; ++d0) qf[d0] = *(const bf16x8*)(Qp + (size_t)r32 * NQ + d0 * 16 + hi * 8);
    const int kr = (r32 & ~12) | ((r32 & 4) << 1) | ((r32 & 8) >> 1);
    const int ksw = (kr >> 1) & 7, vsw = (r32 >> 1) & 7;
    int koff[4], voff[2][2];
#pragma unroll
    for (int d0 = 0; d0 < 4; ++d0) koff[d0] = kr * 128 + (((2 * d0 + hi) ^ ksw) << 4);
#pragma unroll
    for (int hf = 0; hf < 2; ++hf)
#pragma unroll
        for (int s = 0; s < 2; ++s) voff[hf][s] = 8192 + r32 * 128 + (((4 * hf + 2 * s + hi) ^ vsw) << 4);
    const int kaoff = 16384 + kr * 16;
    const int drow = 8 * wave + (lane >> 3), dc = (lane & 7) ^ ((drow >> 1) & 7);
    const bf16* ksrc = Kg + (size_t)drow * NQ + dc * 8;
    const bf16* vsrc = VTg + (size_t)drow * SEQ + dc * 8;
#define ATT_DMA(t, b) do { \
        __builtin_amdgcn_global_load_lds((const unsigned*)(ksrc + (size_t)(t) * 64 * NQ), (LAS unsigned*)(lds + (b) * ATT_BUF + wave * 1024), 16, 0, 0); \
        __builtin_amdgcn_global_load_lds((const unsigned*)(vsrc + (t) * 64), (LAS unsigned*)(lds + (b) * ATT_BUF + 8192 + wave * 1024), 16, 0, 0); \
        if (MODE == 0) { if (wave == 0) __builtin_amdgcn_global_load_lds((const unsigned*)(kaug_g + (t) * 64 + lane), (LAS unsigned*)(lds + (b) * ATT_BUF + 16384), 16, 0, 0); } } while (0)
    bf16x8 qaug = (bf16x8){0, 0, 0, 0, 0, 0, 0, 0};
    if (MODE == 0 && hi == 0) { qaug[0] = (short)0x3F80; qaug[1] = (short)0x3F80; qaug[2] = (short)0x3F80; }
    f32x16 o0, o1;
#pragma unroll
    for (int r = 0; r < 16; ++r) { o0[r] = 0.f; o1[r] = 0.f; }
    float m = (MODE == 1) ? sinkl2 : 0.f, l = (MODE == 1 && hi == 0) ? 1.f : 0.f;
    f32x16 negm;
#pragma unroll
    for (int r = 0; r < 16; ++r) negm[r] = -m;
    const int q = q0 + r32;
    asm volatile("" ::: "memory"); __builtin_amdgcn_s_barrier(); asm volatile("" ::: "memory");
    ATT_DMA(T_lo, 0);
    unsigned long long wn = 0ull;
    if (MODE == 2) wn = mb[(size_t)r32 * 32 + T_lo];
    for (int t = T_lo; t < T_hi; ++t) {
        const int buf = (t - T_lo) & 1;
        asm volatile("s_waitcnt vmcnt(0)" ::: "memory"); __builtin_amdgcn_s_barrier(); asm volatile("" ::: "memory");
        if (t + 1 < T_hi) ATT_DMA(t + 1, buf ^ 1);
        const unsigned long long w = wn;
        if (MODE == 2) { if (t + 1 < T_hi) wn = mb[(size_t)r32 * 32 + t + 1]; }
        if (t < tw_lo || t >= tw_hi) continue;
        const int key0 = t * 64;
        const LAS unsigned char* tb = lds + buf * ATT_BUF;
        f32x16 p0, p1;
#pragma unroll
        for (int d0 = 0; d0 < 4; ++d0) { const bf16x8 k0 = *(const LAS bf16x8*)(tb + koff[d0]), k1 = *(const LAS bf16x8*)(tb + 4096 + koff[d0]);
            p0 = __builtin_amdgcn_mfma_f32_32x32x16_bf16(k0, qf[d0], d0 == 0 ? negm : p0, 0, 0, 0); p1 = __builtin_amdgcn_mfma_f32_32x32x16_bf16(k1, qf[d0], d0 == 0 ? negm : p1, 0, 0, 0); }
        if (MODE == 0) { const bf16x8 a0 = *(const LAS bf16x8*)(tb + kaoff), a1 = *(const LAS bf16x8*)(tb + kaoff + 512);
            p0 = __builtin_amdgcn_mfma_f32_32x32x16_bf16(a0, qaug, p0, 0, 0, 0); p1 = __builtin_amdgcn_mfma_f32_32x32x16_bf16(a1, qaug, p1, 0, 0, 0); }
        bf16x8 vf[2][2][2];
#pragma unroll
        for (int dt = 0; dt < 2; ++dt)
#pragma unroll
            for (int hf = 0; hf < 2; ++hf)
#pragma unroll
                for (int s = 0; s < 2; ++s) vf[dt][hf][s] = *(const LAS bf16x8*)(tb + dt * 4096 + voff[hf][s]);
        if (MODE == 0) { if (key0 + 63 > q0) {
#pragma unroll
            for (int r = 0; r < 16; ++r) { const int key = key0 + 16 * (r >> 3) + 8 * hi + (r & 7); if (key > q) p0[r] = -1e30f; if (key + 32 > q) p1[r] = -1e30f; } } }
        if (MODE == 1) {
#pragma unroll
            for (int r = 0; r < 16; ++r) { const int key = key0 + 16 * (r >> 3) + 8 * hi + (r & 7); if (key > q || key <= q - 128) p0[r] = -1e30f; if (key + 32 > q || key + 32 <= q - 128) p1[r] = -1e30f; } }
        float mq[4];
#pragma unroll
        for (int j = 0; j < 4; ++j) { float t_ = fmaxf(fmaxf(p0[4 * j], p0[4 * j + 1]), p0[4 * j + 2]); t_ = fmaxf(fmaxf(t_, p0[4 * j + 3]), p1[4 * j]); t_ = fmaxf(fmaxf(t_, p1[4 * j + 1]), p1[4 * j + 2]); mq[j] = fmaxf(t_, p1[4 * j + 3]); }
        float mx = fmaxf(fmaxf(fmaxf(mq[0], mq[1]), mq[2]), mq[3]);
        mx = swap_max(mx);
        if (__any(mx > 8.f)) {
            const float dl = fmaxf(mx, 0.f); const float f = __builtin_amdgcn_exp2f(-dl); m += dl; l *= f;
#pragma unroll
            for (int r = 0; r < 16; ++r) { o0[r] *= f; o1[r] *= f; p0[r] -= dl; p1[r] -= dl; negm[r] = -m; }
        }
#pragma unroll
        for (int r = 0; r < 16; ++r) { p0[r] = __builtin_amdgcn_exp2f(p0[r]); p1[r] = __builtin_amdgcn_exp2f(p1[r]); }
        if (MODE == 2) {
            const unsigned wlo = (unsigned)w >> (8 * hi), whi = (unsigned)(w >> 32) >> (8 * hi);
#pragma unroll
            for (int r = 0; r < 16; ++r) { const int bit = 16 * (r >> 3) + (r & 7); int m0, m1;
                asm("v_bfe_i32 %0, %1, %2, 1" : "=v"(m0) : "v"(wlo), "n"(bit)); asm("v_bfe_i32 %0, %1, %2, 1" : "=v"(m1) : "v"(whi), "n"(bit));
                p0[r] = __uint_as_float(__float_as_uint(p0[r]) & (unsigned)m0); p1[r] = __uint_as_float(__float_as_uint(p1[r]) & (unsigned)m1); }
        }
        float ls = 0.f;
#pragma unroll
        for (int r = 0; r < 16; ++r) ls += p0[r] + p1[r];
        l += ls;
        bf16x8 pb[2][2];
#pragma unroll
        for (int s = 0; s < 2; ++s) {
            u32x4 a, b2;
            a.x = cvtpk(p0[8 * s + 0], p0[8 * s + 1]); a.y = cvtpk(p0[8 * s + 2], p0[8 * s + 3]); a.z = cvtpk(p0[8 * s + 4], p0[8 * s + 5]); a.w = cvtpk(p0[8 * s + 6], p0[8 * s + 7]);
            b2.x = cvtpk(p1[8 * s + 0], p1[8 * s + 1]); b2.y = cvtpk(p1[8 * s + 2], p1[8 * s + 3]); b2.z = cvtpk(p1[8 * s + 4], p1[8 * s + 5]); b2.w = cvtpk(p1[8 * s + 6], p1[8 * s + 7]);
            pb[0][s] = __builtin_bit_cast(bf16x8, a); pb[1][s] = __builtin_bit_cast(bf16x8, b2); }
#pragma unroll
        for (int hf = 0; hf < 2; ++hf)
#pragma unroll
            for (int s = 0; s < 2; ++s) { o0 = __builtin_amdgcn_mfma_f32_32x32x16_bf16(vf[0][hf][s], pb[hf][s], o0, 0, 0, 0); o1 = __builtin_amdgcn_mfma_f32_32x32x16_bf16(vf[1][hf][s], pb[hf][s], o1, 0, 0, 0); }
    }
#undef ATT_DMA
    l = swap_sum(l);
    const float inv = FP8_MIX_SCALE / l;
    unsigned char* orow = Op + (size_t)r32 * D + 4 * hi;
#pragma unroll
    for (int g = 0; g < 4; ++g) {
        *(unsigned*)(orow + 8 * g) = pack4_fp8(o0[4 * g] * inv, o0[4 * g + 1] * inv, o0[4 * g + 2] * inv, o0[4 * g + 3] * inv);
        *(unsigned*)(orow + 32 + 8 * g) = pack4_fp8(o1[4 * g] * inv, o1[4 * g + 1] * inv, o1[4 * g + 2] * inv, o1[4 * g + 3] * inv); }
}

__device__ __forceinline__ void attn0_phase(Frame& F, const float* sinks) {
    const bf16* QKV = (const bf16*)(F.ws + WS_QKV); unsigned char* MIX = F.ws + WS_MIX;
    const bf16* VTF = (const bf16*)(F.ws + WS_VT); const bf16* VTS = (const bf16*)(F.ws + WS_VT_SWA);
    const u32x4* KA = (const u32x4*)(F.ws + WS_KAUG);
    for (int it = 0;; ++it) {
        const int idx = it * F.G + F.blk; if (idx >= BATCH * 8 * 8) break;
        const int bh = idx & 127, jn = idx >> 7, itp = jn >> 1, base = 2 * (itp >> 1) + (jn & 1), qb = (itp & 1) ? 7 - base : base;
        const int b = bh >> 3, h = bh & 7, q0 = 256 * qb + 32 * F.wave;
        attn_unit<0>(F.lds, F.wave, F.lane, QKV + (size_t)(b * SEQ) * NQ + 512 + h * 64, VTF + (size_t)(b * 512 + h * 64) * SEQ, KA + (size_t)bh * SEQ,
                     QKV + (size_t)(b * SEQ + q0) * NQ + h * 64, MIX + (size_t)(b * SEQ + q0) * D + h * 64, q0, 0, (q0 + 32 + 63) / 64, 0, 4 * qb + 4, 0.f, nullptr);
    }
    for (int it = 0;; ++it) {
        const int idx = it * F.G + F.blk; if (idx >= BATCH * 2 * 32) break;
        const int b = (idx & 31) >> 1, kvh = idx & 1, qp = idx >> 5, h = kvh * 4 + (F.wave & 3), q0 = 64 * qp + 32 * (F.wave >> 2);
        const int lo = q0 - 127, tw_lo = lo > 0 ? lo / 64 : 0, Lo = 64 * qp - 127, T_lo = Lo > 0 ? Lo / 64 : 0;
        attn_unit<1>(F.lds, F.wave, F.lane, QKV + (size_t)(b * SEQ) * NQ + 2048 + kvh * 64, VTS + (size_t)(b * 128 + kvh * 64) * SEQ, nullptr,
                     QKV + (size_t)(b * SEQ + q0) * NQ + 1536 + h * 64, MIX + (size_t)(b * SEQ + q0) * D + 512 + h * 64, q0, tw_lo, (q0 + 32 + 63) / 64, T_lo, qp + 1,
                     sinks[h] * 1.4426950408889634f, nullptr);
    }
}
__device__ __forceinline__ void attn1_phase(Frame& F) {
    const bf16* QKV = (const bf16*)(F.ws + WS_QKV); unsigned char* MIX = F.ws + WS_MIX;
    const bf16* VTD = (const bf16*)(F.ws + WS_VT); const unsigned long long* MB = (const unsigned long long*)(F.ws + WS_MASK);
    for (int it = 0;; ++it) {
        const int idx = it * F.G + F.blk; if (idx >= BATCH * 4 * 32) break;
        const int b = (idx & 63) >> 2, kvh = idx & 3, jn = idx >> 6, h3 = jn >> 2, a2 = jn & 3;
        const int qp = 4 * ((h3 & 1) ? 7 - (h3 >> 1) : (h3 >> 1)) + ((h3 & 1) ? 3 - a2 : a2);
        const int h = kvh * 4 + (F.wave & 3), q0 = 64 * qp + 32 * (F.wave >> 2);
        attn_unit<2>(F.lds, F.wave, F.lane, QKV + (size_t)(b * SEQ) * NQ + 1024 + kvh * 64, VTD + (size_t)(b * 256 + kvh * 64) * SEQ, nullptr,
                     QKV + (size_t)(b * SEQ + q0) * NQ + h * 64, MIX + (size_t)(b * SEQ + q0) * D + h * 64, q0, 0, qp + 1, 0, qp + 1, 0.f, MB + (size_t)(b * SEQ + q0) * 32);
    }
}

#define WRLANE(dst, val, LANE) asm("s_nop 1\n\tv_writelane_b32 %0, %1, %2" : "+v"(dst) : "s"(val), "n"(LANE))
template <int NR>
__device__ __forceinline__ unsigned select_query(const LAS float* srow_in, LAS unsigned* hist, const int q, const int lane_in, unsigned& Tprev) {
    unsigned myword = 0u;
    int lane = lane_in; asm volatile("" : "+v"(lane));
    const LAS float* srow = srow_in; asm volatile("" : "+v"(srow));
    unsigned ky[NR];
#pragma unroll
    for (int i = 0; i < NR; ++i) { const unsigned bits = __float_as_uint(srow[64 * i]); const unsigned key = (bits & 0x80000000u) ? ~bits : (bits | 0x80000000u); ky[i] = (lane <= q - 64 * i) ? key : 0u; }
#define SEL_COUNT(dst, thr) do { int c0_ = 0, c1_ = 0, c2_ = 0, c3_ = 0; \
        _Pragma("unroll") for (int i = 0; i < NR; i += 4) { c0_ += __popcll(__ballot(ky[i] >= (thr))); c1_ += __popcll(__ballot(ky[i + 1] >= (thr))); c2_ += __popcll(__ballot(ky[i + 2] >= (thr))); c3_ += __popcll(__ballot(ky[i + 3] >= (thr))); } \
        dst = (c0_ + c1_) + (c2_ + c3_); } while (0)
    unsigned Tk = 0u; bool exact = false; int above = 0;
    bool have = false;
    if (Tprev != 0u && (Tprev >> 23) != 0x1ffu) {
        const unsigned lo = Tprev & 0xff800000u, hi = lo + 0x00800000u; int clo, chi;
        SEL_COUNT(clo, lo); SEL_COUNT(chi, hi);
        if (clo >= 256 && chi < 256) { Tk = lo; above = chi; have = true; if (clo == 256) exact = true; }
    }
    if (!have) {
#pragma unroll 1
        for (int bit = 31; bit >= 23; --bit) { const unsigned cand = Tk | (1u << bit); int cnt; SEL_COUNT(cnt, cand);
            if (cnt >= 256) Tk = cand; else above = cnt;
            if (cnt == 256) { exact = true; break; } }
    }
    int lowbit = 22;
    if (!exact) {
        *(LAS u32x4*)(hist + 4 * lane) = (u32x4){0u, 0u, 0u, 0u};
#pragma unroll
        for (int i = 0; i < NR; ++i) { if ((ky[i] >> 23) == (Tk >> 23)) __hip_atomic_fetch_add(hist + ((ky[i] >> 15) & 255u), 1u, __ATOMIC_RELAXED, __HIP_MEMORY_SCOPE_WORKGROUP); }
        const u32x4 c = *(LAS u32x4*)(hist + 4 * lane);
        const int kk = 256 - above;
        const int s4 = (int)(c.x + c.y + c.z + c.w); int suf = s4;
#pragma unroll
        for (int o = 1; o < 64; o <<= 1) { const int t = __shfl_down(suf, o); if (lane + o < 64) suf += t; }
        const int ab3 = suf - s4, ab2 = ab3 + (int)c.w, ab1 = ab2 + (int)c.z, ab0 = ab1 + (int)c.y;
        int dmine = -1, kmine = 0, cmine = 0;
        if (ab3 < kk && kk <= ab3 + (int)c.w) { dmine = 4 * lane + 3; kmine = kk - ab3; cmine = (int)c.w; }
        else if (ab2 < kk && kk <= ab2 + (int)c.z) { dmine = 4 * lane + 2; kmine = kk - ab2; cmine = (int)c.z; }
        else if (ab1 < kk && kk <= ab1 + (int)c.y) { dmine = 4 * lane + 1; kmine = kk - ab1; cmine = (int)c.y; }
        else if (ab0 < kk && kk <= ab0 + (int)c.x) { dmine = 4 * lane; kmine = kk - ab0; cmine = (int)c.x; }
        const unsigned long long fb = __ballot(dmine >= 0);
        if (fb != 0ull) { const int src = __ffsll((long long)fb) - 1; const int dsel = __shfl(dmine, src), ksel = __shfl(kmine, src), csel = __shfl(cmine, src);
            Tk |= (unsigned)(dsel & 255) << 15; lowbit = 14; if (csel == ksel) exact = true; }
    }
    if (!exact) {
#pragma unroll 1
        for (int bit = lowbit; bit >= 0; --bit) { const unsigned cand = Tk | (1u << bit); int cnt; SEL_COUNT(cnt, cand);
            if (cnt >= 256) Tk = cand;
            if (cnt == 256) { exact = true; break; } }
    }
#undef SEL_COUNT
    asm volatile("" : "+v"(Tk));
    Tprev = Tk;
    if (exact) {
#pragma unroll
        for (int i = 0; i < NR; ++i) { const unsigned long long bs = __ballot(ky[i] >= Tk);
            WRLANE(myword, (unsigned)bs, 2 * i); WRLANE(myword, (unsigned)(bs >> 32), 2 * i + 1); }
    } else {
        int cgt = 0;
#pragma unroll
        for (int i = 0; i < NR; ++i) cgt += __popcll(__ballot(ky[i] > Tk));
        const int need = 256 - cgt; int running = 0;
        const unsigned long long ltmask = (1ull << lane) - 1ull;
#pragma unroll
        for (int i = 0; i < NR; ++i) { const bool eq = ky[i] == Tk; const unsigned long long beq = __ballot(eq);
            const int rank = running + __popcll(beq & ltmask); const bool sel = (ky[i] > Tk || (eq && rank < need)) && (lane <= q - 64 * i);
            const unsigned long long bs = __ballot(sel); running += __popcll(beq);
            WRLANE(myword, (unsigned)bs, 2 * i); WRLANE(myword, (unsigned)(bs >> 32), 2 * i + 1); }
    }
    return myword;
}
__device__ __forceinline__ void indexer_phase(Frame& F) {
    const bf16* QKV = (const bf16*)(F.ws + WS_QKV); const float* IW = (const float*)(F.ws + WS_IW); unsigned* MASK = (unsigned*)(F.ws + WS_MASK);
    LAS float* sc = (LAS float*)F.lds;
    constexpr int SP = 2052;
    const int fr = F.lane & 15, fq = F.lane >> 4;
    LAS unsigned* hist = (LAS unsigned*)(F.lds + 16 * SP * 4 + F.wave * 1024);
    unsigned Tprev = 0u;
#define IDX_DECODE(it_, valid_, rb_, q0_) do { const int idx_ = (it_) * F.G + F.blk; valid_ = idx_ < BATCH * 128; const int jn_ = (idx_ >> 4) & 127, h3_ = jn_ >> 4, a4_ = jn_ & 15; \
        q0_ = 16 * (16 * ((h3_ & 1) ? 7 - (h3_ >> 1) : (h3_ >> 1)) + ((h3_ & 1) ? 15 - a4_ : a4_)); rb_ = (size_t)(idx_ & 15) * SEQ; } while (0)
#define IDX_LOAD(rb_, q0_) do { const int nt_ = (q0_) / 16 + 1; const bf16* kb_ = QKV + ((rb_) + fr) * NQ + 2048 + fq * 8; \
        _Pragma("unroll") for (int k = 0; k < 8; ++k) { const int tl = F.wave + 8 * k < nt_ ? F.wave + 8 * k : 0; ik[k][0] = *(const bf16x8*)(kb_ + (size_t)tl * 16 * NQ); ik[k][1] = *(const bf16x8*)(kb_ + (size_t)tl * 16 * NQ + 32); } \
        iw0 = *(const f32x4*)(IW + ((rb_) + (q0_) + fr) * 8); iw1 = *(const f32x4*)(IW + ((rb_) + (q0_) + fr) * 8 + 4); \
        _Pragma("unroll") for (int j_ = 0; j_ < 2; ++j_) { const int r_ = 2 * F.wave + j_;        \
            __builtin_amdgcn_global_load_lds((const unsigned*)(QKV + ((rb_) + (q0_) + r_) * NQ + 1536 + F.lane * 8), (LAS unsigned*)(F.lds + IQ_ROW(r_)), 16, 0, 0); } } while (0)
#define IQ_ROW(r_) ((r_) < 11 ? 139520 + (r_) * 1040 : 152576 + ((r_) - 11) * 1040)
#define IQ_FRAGS() do { _Pragma("unroll") for (int h = 0; h < 8; ++h) _Pragma("unroll") for (int ks = 0; ks < 2; ++ks) iqf[h][ks] = *(const LAS bf16x8*)(F.lds + IQ_ROW(fr) + (h * 64 + ks * 32 + fq * 8) * 2); } while (0)
#define IDX_TILE(IKF, tile_) do { f32x4 s_ = (f32x4){0.f, 0.f, 0.f, 0.f}; \
        _Pragma("unroll") for (int h = 0; h < 8; ++h) { f32x4 a_ = (f32x4){0.f, 0.f, 0.f, 0.f}; const float iwh = h < 4 ? iw0[h & 3] : iw1[h & 3]; \
            a_ = __builtin_amdgcn_mfma_f32_16x16x32_bf16((IKF)[0], iqf[h][0], a_, 0, 0, 0); a_ = __builtin_amdgcn_mfma_f32_16x16x32_bf16((IKF)[1], iqf[h][1], a_, 0, 0, 0); \
            _Pragma("unroll") for (int i = 0; i < 4; ++i) { const int ai_ = __float_as_int(a_[i]); const float r_ = __int_as_float(ai_ > 0 ? ai_ : 0);     asm("v_fmac_f32 %0, %1, %2" : "+v"(s_[i]) : "v"(iwh), "v"(r_)); } } \
        *(LAS f32x4*)(sc + fr * SP + (tile_) * 16 + 4 * fq) = s_; } while (0)
    bf16x8 iqf[8][2], ik[8][2]; f32x4 iw0, iw1;
    bool valid; size_t rb; int q0;
    IDX_DECODE(0, valid, rb, q0);
    if (valid && q0 + 16 > 256) IDX_LOAD(rb, q0);
    __syncthreads();
    for (int it = 0; valid; ++it) {
        const bool light = q0 + 16 <= 256;
        const int ntile = light ? 0 : q0 / 16 + 1;
        if (ntile > 0) {
            IQ_FRAGS();
#pragma unroll
            for (int k = 0; k < 8; ++k) { if (F.wave + 8 * k < ntile) IDX_TILE(ik[k], F.wave + 8 * k); }
            if (ntile > 64) {
                const bf16* kb = QKV + (rb + fr) * NQ + 2048 + fq * 8;
#pragma unroll
                for (int k = 0; k < 8; ++k) { const int tl = F.wave + 64 + 8 * k < ntile ? F.wave + 64 + 8 * k : 0; ik[k][0] = *(const bf16x8*)(kb + (size_t)tl * 16 * NQ); ik[k][1] = *(const bf16x8*)(kb + (size_t)tl * 16 * NQ + 32); }
#pragma unroll
                for (int k = 0; k < 8; ++k) { if (F.wave + 64 + 8 * k < ntile) IDX_TILE(ik[k], F.wave + 64 + 8 * k); } }
        }
        __syncthreads();
        bool nvalid; size_t nrb; int nq0;
        IDX_DECODE(it + 1, nvalid, nrb, nq0);
        if (nvalid && nq0 + 16 > 256) IDX_LOAD(nrb, nq0);
#pragma unroll 1
        for (int k = 0; k < 2; ++k) {
            const int ql = 2 * F.wave + k, q = q0 + ql;
            unsigned myword = 0u;
            if (light) { const int n = q + 1 - 32 * F.lane; myword = n >= 32 ? 0xffffffffu : (n <= 0 ? 0u : ((1u << n) - 1u)); }
            else {
            const int nrb = (((q0 + 15) >> 6) + 4) >> 2;
            const LAS float* srow = sc + ql * SP + F.lane;
            switch (nrb) {
                case 1: myword = select_query<4>(srow, hist, q, F.lane, Tprev); break;   case 2: myword = select_query<8>(srow, hist, q, F.lane, Tprev); break;
                case 3: myword = select_query<12>(srow, hist, q, F.lane, Tprev); break;  case 4: myword = select_query<16>(srow, hist, q, F.lane, Tprev); break;
                case 5: myword = select_query<20>(srow, hist, q, F.lane, Tprev); break;  case 6: myword = select_query<24>(srow, hist, q, F.lane, Tprev); break;
                case 7: myword = select_query<28>(srow, hist, q, F.lane, Tprev); break;  default: myword = select_query<32>(srow, hist, q, F.lane, Tprev); break;
            }
            }
            MASK[(rb + q) * 64 + F.lane] = myword;
        }
        __syncthreads();
        valid = nvalid; rb = nrb; q0 = nq0;
    }
#undef IDX_DECODE
#undef IDX_LOAD
#undef IQ_ROW
#undef IQ_FRAGS
#undef IDX_TILE
}

template <bool MOE, bool SRC_BF16>
__device__ __forceinline__ void final_phase(Frame& F, const void* src, float* out, const float* fnorm, const float* mod1) {
    const int gw = F.blk * 8 + F.wave, NGW = F.G * 8;
    int P[9]; P[0] = 0;
    if (MOE) {
#pragma unroll
        for (int e = 0; e < 8; ++e) { int ce = (int)F.ctl[CW_CNT + 64 * e]; ce = ce < 0 ? 0 : (ce > T ? T : ce); P[e + 1] = P[e] + (ce + 255) / 256; }
    }
    const bf16* Y = (const bf16*)(F.ws + WS_Y); const u32x4* tok = (const u32x4*)(F.ws + WS_TOK);
    f32x4 fn[4];
#pragma unroll
    for (int jj = 0; jj < 4; ++jj) fn[jj] = *(const f32x4*)(fnorm + 4 * F.lane + 256 * jj);
    const int rpw = T / NGW; int gb = -1; f32x4 gfv[4];
    u32x4 tnext = (u32x4){0u, 0u, 0u, 0u};
    if (MOE) tnext = tok[gw * rpw];
    for (int row = gw * rpw; row < (gw + 1) * rpw; ++row) {
        f32x4 v[4];
#pragma unroll
        for (int jj = 0; jj < 4; ++jj) {
            if (SRC_BF16) { const u32x2 w = ((const u32x2*)((const bf16*)src + (size_t)row * D) + F.lane)[64 * jj]; v[jj] = (f32x4){bflo(w.x), bfhi(w.x), bflo(w.y), bfhi(w.y)}; }
            else v[jj] = ((const f32x4*)((const float*)src + (size_t)row * D) + F.lane)[64 * jj]; }
        if (MOE) {
            const u32x4 ti = tnext; if (row + 1 < (gw + 1) * rpw) tnext = tok[row + 1]; const int e1 = ti.x & 0xff, e2 = (ti.x >> 8) & 0xff; int p1 = 0, p2 = 0;
#pragma unroll
            for (int e = 0; e < 8; ++e) { if (e1 == e) p1 = P[e]; if (e2 == e) p2 = P[e]; }
            const size_t r1 = (size_t)p1 * 256 + ti.y, r2 = (size_t)p2 * 256 + ti.z; const float g1 = __uint_as_float(ti.w), g2 = 1.f - g1;
            const int b = row / SEQ;
            const u32x2* y1 = (const u32x2*)(Y + r1 * D) + F.lane; const u32x2* y2 = (const u32x2*)(Y + r2 * D) + F.lane;
            if (b != gb) { gb = b;
#pragma unroll
                for (int jj = 0; jj < 4; ++jj) gfv[jj] = *(const f32x4*)(mod1 + (size_t)b * 6144 + 5 * 1024 + 4 * F.lane + 256 * jj); }
#pragma unroll
            for (int jj = 0; jj < 4; ++jj) { const u32x2 a = y1[64 * jj], c = y2[64 * jj]; const f32x4 gf = gfv[jj];
                v[jj][0] += gf[0] * (g1 * bflo(a.x) + g2 * bflo(c.x)); v[jj][1] += gf[1] * (g1 * bfhi(a.x) + g2 * bfhi(c.x));
                v[jj][2] += gf[2] * (g1 * bflo(a.y) + g2 * bflo(c.y)); v[jj][3] += gf[3] * (g1 * bfhi(a.y) + g2 * bfhi(c.y)); }
        }
        float ss = 0.f;
#pragma unroll
        for (int jj = 0; jj < 4; ++jj) ss += (v[jj][0] * v[jj][0] + v[jj][1] * v[jj][1]) + (v[jj][2] * v[jj][2] + v[jj][3] * v[jj][3]);
        const float rstd = rsqrtf(wave_sum(ss) * (1.f / D) + NORM_EPS);
        f32x4* orow = (f32x4*)(out + (size_t)row * D) + F.lane;
#pragma unroll
        for (int jj = 0; jj < 4; ++jj) orow[64 * jj] = v[jj] * rstd * fn[jj];
    }
}

constexpr int NPHASE = 17;
constexpr int LASTPH = (MK_STAGE == 0) ? 0 : (MK_STAGE == 1) ? 4 : (MK_STAGE == 2) ? 7 : (MK_STAGE == 3) ? 12 : 15;
__global__ void __launch_bounds__(512, 2) fwd_kernel(Args args) {
    extern __shared__ __attribute__((aligned(16))) unsigned char lds_raw[];
    Frame F;
    F.lds = (LAS unsigned char*)lds_raw; F.ws = args.ws; F.ctl = (unsigned*)(args.ws + WS_CTL);
    F.tid = threadIdx.x; F.lane = F.tid & 63; F.wave = __builtin_amdgcn_readfirstlane(F.tid >> 6); F.G = gridDim.x; F.blk = blockIdx.x;
    volatile LAS unsigned* MISC = (volatile LAS unsigned*)(F.lds + MISC_OFF);
    if (F.tid < 64) MISC[F.tid] = 0u;
    __syncthreads();
    XcdBarrier bar; bar.bar = F.ctl + CW_BAR; bar.x = 0; bar.st = MISC + 8;
    if (MK_ONE_LAUNCH) bar = xcd_barrier_post(F.ctl + CW_BAR, MISC + 8);
    const int lo = args.ph_lo, hi = args.ph_hi;
#define IN(k) (lo <= (k) && (k) < hi && ((k) <= LASTPH || (k) == NPHASE - 1))
#define SEAM(k) do { if (MK_ONE_LAUNCH && (k) + 1 < hi) xcd_barrier(bar); } while (0)
    const float* x = (const float*)args.in[0];
    float* mod0 = (float*)(F.ws + WS_MOD); float* mod1 = mod0 + 16 * 6144;
    bf16* Hb = (bf16*)(F.ws + WS_H); bf16* QKV = (bf16*)(F.ws + WS_QKV); bf16* MIX = (bf16*)(F.ws + WS_MIX); unsigned char* ACT0 = F.ws + WS_ACT0; unsigned char* ACT1 = F.ws + WS_ACT1; bf16* Yb = (bf16*)(F.ws + WS_Y); bf16* XR = (bf16*)(F.ws + WS_XR);
    const int* posv = (const int*)args.in[2];
    LAS unsigned char* ring = F.lds;

#define PHASE(k, ...) do { if (IN(k)) { { int l_; asm volatile("v_mbcnt_lo_u32_b32 %0, -1, 0\n\tv_mbcnt_hi_u32_b32 %0, -1, %0" : "=v"(l_)); F.lane = l_; F.tid = F.wave * 64 + l_; } __VA_ARGS__; if (MK_DUP & (1 << (k))) { xcd_barrier(bar); __VA_ARGS__; } } SEAM(k); } while (0)
    PHASE(0, { p0_prologue(F, args); q_strips(F, args); zero_kpad(F, F.ws + WS_WDN1, NE * D); });
    PHASE(1, { norm_phase<1, false, 2>(F, x, (const float*)args.in[5], mod0, 0, 1024, Hb, (const float*)args.in[7], E_IN, 1536, (const float*)args.in[8], (float*)(F.ws + WS_LOGF)); });
    const float* rsc = (const float*)(F.ws + WS_RS); const float* csc = (const float*)(F.ws + WS_CS);
    PHASE(2, {
        pg8::StaticOrder S; S.init(T, NQ, D / 2, F.G, F.blk, Hb, F.ws + WS_WIN0, csc + CS_WIN0);
        pg8::EpiQKV<0> E{QKV, (bf16*)(F.ws + WS_VT), (bf16*)(F.ws + WS_VT_SWA), posv, F.lds + VT_STAGE_OFF, nullptr};
        pg8::gemm_phase<pg8::EpiQKV<0>, pg8::StaticOrder, true, false, 2>(ring, D / 2, S, E, F.wave, rsc); cumsum_kaug(F); });
    PHASE(3, attn0_phase(F, (const float*)args.in[9]));
    PHASE(4, { pg8::StaticOrder S; S.init(T, D, D / 2, F.G, F.blk, MIX, F.ws + WS_WOUT0);
        pg8::EpiResid<true> E{x, XR, mod0 + 2048, 1.f / (FP8_MIX_SCALE * FP8_W_SCALE)};
        pg8::gemm_phase<pg8::EpiResid<true>, pg8::StaticOrder, true, false, 1>(ring, D / 2, S, E, F.wave); });
    PHASE(5, norm_phase<0, true, 2>(F, XR, (const float*)args.in[6], mod0, 3072, 4096, Hb, nullptr, 0, 0, nullptr, nullptr));
    PHASE(6, { pg8::StaticOrder S; S.init(T, 2 * FF, D / 2, F.G, F.blk, Hb, F.ws + WS_WGU0, csc + CS_WGU0);
        pg8::EpiSwiGLU<true> E{ACT0, FF, 1.f};
        pg8::gemm_phase<pg8::EpiSwiGLU<true>, pg8::StaticOrder, true, false, 2>(ring, D / 2, S, E, F.wave, rsc); });
    PHASE(7, { pg8::StaticOrder S; S.init(T, D, FF / 2, F.G, F.blk, ACT0, F.ws + WS_WDN0);
        pg8::EpiResid<false> E{nullptr, XR, mod0 + 5120, FP8_OUT_SCALE};
        pg8::gemm_phase<pg8::EpiResid<false>, pg8::StaticOrder, true, false, 1>(ring, FF / 2, S, E, F.wave); });
    PHASE(8, norm_phase<0, true, 2>(F, XR, (const float*)args.in[16], mod1, 0, 1024, Hb, nullptr, 0, 0, nullptr, nullptr));
    PHASE(9, { pg8::StaticOrder S; S.init(T, NQ, D / 2, F.G, F.blk, Hb, F.ws + WS_WIN1, csc + CS_WIN1);
        pg8::EpiQKV<1> E{QKV, (bf16*)(F.ws + WS_VT), nullptr, posv, F.lds + VT_STAGE_OFF, (float*)(F.ws + WS_IW)};
        pg8::gemm_phase<pg8::EpiQKV<1>, pg8::StaticOrder, true, false, 2>(ring, D / 2, S, E, F.wave, rsc); });
    PHASE(10, indexer_phase(F));
    PHASE(11, attn1_phase(F));
    PHASE(12, { pg8::StaticOrder S; S.init(T, D, D / 2, F.G, F.blk, MIX, F.ws + WS_WOUT1);
        pg8::EpiResid<false> E{nullptr, XR, mod1 + 2048, 1.f / (FP8_MIX_SCALE * FP8_W_SCALE)};
        pg8::gemm_phase<pg8::EpiResid<false>, pg8::StaticOrder, true, false, 1>(ring, D / 2, S, E, F.wave); });
    PHASE(13, { norm_phase<3, true, 2>(F, XR, (const float*)args.in[17], mod1, 3072, 4096, Hb, (const float*)args.in[20], 8, 0, (const float*)args.in[21], nullptr); });
    PHASE(14, { pg8::MoeOrder S; S.init(F.ctl + CW_CNT, 2 * FFE, D / 2, F.G, F.blk, Hb, F.ws + WS_WGU1, (size_t)2 * FFE * D, (const int*)(F.ws + WS_LIST), true, csc + CS_WGU1, 2 * FFE);
        pg8::EpiSwiGLU<true> E{ACT1, FFEP, 1.f};
        pg8::gemm_phase<pg8::EpiSwiGLU<true>, pg8::MoeOrder, true, true, 2>(ring, D / 2, S, E, F.wave, (const float*)(F.ws + WS_RSS)); });
    PHASE(15, { pg8::MoeOrder S; S.init(F.ctl + CW_CNT, D, FFEP / 2, F.G, F.blk, ACT1, F.ws + WS_WDN1, (size_t)D * FFEP, nullptr, false);
        pg8::EpiBf16 E{Yb, D, FP8_OUT_SCALE};
        pg8::gemm_phase<pg8::EpiBf16, pg8::MoeOrder, true, false, 1>(ring, FFEP / 2, S, E, F.wave); });
    if (IN(16)) {
        if (MK_STAGE == 0) final_phase<false, false>(F, x, args.out, (const float*)args.in[25], mod1);
        else if (MK_STAGE < 4) final_phase<false, true>(F, XR, args.out, (const float*)args.in[25], mod1);
        else final_phase<true, true>(F, XR, args.out, (const float*)args.in[25], mod1);
    }
#undef IN
#undef SEAM
#undef PHASE
}

extern "C" void kernel_launch(void* const* d_in, const int* in_sizes, int n_in, void* d_out, int out_size, void* d_ws, size_t ws_size, hipStream_t stream) {
    static int grid = 0;
    if (grid == 0) {
        if (n_in != 26 || out_size != T * D || ws_size < WS_END) { fprintf(stderr, "kernel_launch: unexpected shapes (n_in %d out %d ws %zu)\n", n_in, out_size, ws_size); grid = -1; return; }
        int dev = 0, cus = 0;
        if (hipGetDevice(&dev) != hipSuccess || hipDeviceGetAttribute(&cus, hipDeviceAttributeMultiprocessorCount, dev) != hipSuccess) { grid = -1; return; }
        if (hipFuncSetAttribute((const void*)fwd_kernel, hipFuncAttributeMaxDynamicSharedMemorySize, LDS_BYTES) != hipSuccess) { fprintf(stderr, "kernel_launch: hipFuncSetAttribute failed\n"); grid = -1; return; }
        int per_cu = 0;
        if (hipOccupancyMaxActiveBlocksPerMultiprocessor(&per_cu, (const void*)fwd_kernel, 512, LDS_BYTES) != hipSuccess || per_cu < 1) fprintf(stderr, "kernel_launch: occupancy query reports %d\n", per_cu);
        (void)hipGetLastError();
        grid = 256;
        while (grid > cus && grid > 1) grid >>= 1;
    }
    if (grid < 0) return;
    (void)hipMemsetAsync((char*)d_ws + WS_CTL, 0, CTL_ZERO_BYTES, stream);
    Args a{};
    for (int i = 0; i < 26; ++i) a.in[i] = d_in[i];
    a.out = (float*)d_out; a.ws = (unsigned char*)d_ws;
#if MK_ONE_LAUNCH
    a.ph_lo = 0; a.ph_hi = NPHASE;
    hipLaunchKernelGGL(fwd_kernel, dim3(grid), dim3(512), LDS_BYTES, stream, a);
#else
    for (int p = 0; p < NPHASE; ++p) {
        if (!(p <= LASTPH || p == NPHASE - 1)) continue;
        a.ph_lo = p; a.ph_hi = p + 1;
        hipLaunchKernelGGL(fwd_kernel, dim3(grid), dim3(512), LDS_BYTES, stream, a);
        if (p == MK_REP_PHASE) for (int r = 0; r < MK_REP_N; ++r) hipLaunchKernelGGL(fwd_kernel, dim3(grid), dim3(512), LDS_BYTES, stream, a);
    }
#endif
}
```
